# Optimizing an MI355X kernel written in HIP

```python
import jax, jax.numpy as jnp
from jax import lax
import numpy as np

D_MODEL = 1024
BATCH = 4
SEQ = 8192
DEPTH = 1

HEAD_DIM = 64
MIX_WIDTH = D_MODEL
RWKV_WIDTH = MIX_WIDTH // 2
FOX_WIDTH = MIX_WIDTH - RWKV_WIDTH
RWKV_HEADS = RWKV_WIDTH // HEAD_DIM
FOX_HEADS = FOX_WIDTH // HEAD_DIM
DECAY_LORA = 64
AAA_LORA = 64
GATE_LORA = 128
RWKV_IN = 3 * RWKV_WIDTH + DECAY_LORA + AAA_LORA + GATE_LORA
FOX_IN = 3 * FOX_WIDTH + FOX_HEADS
IN_WIDTH = RWKV_IN + FOX_IN
RWKV_SPLITS = [RWKV_WIDTH, 2 * RWKV_WIDTH, 3 * RWKV_WIDTH,
               3 * RWKV_WIDTH + DECAY_LORA, 3 * RWKV_WIDTH + DECAY_LORA + AAA_LORA]
FOX_SPLITS = [FOX_WIDTH, 2 * FOX_WIDTH, 3 * FOX_WIDTH]
Q_BLOCK = 128
N_EXPERTS = 32
TOP_K = 4
D_FF = D_MODEL
MOE_BLOCK = 128
SWIGLU_ALPHA = 1.702
SWIGLU_LIMIT = 7.0
RMS_EPS = 1e-5
RWKV_GN_EPS = 64e-5

kernel_name = "hymba_rwkv7_fox_moe_layer"


def rms_norm(x, g, eps=RMS_EPS):
    xf = x.astype(jnp.float32)
    y = xf * lax.rsqrt(jnp.mean(xf * xf, axis=-1, keepdims=True) + eps)
    return (y * g.astype(jnp.float32)).astype(x.dtype)


def rwkv7_group(u, mu, w0, w_up, a0, a_up, g_up, k_k, k_a, r_k, ln_w, ln_b):
    B, T, _ = u.shape
    H, N = RWKV_HEADS, HEAD_DIM
    u = u.astype(jnp.float32)
    u_prev = jnp.pad(u[:, :-1], ((0, 0), (1, 0), (0, 0)))
    u = u + (u_prev - u) * mu
    r, k, v, wl, al, gl = jnp.split(u, RWKV_SPLITS, axis=-1)
    w = -jax.nn.softplus(-(w0 + jnp.tanh(wl) @ w_up)) - 0.5
    decay = jnp.exp(-jnp.exp(w))
    a = jax.nn.sigmoid(a0 + al @ a_up)
    g = jax.nn.sigmoid(gl) @ g_up
    kk = (k * k_k).reshape(B, T, H, N)
    kk = kk / jnp.maximum(jnp.sqrt(jnp.sum(kk * kk, axis=-1, keepdims=True)), 1e-12)
    k = k * (1.0 + (a - 1.0) * k_a)
    r, k, v, decay, a = (t.reshape(B, T, H, N) for t in (r, k, v, decay, a))

    def step(S, inp):
        r_t, w_t, k_t, v_t, kk_t, a_t = inp
        s_kk = jnp.einsum('bhvk,bhk->bhv', S, kk_t)
        S = (S * w_t[:, :, None, :]
             - s_kk[..., None] * (kk_t * a_t)[:, :, None, :]
             + v_t[..., None] * k_t[:, :, None, :])
        return S, jnp.einsum('bhvk,bhk->bhv', S, r_t)

    S0 = jnp.zeros((B, H, N, N), jnp.float32)
    seq_inputs = tuple(jnp.moveaxis(t, 1, 0) for t in (r, decay, k, v, kk, a))
    _, y = lax.scan(step, S0, seq_inputs)
    y = jnp.moveaxis(y, 0, 1)
    mean = jnp.mean(y, axis=-1, keepdims=True)
    var = jnp.mean(jnp.square(y - mean), axis=-1, keepdims=True)
    y = ((y - mean) * lax.rsqrt(var + RWKV_GN_EPS)).reshape(B, T, RWKV_WIDTH) * ln_w + ln_b
    bonus = jnp.sum(r * k * r_k, axis=-1, keepdims=True) * v
    return (y + bonus.reshape(B, T, RWKV_WIDTH)) * g


def fox_group(u, f_bias, out_g):
    B, T, _ = u.shape
    H, Dh = FOX_HEADS, HEAD_DIM
    q, k, v, fl = jnp.split(u.astype(jnp.float32), FOX_SPLITS, axis=-1)
    q = q.reshape(B, T, H, Dh) * (Dh ** -0.5)
    k = k.reshape(B, T, H, Dh)
    v = v.reshape(B, T, H, Dh)
    log_f = jax.nn.log_sigmoid(fl + f_bias)
    c = jnp.transpose(jnp.cumsum(log_f, axis=1), (0, 2, 1))
    key_pos = jnp.arange(T)

    def query_block(i):
        start = i * Q_BLOCK
        qb = lax.dynamic_slice_in_dim(q, start, Q_BLOCK, axis=1)
        cb = lax.dynamic_slice_in_dim(c, start, Q_BLOCK, axis=2)
        s = jnp.einsum('bqhd,bkhd->bhqk', qb, k) + cb[..., :, None] - c[..., None, :]
        q_pos = start + jnp.arange(Q_BLOCK)
        s = jnp.where(key_pos[None, :] <= q_pos[:, None], s, -jnp.inf)
        p = jax.nn.softmax(s, axis=-1)
        return jnp.einsum('bhqk,bkhd->bqhd', p, v)

    o = lax.map(query_block, jnp.arange(T // Q_BLOCK))
    o = jnp.transpose(o, (1, 0, 2, 3, 4)).reshape(B, T, H, Dh)
    o = o * lax.rsqrt(jnp.mean(o * o, axis=-1, keepdims=True) + RMS_EPS)
    return o.reshape(B, T, FOX_WIDTH) * out_g


def clamped_swiglu(h):
    glu, lin = h[..., ::2], h[..., 1::2]
    glu = jnp.minimum(glu, SWIGLU_LIMIT)
    lin = jnp.clip(lin, -SWIGLU_LIMIT, SWIGLU_LIMIT)
    return glu * jax.nn.sigmoid(SWIGLU_ALPHA * glu) * (lin + 1.0)


def moe_ffn(h, router_w, router_b, w1, b1, w2, b2):
    B, T, D = h.shape
    n_tok = B * T
    n_slots = n_tok * TOP_K
    xt = h.reshape(n_tok, D)
    logits = (xt @ router_w + router_b).astype(jnp.float32)
    top_val, top_idx = lax.top_k(logits, TOP_K)
    gates = jax.nn.softmax(top_val, axis=-1)
    flat_e = top_idx.reshape(-1)
    order = jnp.argsort(flat_e)
    sorted_e = flat_e[order]
    sorted_tok = (order // TOP_K).astype(jnp.int32)
    sorted_gate = gates.reshape(-1)[order]
    sizes = jnp.bincount(flat_e, length=N_EXPERTS).astype(jnp.int32)
    padded = (sizes + MOE_BLOCK - 1) // MOE_BLOCK * MOE_BLOCK
    starts = jnp.cumsum(sizes) - sizes
    pad_ends = jnp.cumsum(padded)
    pad_starts = pad_ends - padded
    dest = pad_starts[sorted_e] + jnp.arange(n_slots, dtype=jnp.int32) - starts[sorted_e]
    n_pad = n_slots + N_EXPERTS * MOE_BLOCK
    n_blocks = n_pad // MOE_BLOCK
    slot_tok = jnp.zeros((n_pad,), jnp.int32).at[dest].set(sorted_tok)
    slot_gate = jnp.zeros((n_pad,), jnp.float32).at[dest].set(sorted_gate)
    block_start = jnp.arange(n_blocks, dtype=jnp.int32) * MOE_BLOCK
    block_e = jnp.minimum(jnp.searchsorted(pad_ends, block_start, side='right'), N_EXPERTS - 1)

    def expert_block(args):
        tok, gate, e = args
        hid = xt[tok] @ w1[e] + b1[e]
        out = clamped_swiglu(hid) @ w2[e] + b2[e]
        return out * gate[:, None].astype(out.dtype)

    outs = lax.map(expert_block, (slot_tok.reshape(n_blocks, MOE_BLOCK),
                                  slot_gate.reshape(n_blocks, MOE_BLOCK), block_e))
    y = jnp.zeros((n_tok, D), outs.dtype).at[slot_tok].add(outs.reshape(n_pad, D))
    return y.reshape(B, T, D).astype(h.dtype)


def setup_inputs(seed: int = 0) -> dict:
    key = jax.random.key(seed)
    ks = jax.random.split(key, 25)
    L = DEPTH
    f32 = jnp.float32

    def nrm(k, shape, scale):
        return scale * jax.random.normal(k, shape, f32)

    return {
        "x": jax.random.normal(ks[0], (BATCH, SEQ, D_MODEL), f32),
        "attn_norm_g": 1.0 + nrm(ks[1], (L, D_MODEL), 0.02),
        "w_in": nrm(ks[2], (L, D_MODEL, IN_WIDTH), D_MODEL ** -0.5),
        "rwkv_mu": jax.random.uniform(ks[3], (L, RWKV_IN), f32),
        "rwkv_w0": jax.random.uniform(ks[4], (L, RWKV_WIDTH), f32, -6.0, -0.5),
        "rwkv_w_up": nrm(ks[5], (L, DECAY_LORA, RWKV_WIDTH), 0.5 * DECAY_LORA ** -0.5),
        "rwkv_a0": nrm(ks[6], (L, RWKV_WIDTH), 0.5),
        "rwkv_a_up": nrm(ks[7], (L, AAA_LORA, RWKV_WIDTH), AAA_LORA ** -0.5),
        "rwkv_g_up": nrm(ks[8], (L, GATE_LORA, RWKV_WIDTH), GATE_LORA ** -0.5),
        "rwkv_k_k": 0.85 + nrm(ks[9], (L, RWKV_WIDTH), 0.02),
        "rwkv_k_a": 1.0 + nrm(ks[10], (L, RWKV_WIDTH), 0.02),
        "rwkv_r_k": nrm(ks[11], (L, RWKV_HEADS, HEAD_DIM), 0.1),
        "rwkv_ln_w": 1.0 + nrm(ks[12], (L, RWKV_WIDTH), 0.02),
        "rwkv_ln_b": nrm(ks[13], (L, RWKV_WIDTH), 0.01),
        "fox_f_bias": jax.random.uniform(ks[14], (L, FOX_HEADS), f32, 1.0, 4.0),
        "fox_out_g": 1.0 + nrm(ks[15], (L, FOX_WIDTH), 0.02),
        "w_out": nrm(ks[16], (L, MIX_WIDTH, D_MODEL), MIX_WIDTH ** -0.5),
        "ffn_norm_g": 1.0 + nrm(ks[17], (L, D_MODEL), 0.02),
        "router_w": nrm(ks[18], (L, D_MODEL, N_EXPERTS), D_MODEL ** -0.5),
        "router_b": nrm(ks[19], (L, N_EXPERTS), 0.01),
        "expert_w1": nrm(ks[20], (L, N_EXPERTS, D_MODEL, 2 * D_FF), D_MODEL ** -0.5),
        "expert_b1": nrm(ks[21], (L, N_EXPERTS, 2 * D_FF), 0.01),
        "expert_w2": nrm(ks[22], (L, N_EXPERTS, D_FF, D_MODEL), D_FF ** -0.5),
        "expert_b2": nrm(ks[23], (L, N_EXPERTS, D_MODEL), 0.01),
        "final_norm_g": 1.0 + nrm(ks[24], (D_MODEL,), 0.02),
    }


def reference(x, attn_norm_g, w_in, rwkv_mu, rwkv_w0, rwkv_w_up, rwkv_a0, rwkv_a_up,
              rwkv_g_up, rwkv_k_k, rwkv_k_a, rwkv_r_k, rwkv_ln_w, rwkv_ln_b,
              fox_f_bias, fox_out_g, w_out, ffn_norm_g, router_w, router_b,
              expert_w1, expert_b1, expert_w2, expert_b2, final_norm_g):
    for l in range(DEPTH):
        h = rms_norm(x, attn_norm_g[l])
        u = h @ w_in[l]
        y_rwkv = rwkv7_group(u[..., :RWKV_IN], rwkv_mu[l], rwkv_w0[l], rwkv_w_up[l],
                             rwkv_a0[l], rwkv_a_up[l], rwkv_g_up[l], rwkv_k_k[l],
                             rwkv_k_a[l], rwkv_r_k[l], rwkv_ln_w[l], rwkv_ln_b[l])
        y_fox = fox_group(u[..., RWKV_IN:], fox_f_bias[l], fox_out_g[l])
        mix = jnp.concatenate([y_rwkv.astype(x.dtype), y_fox.astype(x.dtype)], axis=-1)
        x = x + mix @ w_out[l]
        x = x + moe_ffn(rms_norm(x, ffn_norm_g[l]), router_w[l], router_b[l],
                        expert_w1[l], expert_b1[l], expert_w2[l], expert_b2[l])
    return rms_norm(x, final_norm_g)
```

```cpp
#include <hip/hip_runtime.h>
#include <cstdio>
#include <cstdint>
namespace pg8 {
#define PG8_LAS __attribute__((address_space(3)))
typedef unsigned short bf16_t;
typedef short bf16x8 __attribute__((ext_vector_type(8)));
typedef float f32x4 __attribute__((ext_vector_type(4)));
typedef unsigned u32x4 __attribute__((ext_vector_type(4)));
constexpr int BM = 256, BK = 64, HALF = 128, HTB = HALF * BK * 2  , STAGE_BYTES = 8 * HTB, NXCD = 8, WGM = 8;

__host__ __device__ __forceinline__ int lds_byte(int r, int c) { const int st = (r >> 4) * 2 + (c >> 5), rr = r & 15, cc = c & 31, ob = rr * 64 + cc * 2; return st * 1024 + (ob ^ (((ob >> 9) & 1) << 5)); }
__host__ __device__ __forceinline__ void stage_rc(int b, int& R, int& C) { const int st = b / 1024, sb = b % 1024, swz = sb ^ (((sb >> 9) & 1) << 5); R = (st >> 1) * 16 + swz / 64; C = (st & 1) * 32 + (swz % 64) / 2; }
__host__ __device__ __forceinline__ int perm32(int rho) { const int n = rho >> 4, i = rho & 15; return 8 * (i >> 2) + 4 * n + (i & 3); }

struct Unit { int pm, pn, e, l0, cnt; };
struct Gemm { const bf16_t* A; const bf16_t* Bt; int K; size_t bstride; const int* rows; int rows_stride; };

struct StaticOrder {
    int nM, nN, nwg, G, c;
    __host__ __device__ void init(int M, int N, int G_, int c_) { nM = M / BM; nN = N / BM; nwg = nM * nN; G = G_; c = c_; }
    __host__ __device__ bool next(int i, Unit& u) const {
        const long L = (long)i * G + c; if (L >= nwg) return false;
        int wgid = (int)L; { const int q = nwg / NXCD, r = nwg % NXCD, xcd = wgid % NXCD, off = wgid / NXCD; wgid = (xcd < r ? xcd * (q + 1) : r * (q + 1) + (xcd - r) * q) + off; }
        const int nig = WGM * nN, gid = wgid / nig, fm = gid * WGM, gsz = (nM - fm) < WGM ? (nM - fm) : WGM;
        u.pm = fm + ((wgid % nig) % gsz); u.pn = (wgid % nig) / gsz; u.e = 0; u.l0 = 0; u.cnt = 256; return true;
    }
    __device__ __forceinline__ void a_ready(const Unit&) const {}
    __device__ __forceinline__ void done(const Unit&) const {}
};

__device__ __forceinline__ unsigned cvt_pk_bf16(float lo, float hi) { unsigned r; asm volatile("v_cvt_pk_bf16_f32 %0, %1, %2" : "=v"(r) : "v"(lo), "v"(hi)); return r; }
typedef float f32x2 __attribute__((ext_vector_type(2)));
typedef unsigned u32x2 __attribute__((ext_vector_type(2)));
struct EpiU {
    static constexpr bool PERM = true, AFTER_DRAIN = false;
    bf16_t* O; int ldc; int q_lo, q_hi; float qscale;
    __device__ __forceinline__ void operator()(const f32x4 (&acc)[2][2][4][2], const Unit& u, int wr, int wc, int fr, int fq) const {
        const int row0 = u.pm * BM + wr * 64 + fr; const int col0 = u.pn * BM + wc * 32 + 8 * fq;
        const float sc = (u.pn >= q_lo && u.pn < q_hi) ? qscale : 1.f;
#pragma unroll
        for (int ai = 0; ai < 2; ++ai)
#pragma unroll
            for (int m = 0; m < 4; ++m) { bf16_t* rowp = O + (size_t)(row0 + ai * HALF + m * 16) * ldc + col0;
#pragma unroll
                for (int bj = 0; bj < 2; ++bj) { const f32x4 v0 = acc[ai][bj][m][0] * sc, v1 = acc[ai][bj][m][1] * sc;
                    u32x4 w; w.x = cvt_pk_bf16(v0[0], v0[1]); w.y = cvt_pk_bf16(v0[2], v0[3]); w.z = cvt_pk_bf16(v1[0], v1[1]); w.w = cvt_pk_bf16(v1[2], v1[3]);
                    *(u32x4*)(rowp + bj * HALF) = w; } }
    }
};
struct EpiRes {
    static constexpr bool PERM = false, AFTER_DRAIN = false;
    const float* base; float* out; int ldc;
    __device__ __forceinline__ void operator()(const f32x4 (&acc)[2][2][4][2], const Unit& u, int wr, int wc, int fr, int fq) const {
        const int col0 = u.pn * BM + wc * 32 + 4 * fq;
#pragma unroll
        for (int ai = 0; ai < 2; ++ai)
#pragma unroll
            for (int m = 0; m < 4; ++m) { const size_t off = (size_t)(u.pm * BM + ai * HALF + wr * 64 + m * 16 + fr) * ldc + col0;
#pragma unroll
                for (int bj = 0; bj < 2; ++bj)
#pragma unroll
                    for (int n = 0; n < 2; ++n) { const f32x4 bs = *(const f32x4*)(base + off + bj * HALF + n * 16); *(f32x4*)(out + off + bj * HALF + n * 16) = bs + acc[ai][bj][m][n]; } }
    }
};
struct EpiSwiglu {
    static constexpr bool PERM = true, AFTER_DRAIN = false;
    bf16_t* O; int ldc; const float* bias; int nb;
    __device__ __forceinline__ static float act(float g, float l) {
        g = fminf(g, 7.0f); l = fminf(fmaxf(l, -7.0f), 7.0f);
        const float s = __builtin_amdgcn_rcpf(1.0f + __builtin_amdgcn_exp2f(-1.702f * 1.4426950408889634f * g));
        return g * s * (l + 1.0f);
    }
    __device__ __forceinline__ void operator()(const f32x4 (&acc)[2][2][4][2], const Unit& u, int wr, int wc, int fr, int fq) const {
        const int row0 = u.pm * BM + wr * 64 + fr; const int col0 = u.pn * BM + wc * 32 + 8 * fq;
        const float* bp = bias + (size_t)u.e * nb + col0;
        f32x4 bv[2][2];
#pragma unroll
        for (int bj = 0; bj < 2; ++bj)
#pragma unroll
            for (int n = 0; n < 2; ++n) bv[bj][n] = *(const f32x4*)(bp + bj * HALF + 4 * n);
#pragma unroll
        for (int ai = 0; ai < 2; ++ai)
#pragma unroll
            for (int m = 0; m < 4; ++m) { bf16_t* rowp = O + (size_t)(row0 + ai * HALF + m * 16) * ldc + (col0 >> 1);
#pragma unroll
                for (int bj = 0; bj < 2; ++bj) { const f32x4 v0 = acc[ai][bj][m][0] + bv[bj][0], v1 = acc[ai][bj][m][1] + bv[bj][1];
                    u32x2 w; w.x = cvt_pk_bf16(act(v0[0], v0[1]), act(v0[2], v0[3])); w.y = cvt_pk_bf16(act(v1[0], v1[1]), act(v1[2], v1[3]));
                    *(u32x2*)(rowp + bj * (HALF / 2)) = w; } }
    }
};
struct EpiBias {
    static constexpr bool PERM = true, AFTER_DRAIN = false;
    bf16_t* O; int ldc; const float* bias; int nb;
    __device__ __forceinline__ void operator()(const f32x4 (&acc)[2][2][4][2], const Unit& u, int wr, int wc, int fr, int fq) const {
        const int row0 = u.pm * BM + wr * 64 + fr; const int col0 = u.pn * BM + wc * 32 + 8 * fq;
        const float* bp = bias + (size_t)u.e * nb + col0;
        f32x4 bv[2][2];
#pragma unroll
        for (int bj = 0; bj < 2; ++bj)
#pragma unroll
            for (int n = 0; n < 2; ++n) bv[bj][n] = *(const f32x4*)(bp + bj * HALF + 4 * n);
#pragma unroll
        for (int ai = 0; ai < 2; ++ai)
#pragma unroll
            for (int m = 0; m < 4; ++m) { bf16_t* rowp = O + (size_t)(row0 + ai * HALF + m * 16) * ldc + col0;
#pragma unroll
                for (int bj = 0; bj < 2; ++bj) { const f32x4 v0 = acc[ai][bj][m][0] + bv[bj][0], v1 = acc[ai][bj][m][1] + bv[bj][1];
                    u32x4 w; w.x = cvt_pk_bf16(v0[0], v0[1]); w.y = cvt_pk_bf16(v0[2], v0[3]); w.z = cvt_pk_bf16(v1[0], v1[1]); w.w = cvt_pk_bf16(v1[2], v1[3]);
                    *(u32x4*)(rowp + bj * HALF) = w; } }
    }
};

template <class Epi, class Sched, bool GATHER, bool ALIGN_EPI = false, bool SP2 = false>
__device__ __forceinline__ void gemm_phase(PG8_LAS unsigned char* lds, const Gemm g, const Sched& S, const Epi& E) {
    const int tid = threadIdx.x, wid = __builtin_amdgcn_readfirstlane(tid >> 6), lane = tid & 63, wr = wid >> 2, wc = wid & 3, fr = lane & 15, fq = lane >> 4;
    const int K = g.K, nt = K / BK;
    unsigned voffA[2], voffB[2]; int sR[2], sC[2];
#pragma unroll
    for (int i = 0; i < 2; ++i) { int R, C; stage_rc(tid * 16 + i * 8192, R, C); const int Rb = Epi::PERM ? ((R & ~31) + perm32(R & 31)) : R; sR[i] = R; sC[i] = C;
        voffA[i] = (unsigned)(R * K + C) * 2u; voffB[i] = (unsigned)(Rb * K + C) * 2u; }
    unsigned vC[2][2], vN[2][2], vS[2][2];
#define PG8_GOFF(U, V) do { _Pragma("unroll") for (int _h = 0; _h < 2; ++_h) _Pragma("unroll") for (int _i = 0; _i < 2; ++_i) { int _ix = (U).l0 + _h * HALF + sR[_i]; _ix = _ix < (U).cnt ? _ix : (U).cnt - 1; \
        const int _tok = g.rows[(size_t)(U).e * g.rows_stride + _ix]; V[_h][_i] = (unsigned)(_tok * K + sC[_i]) * 2u; } } while (0)
#define PG8_STAGE_A(bufoff, gbase, h, VG) do { if constexpr (GATHER) { PG8_STAGE(bufoff, gbase, VG[h]); } else { PG8_STAGE(bufoff, (gbase) + (h) * hstep, voffA); } } while (0)
    const size_t kstep = (size_t)(BK * 2);
    const size_t hstep = (size_t)HALF * K * 2;
    const size_t tstep = 2 * hstep;
    const unsigned ldsw = (unsigned)wid * 1024u;
    const int aoff = lds_byte(wr * 64 + fr, fq * 8), boff = lds_byte(wc * 32 + fr, fq * 8);
#define PG8_SA(b, h) (((b) * 2 + (h)) * HTB)
#define PG8_SB(b, h) ((4 + (b) * 2 + (h)) * HTB)
#define PG8_STAGE(bufoff, gbase, voff) do { _Pragma("unroll") for (int _i = 0; _i < 2; ++_i) \
        __builtin_amdgcn_global_load_lds((const unsigned*)((const char*)(gbase) + (voff)[_i]), (PG8_LAS unsigned*)(lds + (bufoff) + ldsw + _i * 8192), 16, 0, 0); } while (0)
#define PG8_LDA(dst, b, h) do { _Pragma("unroll") for (int m = 0; m < 4; ++m) _Pragma("unroll") for (int k = 0; k < 2; ++k) dst[m][k] = *(const PG8_LAS bf16x8*)(lds + PG8_SA(b, h) + aoff + m * 2048 + k * 1024); } while (0)
#define PG8_LDB(dst, b, h) do { _Pragma("unroll") for (int n = 0; n < 2; ++n) _Pragma("unroll") for (int k = 0; k < 2; ++k) dst[n][k] = *(const PG8_LAS bf16x8*)(lds + PG8_SB(b, h) + boff + n * 2048 + k * 1024); } while (0)
#define PG8_MMA(ai, bj, At, Bt) do { __builtin_amdgcn_s_setprio(1); _Pragma("unroll") for (int m = 0; m < 4; ++m) _Pragma("unroll") for (int n = 0; n < 2; ++n) _Pragma("unroll") for (int k = 0; k < 2; ++k) \
        acc[ai][bj][m][n] = __builtin_amdgcn_mfma_f32_16x16x32_bf16(Bt[n][k], At[m][k], acc[ai][bj][m][n], 0, 0, 0); __builtin_amdgcn_s_setprio(0); } while (0)
#define PG8_WAIT_V(n) asm volatile("s_waitcnt vmcnt(" #n ")" ::: "memory")
#define PG8_WAIT_L(n) asm volatile("s_waitcnt lgkmcnt(" #n ")" ::: "memory")
#define PG8_BAR __builtin_amdgcn_s_barrier()
#define PG8_SCHED __builtin_amdgcn_sched_barrier(0)
    Unit cur, nxt; int ui = 0;
    if (!S.next(0, cur)) return;
    f32x4 acc[2][2][4][2];
#pragma unroll
    for (int a = 0; a < 2; ++a)
#pragma unroll
        for (int b = 0; b < 2; ++b)
#pragma unroll
            for (int m = 0; m < 4; ++m)
#pragma unroll
                for (int n = 0; n < 2; ++n) acc[a][b][m][n] = (f32x4){0.f, 0.f, 0.f, 0.f};
    bf16x8 At[4][2], B0[2][2], B1[2][2];
    const char* cA = (const char*)g.A + (GATHER ? (size_t)0 : (size_t)cur.pm * tstep); const char* cB = (const char*)g.Bt + ((size_t)cur.e * g.bstride) * 2 + (size_t)cur.pn * tstep;
    if constexpr (GATHER) { PG8_GOFF(cur, vC); }
    S.a_ready(cur);
    if constexpr (SP2) {
        PG8_STAGE(PG8_SB(0, 0), cB, voffB); PG8_STAGE(PG8_SB(0, 1), cB + hstep, voffB); PG8_STAGE_A(PG8_SA(0, 0), cA, 0, vC); PG8_STAGE_A(PG8_SA(0, 1), cA, 1, vC);
        if (wr == 1) PG8_BAR;
        PG8_WAIT_V(2); PG8_BAR;
        PG8_STAGE(PG8_SB(1, 0), cB + kstep, voffB); PG8_STAGE_A(PG8_SA(1, 0), cA + kstep, 0, vC); PG8_STAGE(PG8_SB(1, 1), cB + hstep + kstep, voffB);
        PG8_WAIT_V(6); PG8_BAR;
    } else {
        PG8_STAGE(PG8_SB(0, 0), cB, voffB); PG8_STAGE_A(PG8_SA(0, 0), cA, 0, vC); PG8_STAGE(PG8_SB(0, 1), cB + hstep, voffB); PG8_STAGE_A(PG8_SA(0, 1), cA, 1, vC);
        if (wr == 1) PG8_BAR;
        PG8_WAIT_V(4); PG8_BAR;
        PG8_STAGE(PG8_SB(1, 0), cB + kstep, voffB); PG8_STAGE_A(PG8_SA(1, 0), cA + kstep, 0, vC); PG8_STAGE(PG8_SB(1, 1), cB + hstep + kstep, voffB);
        PG8_WAIT_V(6); PG8_BAR;
    }
    for (;;) {
        const bool has_next = S.next(ui + 1, nxt);
        const char* nA = (has_next && !GATHER) ? (const char*)g.A + (size_t)nxt.pm * tstep : cA; const char* nB = has_next ? (const char*)g.Bt + ((size_t)nxt.e * g.bstride) * 2 + (size_t)nxt.pn * tstep : cB;
        if constexpr (GATHER) { if (has_next) { PG8_GOFF(nxt, vN); } else { _Pragma("unroll") for (int h_ = 0; h_ < 2; ++h_) _Pragma("unroll") for (int i_ = 0; i_ < 2; ++i_) vN[h_][i_] = vC[h_][i_]; } }
        for (int t = 0; t < nt; t += 2) {
            const bool last = (t == nt - 2);
            const char* a1 = cA + (size_t)(t + 1) * kstep;
            const char* a2 = last ? nA : cA + (size_t)(t + 2) * kstep;
            if constexpr (GATHER) { _Pragma("unroll") for (int h_ = 0; h_ < 2; ++h_) _Pragma("unroll") for (int i_ = 0; i_ < 2; ++i_) vS[h_][i_] = last ? vN[h_][i_] : vC[h_][i_]; } const char* b2 = last ? nB : cB + (size_t)(t + 2) * kstep;
            const char* a3 = a2 + kstep; const char* b3 = b2 + kstep;
            if (last && has_next) S.a_ready(nxt);
            if constexpr (SP2) {
            PG8_LDB(B0, 0, 0); PG8_LDB(B1, 0, 1); PG8_SCHED; PG8_LDA(At, 0, 0); PG8_STAGE_A(PG8_SA(1, 1), a1, 1, vC);
            PG8_WAIT_V(8); PG8_WAIT_L(0); PG8_BAR; PG8_MMA(0, 0, At, B0); PG8_MMA(0, 1, At, B1); PG8_BAR; PG8_SCHED;
            PG8_LDA(At, 0, 1); PG8_STAGE(PG8_SB(0, 0), b2, voffB); PG8_STAGE(PG8_SB(0, 1), b2 + hstep, voffB); PG8_STAGE_A(PG8_SA(0, 0), a2, 0, vS);
            PG8_WAIT_V(8); PG8_WAIT_L(0); PG8_BAR; PG8_MMA(1, 0, At, B0); PG8_MMA(1, 1, At, B1); PG8_BAR; PG8_SCHED;
            PG8_LDB(B0, 1, 0); PG8_LDB(B1, 1, 1); PG8_SCHED; PG8_LDA(At, 1, 0); PG8_STAGE_A(PG8_SA(0, 1), a2, 1, vS);
            PG8_WAIT_V(8); PG8_WAIT_L(0); PG8_BAR; PG8_MMA(0, 0, At, B0); PG8_MMA(0, 1, At, B1); PG8_BAR; PG8_SCHED;
            PG8_LDA(At, 1, 1); PG8_STAGE(PG8_SB(1, 0), b3, voffB); PG8_STAGE(PG8_SB(1, 1), b3 + hstep, voffB); PG8_STAGE_A(PG8_SA(1, 0), a3, 0, vS);
            PG8_WAIT_V(8); PG8_WAIT_L(0); PG8_BAR; PG8_MMA(1, 0, At, B0); PG8_MMA(1, 1, At, B1); PG8_BAR; PG8_SCHED;
            } else {
            PG8_LDB(B0, 0, 0); PG8_SCHED; PG8_LDA(At, 0, 0); PG8_STAGE_A(PG8_SA(1, 1), a1, 1, vC);
            PG8_WAIT_L(8); PG8_BAR; PG8_WAIT_L(0); PG8_MMA(0, 0, At, B0); PG8_BAR; PG8_SCHED;
            PG8_LDB(B1, 0, 1); PG8_STAGE(PG8_SB(0, 0), b2, voffB);
            PG8_BAR; PG8_WAIT_L(0); PG8_MMA(0, 1, At, B1); PG8_BAR;
            PG8_LDA(At, 0, 1); PG8_STAGE_A(PG8_SA(0, 0), a2, 0, vS);
            PG8_BAR; PG8_WAIT_L(0); PG8_MMA(1, 0, At, B0); PG8_BAR; PG8_SCHED;
            PG8_STAGE(PG8_SB(0, 1), b2 + hstep, voffB);
            PG8_WAIT_V(6); PG8_BAR; PG8_MMA(1, 1, At, B1); PG8_BAR;
            PG8_LDB(B0, 1, 0); PG8_SCHED; PG8_LDA(At, 1, 0); PG8_STAGE_A(PG8_SA(0, 1), a2, 1, vS);
            PG8_WAIT_L(8); PG8_BAR; PG8_WAIT_L(0); PG8_MMA(0, 0, At, B0); PG8_BAR; PG8_SCHED;
            PG8_LDB(B1, 1, 1); PG8_STAGE(PG8_SB(1, 0), b3, voffB);
            PG8_BAR; PG8_WAIT_L(0); PG8_MMA(0, 1, At, B1); PG8_BAR;
            PG8_LDA(At, 1, 1); PG8_STAGE_A(PG8_SA(1, 0), a3, 0, vS);
            PG8_BAR; PG8_WAIT_L(0); PG8_MMA(1, 0, At, B0); PG8_BAR; PG8_SCHED;
            PG8_STAGE(PG8_SB(1, 1), b3 + hstep, voffB);
            PG8_WAIT_V(6); PG8_BAR; PG8_MMA(1, 1, At, B1); PG8_BAR;
            }
        }
        if constexpr (ALIGN_EPI) { if (wr == 0) PG8_BAR; }
        if constexpr (!Epi::AFTER_DRAIN) { E(acc, cur, wr, wc, fr, fq); S.done(cur); }
        if (!has_next) break;
#pragma unroll
        for (int a = 0; a < 2; ++a)
#pragma unroll
            for (int b = 0; b < 2; ++b)
#pragma unroll
                for (int m = 0; m < 4; ++m)
#pragma unroll
                    for (int n = 0; n < 2; ++n) acc[a][b][m][n] = (f32x4){0.f, 0.f, 0.f, 0.f};
        cur = nxt; cA = nA; cB = nB; ++ui;
        if constexpr (GATHER) { _Pragma("unroll") for (int h_ = 0; h_ < 2; ++h_) _Pragma("unroll") for (int i_ = 0; i_ < 2; ++i_) vC[h_][i_] = vN[h_][i_]; }
        if constexpr (ALIGN_EPI) { if (wr == 1) PG8_BAR; }
    }
    PG8_WAIT_V(0);
    if constexpr (!ALIGN_EPI) { if (wr == 0) PG8_BAR; }
    PG8_BAR;
    if constexpr (Epi::AFTER_DRAIN) { E.fused(acc, cur, wr, wc, fr, fq, lds, wid, lane); S.done(cur); }
#undef PG8_SA
#undef PG8_GOFF
#undef PG8_STAGE_A
#undef PG8_SB
#undef PG8_STAGE
#undef PG8_LDA
#undef PG8_LDB
#undef PG8_MMA
#undef PG8_WAIT_V
#undef PG8_WAIT_L
#undef PG8_BAR
#undef PG8_SCHED
}
}
#ifndef PG8_SP2
#define PG8_SP2 true
#endif
#ifndef PG8_ALIGN
#define PG8_ALIGN true
#endif
#include <hip/hip_bf16.h>
#include <cmath>
namespace attn_body {
using bf16=__hip_bfloat16;
using bf16x8=__attribute__((ext_vector_type(8)))short;
using s16x4=__attribute__((ext_vector_type(4)))short;
using f32x16=__attribute__((ext_vector_type(16)))float;
using u32x4=__attribute__((ext_vector_type(4)))unsigned;
constexpr int BATCH=4,NHEAD=8,SEQ=8192,D=64,PQ=3328,PO=1024;
constexpr int NW=8,QBLK=32,QB=QBLK*NW,KVBLK=64,NQB=SEQ/QB;
constexpr int ATTN_UNIT_ROWS=QB;
__device__ __forceinline__ int crow(int r,int hi){return (r&3)+8*(r>>2)+4*hi;}
#define SBAR() __builtin_amdgcn_sched_barrier(0)
__device__ __forceinline__ void cmask(f32x16&p0,f32x16&p1,int jb,int qrel,int hi){
  const float NEG=-INFINITY; int kb=64*jb+4*hi;
  #pragma unroll
  for(int r=0;r<16;++r){int kv=kb+(r&3)+8*(r>>2); if(kv>qrel)p0[r]=NEG; if(kv+32>qrel)p1[r]=NEG;}
}

constexpr int NSLOT=3, SLOTB=8192;
constexpr int LDS_K=0, LDS_V=NSLOT*SLOTB, LDS_WS=2*NSLOT*SLOTB, LDS_OST=LDS_WS+NW*64*4, LDS_CK=LDS_OST+NW*4096, LDS_BYTES=LDS_CK+SEQ*4;
constexpr float C2=0.125f*1.4426950408889634f;
__device__ __forceinline__ void glds16(const void*gsrc,unsigned lds_dst){unsigned keep;
  asm volatile("s_mov_b32 %0, m0\n\ts_mov_b32 m0, %2\n\ts_nop 0\n\tglobal_load_lds_dwordx4 %1, off\n\ts_mov_b32 m0, %0":"=&s"(keep):"v"(gsrc),"s"(lds_dst):"memory");}
__device__ __forceinline__ float max3f(float a,float b,float c){float r;asm("v_max3_f32 %0, %1, %2, %3":"=v"(r):"v"(a),"v"(b),"v"(c));return r;}
__device__ __forceinline__ float max2f(float a,float b){float r;asm("v_max_f32_e32 %0, %1, %2":"=v"(r):"v"(a),"v"(b));return r;}
__device__ __forceinline__ float fadd_s(float a,float b){float r;asm("v_add_f32_e32 %0, %1, %2":"=v"(r):"v"(a),"v"(b));return r;}
__device__ __forceinline__ float fsub_s(float a,float b){float r;asm("v_sub_f32_e32 %0, %1, %2":"=v"(r):"v"(a),"v"(b));return r;}
typedef float f32x2_t __attribute__((ext_vector_type(2))); typedef __bf16 bf16x2_t __attribute__((ext_vector_type(2)));
__device__ __forceinline__ unsigned cvtpk_s(float lo,float hi){f32x2_t v={lo,hi};bf16x2_t b=__builtin_convertvector(v,bf16x2_t);return __builtin_bit_cast(unsigned,b);}
#define WAIT_BAR(N) asm volatile("s_waitcnt vmcnt(" #N ") lgkmcnt(0)\n\ts_barrier":::"memory")

__device__ __forceinline__ void qkt(f32x16&p0,f32x16&p1,const char*Kslot,const bf16x8*qr,int r32,int hi){
  const char*kb=Kslot+hi*1024+r32*16;
  #pragma unroll
  for(int d0=0;d0<4;++d0){
    const bf16x8 b0=*reinterpret_cast<const bf16x8*>(kb+d0*2048);
    const bf16x8 b1=*reinterpret_cast<const bf16x8*>(kb+d0*2048+512);
    p0=__builtin_amdgcn_mfma_f32_32x32x16_bf16(b0,qr[d0],p0,0,0,0);p1=__builtin_amdgcn_mfma_f32_32x32x16_bf16(b1,qr[d0],p1,0,0,0);}
}
typedef __attribute__((address_space(3))) const char* lds_cptr;
typedef __attribute__((address_space(3))) float* lds_f32p; typedef __attribute__((address_space(3))) const float* lds_cf32p; typedef float f32x4_t __attribute__((ext_vector_type(4)));
typedef short v4i16_t __attribute__((ext_vector_type(4)));
__device__ __forceinline__ void kload8(bf16x8*kf,lds_cptr kp){
  kf[0]=*(const __attribute__((address_space(3))) bf16x8*)(kp);      kf[1]=*(const __attribute__((address_space(3))) bf16x8*)(kp+512);
  kf[2]=*(const __attribute__((address_space(3))) bf16x8*)(kp+2048); kf[3]=*(const __attribute__((address_space(3))) bf16x8*)(kp+2560);
  kf[4]=*(const __attribute__((address_space(3))) bf16x8*)(kp+4096); kf[5]=*(const __attribute__((address_space(3))) bf16x8*)(kp+4608);
  kf[6]=*(const __attribute__((address_space(3))) bf16x8*)(kp+6144); kf[7]=*(const __attribute__((address_space(3))) bf16x8*)(kp+6656);
}
__device__ __forceinline__ void kload2(bf16x8*kf,lds_cptr kp,int j){ kf[2*j]=*(const __attribute__((address_space(3))) bf16x8*)(kp+j*2048); kf[2*j+1]=*(const __attribute__((address_space(3))) bf16x8*)(kp+j*2048+512); }
__device__ __forceinline__ s16x4 vtr(lds_cptr p){ return __builtin_bit_cast(s16x4,__builtin_amdgcn_ds_read_tr16_b64_v4i16((__attribute__((address_space(3))) v4i16_t*)p)); }
__device__ __forceinline__ float rowmax(const f32x16&p0,const f32x16&p1){
  float a=max3f(p0[0],p0[1],p1[0]),b=max3f(p0[2],p0[3],p1[1]);a=max3f(a,p1[2],p1[3]);
  #pragma unroll
  for(int r=4;r<16;r+=4){a=max3f(a,p0[r],p0[r+1]);b=max3f(b,p0[r+2],p0[r+3]);a=max3f(a,p1[r],p1[r+1]);b=max3f(b,p1[r+2],p1[r+3]);}
  const float m=max2f(a,b);
  auto rr=__builtin_amdgcn_permlane32_swap(__float_as_uint(m),__float_as_uint(m),false,false);
  return max2f(__uint_as_float(rr[0]),__uint_as_float(rr[1]));
}
__device__ __forceinline__ void pv(f32x16*o,int vb,bf16x8 pa0,bf16x8 pa1,bf16x8 pa2,bf16x8 pa3){
  #pragma unroll
  for(int d0=0;d0<2;++d0){s16x4 lo[4],hi[4];
    #pragma unroll
    for(int ks=0;ks<4;++ks){
      asm volatile("ds_read_b64_tr_b16 %0,%1 offset:%c2":"=&v"(lo[ks]):"v"(vb),"i"(d0*4096+ks*1024):"memory");
      asm volatile("ds_read_b64_tr_b16 %0,%1 offset:%c2":"=&v"(hi[ks]):"v"(vb),"i"(d0*4096+ks*1024+512):"memory");}
    asm volatile("s_waitcnt lgkmcnt(0)":::"memory");SBAR();
    #define PK(k) (bf16x8){lo[k][0],lo[k][1],lo[k][2],lo[k][3],hi[k][0],hi[k][1],hi[k][2],hi[k][3]}
    o[d0]=__builtin_amdgcn_mfma_f32_32x32x16_bf16(pa0,PK(0),o[d0],0,0,0);
    o[d0]=__builtin_amdgcn_mfma_f32_32x32x16_bf16(pa1,PK(1),o[d0],0,0,0);
    o[d0]=__builtin_amdgcn_mfma_f32_32x32x16_bf16(pa2,PK(2),o[d0],0,0,0);
    o[d0]=__builtin_amdgcn_mfma_f32_32x32x16_bf16(pa3,PK(3),o[d0],0,0,0);
    #undef PK
  }
}

#ifndef ATTN_STORE16
#define ATTN_STORE16(p,v) (*(u32x4*)(p)=(v))
#endif
template<int THRL> __device__ __forceinline__ void attn_unit(int b,int h,int qb,const bf16*Q,const bf16*__restrict__ K,const bf16*__restrict__ V,bf16*O,const float*__restrict__ CKG,const float*__restrict__ OG,char*shm){
  const int tid=threadIdx.x,lane=tid&63,r32=lane&31,hi=lane>>5; const int wid=__builtin_amdgcn_readfirstlane(tid>>6);
  const long rowbase=(long)b*SEQ; const int q0=qb*QB; const lds_cptr shm3_=(lds_cptr)shm;
  const bf16*Qw=Q+(rowbase+q0+wid*QBLK)*PQ+h*D;
  const bf16*Kh=K+rowbase*PQ+h*D,*Vh=V+rowbase*PQ+h*D;
  const unsigned lds0=(unsigned)(uintptr_t)shm;
  float*wsf=(float*)(shm+LDS_WS)+wid*64;
  const bf16*ksrc=Kh+(long)lane*PQ+wid*8;
  const bf16*vsrc=Vh+(long)(16*(wid&3)+(lane>>2))*PQ+(wid>>2)*32+(lane&3)*8;
  const unsigned kdst=lds0+LDS_K+wid*1024, vdst=lds0+LDS_V+wid*1024;
  #define DMA_K(t,slot) glds16(ksrc+(long)(t)*KVBLK*PQ,(unsigned)__builtin_amdgcn_readfirstlane(kdst+(slot)))
  #define DMA_V(t,slot) glds16(vsrc+(long)(t)*KVBLK*PQ,(unsigned)__builtin_amdgcn_readfirstlane(vdst+(slot)))
  const int vb0=(int)(lds0+LDS_V)+((lane>>4)&1)*32+(lane&3)*8+(4*hi+((lane&15)>>2))*64;
  const char*Kbase=shm+LDS_K; bf16x8 kf[8];
  const lds_cptr shm3=(lds_cptr)shm; const lds_cptr kp0=shm3+LDS_K+hi*1024+r32*16; const lds_cptr vp0=shm3+LDS_V+((lane>>4)&1)*32+(lane&3)*8+(4*hi+((lane&15)>>2))*64;
  const int NT=(q0+QB)/KVBLK;
  { const float*ckg=CKG+((long)(b*NHEAD+h))*SEQ; lds_f32p ckl=(lds_f32p)(shm3_+LDS_CK);
    for(int i=tid*4;i<q0+QB;i+=NW*64*4){ const f32x4_t v=*(const f32x4_t*)(ckg+i); *(__attribute__((address_space(3))) f32x4_t*)(ckl+i)=v; } }
  const lds_cf32p ckb=(lds_cf32p)(shm3_+LDS_CK)+4*hi;
  DMA_K(0,0);DMA_V(0,0);DMA_K(1,SLOTB);
  bf16x8 qr[4];
  #pragma unroll
  for(int d0=0;d0<4;++d0)qr[d0]=*reinterpret_cast<const bf16x8*>(&Qw[(long)r32*PQ+d0*16+hi*8]);
  float mhat=0.f,l_reg=0.f;f32x16 o[2];o[0]=f32x16{};o[1]=f32x16{};float negmh=0.f;
  #define BIAS(C0,C1,t) do{ const lds_cf32p cp_=ckb+(t)*KVBLK; \
    _Pragma("unroll") for(int g_=0;g_<4;++g_){ const f32x4_t a_=*(const __attribute__((address_space(3))) f32x4_t*)(cp_+8*g_); const f32x4_t b_=*(const __attribute__((address_space(3))) f32x4_t*)(cp_+8*g_+32); \
      _Pragma("unroll") for(int j_=0;j_<4;++j_){ C0[4*g_+j_]=negmh-a_[j_]; C1[4*g_+j_]=negmh-b_[j_]; } if(g_&1){SBAR();} } }while(0)
  const int qrel=wid*QBLK+r32;
  #define CMASK(P0,P1,t) do{int jb_=(t)-(NT-4); if(jb_>=0)cmask(P0,P1,jb_,qrel,hi);}while(0)
  bool resc=false;
  #define START(P0,P1) do{ const float rm=rowmax(P0,P1); resc=false; \
    { const float dl=rm; mhat=fadd_s(mhat,dl); \
      _Pragma("unroll") for(int r=0;r<16;++r){P0[r]=fsub_s(P0[r],dl);P1[r]=fsub_s(P1[r],dl);} \
      negmh=-mhat; } \
    _Pragma("unroll") for(int r=0;r<16;++r)P0[r]=__builtin_amdgcn_exp2f(P0[r]); }while(0)
  #define RESC() do{ if(resc){ asm volatile("s_waitcnt lgkmcnt(0)":::"memory"); \
      _Pragma("unroll") for(int d_=0;d_<2;++d_) _Pragma("unroll") for(int r=0;r<16;++r)o[d_][r]*=wsf[crow(r,hi)]; } }while(0)
  f32x16 pA0,pA1,pB0,pB1;
  int sl_prev=0,sl_cur=0,sl_next=SLOTB;
  #define ROT() do{sl_prev=sl_cur;sl_cur=sl_next;sl_next=(sl_next==(NSLOT-1)*SLOTB)?0:sl_next+SLOTB;}while(0)
  DMA_K(2,2*SLOTB);
  WAIT_BAR(3);
  BIAS(pA0,pA1,0); qkt(pA0,pA1,Kbase,qr,r32,hi);asm volatile("s_nop 15\n\ts_nop 7":"+v"(pA0),"+v"(pA1));CMASK(pA0,pA1,0);
  START(pA0,pA1);
  _Pragma("unroll") for(int r=0;r<16;++r)pA1[r]=__builtin_amdgcn_exp2f(pA1[r]);
  WAIT_BAR(0);
  DMA_K(3,0);DMA_V(1,SLOTB);
  ROT();
  kload8(kf,kp0+sl_cur);
  WAIT_BAR(2);
  s16x4 vlo[8],vhi[8]; u32x4 pw0,pw1,pw2,pw3;
  #define PKW(P,B) cvtpk_s(P[B],P[B+1])
  #define PAF(k) __builtin_bit_cast(bf16x8,pw##k)
  #define VFR(i) (bf16x8){vlo[i][0],vlo[i][1],vlo[i][2],vlo[i][3],vhi[i][0],vhi[i][1],vhi[i][2],vhi[i][3]}
  #define PIN(x) asm volatile("":"+v"(x))
  #define MX3(a,b,c) __builtin_fmaxf(__builtin_fmaxf((a),(b)),(c))
  #define GAPA(MF,A0,A1,A2,A3,W0,W1,PW) do{ MF; sacc+=A0; sacc+=A1; sacc+=A2; sacc+=A3; PIN(sacc); W0; W1; PIN(PW); SBAR(); }while(0)
  #define EX(v) __builtin_amdgcn_exp2f(v)
  #define GAPB(MF,X,B) do{ MF; X[B]=EX(X[B]); X[B+1]=EX(X[B+1]); X[B+2]=EX(X[B+2]); X[B+3]=EX(X[B+3]); PIN(X); SBAR(); }while(0)
  #define VRD(i) do{ vlo[i]=vtr(vp_+(((i)>>2)*4096+((i)&3)*1024)); vhi[i]=vtr(vp_+(((i)>>2)*4096+((i)&3)*1024+512)); }while(0)
  #define KRD(G,j) do{ if(G){ kload2(kf,kp0+sl_next,j); SBAR(); } }while(0)
  #define STEP(C0,C1,P0,P1,t,GK,GV,GL) do{ SBAR(); BIAS(C0,C1,t); SBAR(); \
    const lds_cptr vp_=vp0+sl_prev; \
    VRD(0); SBAR(); float sacc=(P0[0]+P0[1]); \
    GAPA(C0=__builtin_amdgcn_mfma_f32_32x32x16_bf16(kf[0],qr[0],C0,0,0,0), P0[2],P0[3],P0[4],P0[5],     pw0[0]=PKW(P0,0), pw0[1]=PKW(P0,2), pw0); \
    VRD(4); SBAR(); GAPA(C1=__builtin_amdgcn_mfma_f32_32x32x16_bf16(kf[1],qr[0],C1,0,0,0), P0[6],P0[7],P0[8],P0[9],     pw0[2]=PKW(P0,4), pw0[3]=PKW(P0,6), pw0); \
    VRD(1); SBAR(); GAPA(C0=__builtin_amdgcn_mfma_f32_32x32x16_bf16(kf[2],qr[1],C0,0,0,0),   P0[10],P0[11],P0[12],P0[13], pw1[0]=PKW(P0,8), pw1[1]=PKW(P0,10), pw1); \
    VRD(5); SBAR(); GAPA(C1=__builtin_amdgcn_mfma_f32_32x32x16_bf16(kf[3],qr[1],C1,0,0,0),   P0[14],P0[15],P1[0],P1[1],   pw1[2]=PKW(P0,12),pw1[3]=PKW(P0,14), pw1); \
    VRD(2); SBAR(); GAPA(C0=__builtin_amdgcn_mfma_f32_32x32x16_bf16(kf[4],qr[2],C0,0,0,0),   P1[2],P1[3],P1[4],P1[5],     pw2[0]=PKW(P1,0), pw2[1]=PKW(P1,2), pw2); \
    VRD(6); SBAR(); GAPA(C1=__builtin_amdgcn_mfma_f32_32x32x16_bf16(kf[5],qr[2],C1,0,0,0),   P1[6],P1[7],P1[8],P1[9],     pw2[2]=PKW(P1,4), pw2[3]=PKW(P1,6), pw2); \
    VRD(3); SBAR(); GAPA(C0=__builtin_amdgcn_mfma_f32_32x32x16_bf16(kf[6],qr[3],C0,0,0,0),   P1[10],P1[11],P1[12],P1[13], pw3[0]=PKW(P1,8), pw3[1]=PKW(P1,10), pw3); \
    VRD(7); SBAR(); GAPA(C1=__builtin_amdgcn_mfma_f32_32x32x16_bf16(kf[7],qr[3],C1,0,0,0),   P1[14],P1[15],0.f,0.f,       pw3[2]=PKW(P1,12),pw3[3]=PKW(P1,14), pw3); \
    l_reg+=sacc; \
    if(GK){DMA_K((t)+3,sl_cur);} if(GV){DMA_V((t)+1,sl_next);} \
    CMASK(C0,C1,t); \
    { float a=MX3(C0[0],C0[1],C1[0]),b=MX3(C0[2],C0[3],C1[1]); a=MX3(a,C1[2],C1[3]); \
      _Pragma("unroll") for(int r=4;r<16;r+=4){a=MX3(a,C0[r],C0[r+1]);b=MX3(b,C0[r+2],C0[r+3]);a=MX3(a,C1[r],C1[r+1]);b=MX3(b,C1[r+2],C1[r+3]);} \
      float rm=__builtin_fmaxf(a,b); { auto rr=__builtin_amdgcn_permlane32_swap(__float_as_uint(rm),__float_as_uint(rm),false,false); rm=__builtin_fmaxf(__uint_as_float(rr[0]),__uint_as_float(rr[1])); } \
      resc=false; \
      if(__builtin_expect(__any(rm>(float)THRL),0)){ const float dl=__builtin_fmaxf(rm,0.f); mhat+=dl; \
        _Pragma("unroll") for(int r=0;r<16;++r){C0[r]-=dl;C1[r]-=dl;} \
        negmh=-mhat; \
        const float f=__builtin_amdgcn_exp2f(-dl); l_reg*=f; if(hi==0)wsf[r32]=f; resc=true; } } \
    SBAR(); \
    GAPB(o[0]=__builtin_amdgcn_mfma_f32_32x32x16_bf16(PAF(0),VFR(0),o[0],0,0,0), C0,0); \
    GAPB(o[1]=__builtin_amdgcn_mfma_f32_32x32x16_bf16(PAF(0),VFR(4),o[1],0,0,0), C0,4); \
    KRD(GL,0); GAPB(o[0]=__builtin_amdgcn_mfma_f32_32x32x16_bf16(PAF(1),VFR(1),o[0],0,0,0), C0,8); \
    KRD(GL,1); GAPB(o[1]=__builtin_amdgcn_mfma_f32_32x32x16_bf16(PAF(1),VFR(5),o[1],0,0,0), C0,12); \
    KRD(GL,2); GAPB(o[0]=__builtin_amdgcn_mfma_f32_32x32x16_bf16(PAF(2),VFR(2),o[0],0,0,0), C1,0); \
    KRD(GL,3); GAPB(o[1]=__builtin_amdgcn_mfma_f32_32x32x16_bf16(PAF(2),VFR(6),o[1],0,0,0), C1,4); \
    GAPB(o[0]=__builtin_amdgcn_mfma_f32_32x32x16_bf16(PAF(3),VFR(3),o[0],0,0,0), C1,8); \
    GAPB(o[1]=__builtin_amdgcn_mfma_f32_32x32x16_bf16(PAF(3),VFR(7),o[1],0,0,0), C1,12); \
    }while(0)
  int t=1;
  #undef CMASK
  #define CMASK(P0,P1,t) do{}while(0)
  for(;t+5<NT;t+=2){
    STEP(pB0,pB1,pA0,pA1,t,true,true,true);     WAIT_BAR(2); RESC(); ROT();
    STEP(pA0,pA1,pB0,pB1,t+1,true,true,true);   WAIT_BAR(2); RESC(); ROT();
  }
  #undef CMASK
  #define CMASK(P0,P1,t) do{int jb_=(t)-(NT-4); if(jb_>=0)cmask(P0,P1,jb_,qrel,hi);}while(0)
  #define ENDW(tt) do{ if((tt)+3<NT){WAIT_BAR(2);} else if((tt)+2<NT){WAIT_BAR(1);} else {WAIT_BAR(0);} }while(0)
  for(;t+1<NT;t+=2){
    STEP(pB0,pB1,pA0,pA1,t,(t+3<NT),(t+1<NT),(t+1<NT));       ENDW(t);   RESC(); ROT();
    STEP(pA0,pA1,pB0,pB1,t+1,(t+4<NT),(t+2<NT),(t+2<NT));     ENDW(t+1); RESC(); ROT();
  }
  STEP(pB0,pB1,pA0,pA1,NT-1,false,false,false); RESC();
  { float sacc=pB0[0]+pB0[1]; _Pragma("unroll") for(int r=2;r<16;++r)sacc+=pB0[r]; _Pragma("unroll") for(int r=0;r<16;++r)sacc+=pB1[r]; l_reg+=sacc;
    pw0=(u32x4){PKW(pB0,0),PKW(pB0,2),PKW(pB0,4),PKW(pB0,6)};pw1=(u32x4){PKW(pB0,8),PKW(pB0,10),PKW(pB0,12),PKW(pB0,14)};pw2=(u32x4){PKW(pB1,0),PKW(pB1,2),PKW(pB1,4),PKW(pB1,6)};pw3=(u32x4){PKW(pB1,8),PKW(pB1,10),PKW(pB1,12),PKW(pB1,14)};
    SBAR(); pv(o,vb0+sl_cur,PAF(0),PAF(1),PAF(2),PAF(3)); }
  #undef PKW
  #undef PAF
  #undef VFR
  #undef PIN
  #undef MX3
  #undef GAPA
  #undef GAPB
  #undef EX
  #undef VRD
  #undef KRD
  #undef STEP
  #undef ENDW
  {auto rr=__builtin_amdgcn_permlane32_swap(__float_as_uint(l_reg),__float_as_uint(l_reg),false,false);l_reg=__uint_as_float(rr[0])+__uint_as_float(rr[1]);}
  if(hi==0)wsf[32+r32]=l_reg;asm volatile("s_waitcnt lgkmcnt(0)":::"memory");
  float rli[16];
  #pragma unroll
  for(int r=0;r<16;++r)rli[r]=__builtin_amdgcn_rcpf(wsf[32+crow(r,hi)]);
  bf16*Ow=O+(rowbase+q0+wid*QBLK)*PO+h*D;
  { bf16*stg=(bf16*)(shm+LDS_OST)+wid*2048;
    #pragma unroll
    for(int r=0;r<16;++r){const int orow=crow(r,hi);
      #pragma unroll
      for(int d0=0;d0<2;++d0)stg[orow*64+d0*32+r32]=__float2bfloat16(o[d0][r]*rli[r]);}
    asm volatile("s_waitcnt lgkmcnt(0)":::"memory");
    #pragma unroll
    for(int i=0;i<4;++i){const int row=i*8+(lane>>3),ch=lane&7; const u32x4 v=*(const u32x4*)(stg+row*64+ch*8);
      float f[8]; _Pragma("unroll") for(int j=0;j<4;++j){ f[2*j]=__uint_as_float(v[j]<<16); f[2*j+1]=__uint_as_float(v[j]&0xffff0000u); }
      float ss=0.f; _Pragma("unroll") for(int j=0;j<8;++j)ss+=f[j]*f[j];
      ss+=__shfl_xor(ss,1); ss+=__shfl_xor(ss,2); ss+=__shfl_xor(ss,4);
      const float rs=__builtin_amdgcn_rsqf(ss*(1.0f/64.0f)+1e-5f);
      const f32x4_t g0=*(const f32x4_t*)(OG+h*D+ch*8), g1=*(const f32x4_t*)(OG+h*D+ch*8+4);
      u32x4 w; w[0]=cvtpk_s(f[0]*rs*g0[0],f[1]*rs*g0[1]); w[1]=cvtpk_s(f[2]*rs*g0[2],f[3]*rs*g0[3]); w[2]=cvtpk_s(f[4]*rs*g1[0],f[5]*rs*g1[1]); w[3]=cvtpk_s(f[6]*rs*g1[2],f[7]*rs*g1[3]);
      ATTN_STORE16(Ow+(long)row*PO+ch*8,w);} }
  asm volatile("s_waitcnt lgkmcnt(0)\n\ts_barrier":::"memory");
  #undef DMA_K
  #undef DMA_V
  #undef CMASK
  #undef START
  #undef RESC
  #undef ROT
  #undef BIAS
}
constexpr int ATTN_LDS_BYTES=LDS_BYTES;
struct AttnTensors { const bf16* Q; const bf16* K; const bf16* V; bf16* O; const float* CK; const float* OG; };
struct AttnUnit { int bh; int qb; };
struct StaticOrder {
  int vcu;
  __device__ __forceinline__ explicit StaticOrder(int grid,int block):vcu((block%8)*(grid/8)+block/8){}
  __device__ __forceinline__ bool next(int i,AttnUnit&u)const{ if(i>=4)return false; const int s=vcu&7; u.bh=vcu>>3; u.qb=(i==0)?s:(i==1)?15-s:(i==2)?16+s:31-s; return true; }
  __device__ __forceinline__ void a_ready(const AttnUnit&)const{}
  __device__ __forceinline__ void done(const AttnUnit&)const{}
};
template<class Sched,int THRL=8> __device__ __forceinline__ void attn_phase(char*lds,const AttnTensors&T,const Sched&S){
  AttnUnit u;
  for(int i=0;S.next(i,u);++i){ S.a_ready(u); attn_unit<THRL>(u.bh/NHEAD,u.bh%NHEAD,u.qb,T.Q,T.K,T.V,T.O,T.CK,T.OG,lds); S.done(u); }
}
#undef SBAR
#undef WAIT_BAR
}
constexpr int NWAVES = 8;
#ifndef MK_N_LAUNCHES
#define MK_N_LAUNCHES 1
#endif
constexpr int PER_PHASE = 10;
constexpr int N_LAUNCHES = MK_N_LAUNCHES;

constexpr int BATCH = 4, T = 8192, D = 1024, M = BATCH * T;
constexpr int IN_W = 3336, NU = 3328;
constexpr int RW = 512, NH = 8, HD = 64;
constexpr int C_R = 0, C_K = 512, C_V = 1024, C_WL = 1536, C_AL = 1600, C_GL = 1664, C_FQ = 1792, C_FK = 2304, C_FV = 2816;
constexpr int NE = 32, TOPK = 4, DFF = 1024, NH1 = 2 * DFF;
constexpr int NSLOTS = M * TOPK + NE * 256;
constexpr float RMS_EPS = 1e-5f, GN_EPS = 64e-5f;
constexpr float LOG2E = 1.4426950408889634f;

constexpr size_t MiB = 1u << 20;
constexpr size_t WS_CTL = 0, CTL_ZERO_BYTES = 1 * MiB;
constexpr size_t WS_WIN = 2 * MiB, WS_WOUT = 9 * MiB, WS_W1 = 12 * MiB, WS_W2 = 140 * MiB;
constexpr size_t WS_XN = 204 * MiB;
constexpr size_t WS_U = 268 * MiB;
constexpr size_t WS_MIX = 476 * MiB;
constexpr size_t WS_ACT = 268 * MiB;
constexpr size_t WS_Y2 = 540 * MiB;
constexpr size_t WS_LF = 812 * MiB, WS_CK = 813 * MiB;
constexpr size_t WS_ELIST = 814 * MiB;
constexpr size_t WS_TOKSLOT = 818 * MiB, WS_GATE = 819 * MiB;
constexpr size_t WS_RW_W = 820 * MiB, WS_RW_G = 884 * MiB, WS_RW_Y = 916 * MiB;
constexpr size_t WS_RW_R = 540 * MiB, WS_RW_K = 572 * MiB, WS_RW_V = 604 * MiB, WS_RW_KK = 636 * MiB, WS_RW_KA = 668 * MiB;
constexpr size_t WS_END = 980 * MiB;
constexpr int CW_TMO = 0, CW_CODE = 1;
constexpr int CW_BAR = 4096;
constexpr int CW_CNT = 8192;

constexpr int RING_OFF = 0, RING_BYTES = 131072;
constexpr int LDSCTL_OFF = RING_BYTES, MISC_OFF = LDSCTL_OFF + 320;
constexpr int LCNT_OFF = LDSCTL_OFF + 1024, LBASE_OFF = LCNT_OFF + 128, TPRE_OFF = LBASE_OFF + 128, ECNT_OFF = TPRE_OFF + 256;
constexpr int LDS_BYTES = 147456;
static_assert(ECNT_OFF + 128 <= LDS_BYTES, "LDS map");

#define GAS __attribute__((address_space(1)))
#define LAS __attribute__((address_space(3)))
typedef unsigned short bf16;
typedef unsigned v4u __attribute__((ext_vector_type(4)));
typedef float f32x4 __attribute__((ext_vector_type(4)));
typedef short bf16x8 __attribute__((ext_vector_type(8)));
typedef GAS unsigned gu32;
typedef GAS unsigned long long gu64;
#define RLX_AGENT __ATOMIC_RELAXED, __HIP_MEMORY_SCOPE_AGENT
#define LDS_WAIT() asm volatile("s_waitcnt lgkmcnt(0)" ::: "memory")
#define VM_WAIT() asm volatile("s_waitcnt vmcnt(0)" ::: "memory")
__device__ __forceinline__ unsigned long long rt() { return __builtin_amdgcn_s_memrealtime(); }
__device__ __forceinline__ unsigned f2bf(float f) { unsigned u = __builtin_bit_cast(unsigned, f); return (u + 0x7fffu + ((u >> 16) & 1u)) >> 16; }
__device__ __forceinline__ unsigned pk2(float lo, float hi) { return f2bf(lo) | (f2bf(hi) << 16); }

#define XB_TMO      128
#define XB_XCNT(j)  (256  + 64 * (j))
#define XB_XSUB(j)  (1280 + 64 * (j))
#define XB_XGEN(j)  (2304 + 64 * (j))
#define XB_TOP      3328
#define XB_TOPGEN   3392
#define XCD_BAR_WORDS 3456
#define XB_SPIN_CAP (1u << 18)

__device__ __forceinline__ unsigned xb_ld(unsigned* p)              { return __hip_atomic_load(p, __ATOMIC_RELAXED, __HIP_MEMORY_SCOPE_AGENT); }
__device__ __forceinline__ unsigned xb_add(unsigned* p, unsigned v) { return __hip_atomic_fetch_add(p, v, __ATOMIC_RELAXED, __HIP_MEMORY_SCOPE_AGENT); }
__device__ __forceinline__ unsigned xb_xcc_id() { return (unsigned)__builtin_amdgcn_s_getreg((3 << 11) | 20) & 0xFu; }
#define XB_SPIN(cond, bar) do { unsigned _sp = 0; while (cond) { __builtin_amdgcn_s_sleep(1); \
    if ((++_sp & 255u) == 0u) { if (xb_ld(&(bar)[XB_TMO])) break; if (_sp > XB_SPIN_CAP) { atomicAdd(&(bar)[XB_TMO], 1u); break; } } } } while (0)

struct XcdBarrier {
    unsigned* bar; unsigned x;
    volatile LAS unsigned* st;
};

__device__ __forceinline__ XcdBarrier xcd_barrier_post(unsigned* bar, volatile LAS unsigned* st) {
    XcdBarrier b; b.bar = bar; b.x = xb_xcc_id(); b.st = st;
    if (threadIdx.x == 0) (void)xb_add(&bar[XB_XCNT(b.x)], 1u);
    return b;
}
__device__ __forceinline__ void xcd_barrier_complete(unsigned* bar, unsigned x, unsigned& nloc, unsigned& nx) {
    const unsigned G = gridDim.x * gridDim.y * gridDim.z;
    unsigned sum, cnt, mine, sp = 0u;
    for (;;) {
        sum = 0u; cnt = 0u; mine = 0u;
#pragma unroll
        for (unsigned j = 0; j < 16; ++j) { const unsigned c = xb_ld(&bar[XB_XCNT(j)]); sum += c; cnt += (c > 0u) ? 1u : 0u; mine = (j == x) ? c : mine; }
        if (sum == G) break;
        __builtin_amdgcn_s_sleep(1);
        if ((++sp & 255u) == 0u) { if (xb_ld(&bar[XB_TMO])) break; if (sp > XB_SPIN_CAP) { atomicAdd(&bar[XB_TMO], 1u); break; } }
    }
    nloc = mine > 0u ? mine : 1u; nx = cnt > 0u ? cnt : 1u;
}

__device__ __forceinline__ void xcd_barrier(const XcdBarrier& b) {
    asm volatile("s_waitcnt vmcnt(0)" ::: "memory");
    __syncthreads();
    if (threadIdx.x == 0) {
        unsigned* bar = b.bar;
        __builtin_amdgcn_s_waitcnt(0);
        unsigned nloc = b.st[0], nx = b.st[1];
        if (nloc == 0u) { xcd_barrier_complete(bar, b.x, nloc, nx); b.st[0] = nloc; b.st[1] = nx; }
        const unsigned old = xb_add(&bar[XB_XSUB(b.x)], 1u);
        const unsigned gen = old / nloc;
        if (old + 1u == (gen + 1u) * nloc) {
            __builtin_amdgcn_fence(__ATOMIC_RELEASE, "agent");
            asm volatile("s_waitcnt vmcnt(0)" ::: "memory");
            const unsigned og = xb_add(&bar[XB_TOP], 1u);
            const unsigned tg = og / nx;
            if (og + 1u == (tg + 1u) * nx) xb_add(&bar[XB_TOPGEN], 1u);
            else XB_SPIN(xb_ld(&bar[XB_TOPGEN]) == tg, bar);
            __builtin_amdgcn_fence(__ATOMIC_ACQUIRE, "agent");
            xb_add(&bar[XB_XGEN(b.x)], 1u);
            asm volatile("s_waitcnt vmcnt(0)" ::: "memory");
        } else {
            XB_SPIN(xb_ld(&bar[XB_XGEN(b.x)]) == gen, bar);
            __builtin_amdgcn_fence(__ATOMIC_ACQUIRE, "agent");
            asm volatile("s_waitcnt vmcnt(0)" ::: "memory");
        }
    }
    __syncthreads();
}
struct Frame {
    LAS unsigned char* lds;
    volatile LAS unsigned* MISC;
    gu32* ctl;
    int tid, lane, wave;
    int vcu, G;
    const float* in[25];
    float* out; unsigned char* ws;
};
enum { I_X = 0, I_ANG, I_WIN, I_MU, I_W0, I_WUP, I_A0, I_AUP, I_GUP, I_KK, I_KA, I_RK, I_LNW, I_LNB, I_FB, I_OG, I_WOUT, I_FNG, I_RW, I_RB, I_W1, I_B1, I_W2, I_B2, I_FIN };

__device__ __forceinline__ float wave_sum(float v) {
#pragma unroll
    for (int o = 1; o < 64; o <<= 1) v += __shfl_xor(v, o);
    return v;
}
__device__ __forceinline__ float bf2f(bf16 b) { return __uint_as_float((unsigned)b << 16); }
__device__ __forceinline__ float sigmoidf_(float x) { return 1.0f / (1.0f + __expf(-x)); }

__device__ __forceinline__ void p0_transpose_item(const float* W, int K, int ldw, int ncols, bf16* WT, LAS float* scr, int item, int lane) {
    const int nblk = ncols / 32, kb = item / nblk, nb = item % nblk, k0 = 64 * kb, n0 = 32 * nb;
#pragma unroll 8
    for (int i = 0; i < 32; ++i) { const int kk = 2 * i + (lane >> 5); scr[kk * 33 + (lane & 31)] = W[(size_t)(k0 + kk) * ldw + n0 + (lane & 31)]; }
    LDS_WAIT(); asm volatile("" ::: "memory");
    const int c = lane & 7;
#pragma unroll
    for (int j = 0; j < 4; ++j) { const int n = (lane >> 3) + 8 * j; const LAS float* s = scr + (8 * c) * 33 + n;
        v4u o; o.x = pk2(s[0 * 33], s[1 * 33]); o.y = pk2(s[2 * 33], s[3 * 33]); o.z = pk2(s[4 * 33], s[5 * 33]); o.w = pk2(s[6 * 33], s[7 * 33]);
        *(GAS v4u*)(WT + (size_t)(n0 + n) * K + k0 + 8 * c) = o; }
    LDS_WAIT(); asm volatile("" ::: "memory");
}

__device__ __forceinline__ void p0_prologue(Frame& F) {
    LAS float* scr = (LAS float*)(F.lds + RING_OFF + F.wave * 16384);
    const int gw = F.vcu * NWAVES + F.wave, NGW = F.G * NWAVES;
    constexpr int I_IN = (D / 64) * (NU / 32), I_O = (D / 64) * (D / 32), I_1 = (D / 64) * (NH1 / 32), I_2 = (DFF / 64) * (D / 32);
    constexpr int NITEMS = I_IN + I_O + NE * I_1 + NE * I_2;
    bf16* WIN_T = (bf16*)(F.ws + WS_WIN); bf16* WOUT_T = (bf16*)(F.ws + WS_WOUT); bf16* W1_T = (bf16*)(F.ws + WS_W1); bf16* W2_T = (bf16*)(F.ws + WS_W2);
    for (int it = gw; it < NITEMS; it += NGW) {
        int r = it;
        if (r < I_IN) { p0_transpose_item(F.in[I_WIN], D, IN_W, NU, WIN_T, scr, r, F.lane); continue; } r -= I_IN;
        if (r < I_O) { p0_transpose_item(F.in[I_WOUT], D, D, D, WOUT_T, scr, r, F.lane); continue; } r -= I_O;
        if (r < NE * I_1) { const int e = r / I_1; p0_transpose_item(F.in[I_W1] + (size_t)e * D * NH1, D, NH1, NH1, W1_T + (size_t)e * NH1 * D, scr, r % I_1, F.lane); continue; } r -= NE * I_1;
        { const int e = r / I_2; p0_transpose_item(F.in[I_W2] + (size_t)e * DFF * D, DFF, D, D, W2_T + (size_t)e * D * DFF, scr, r % I_2, F.lane); }
    }
    __syncthreads();
    LAS float* wfl = (LAS float*)(F.lds + RING_OFF);
    for (int k = F.tid; k < D; k += NWAVES * 64) {
#pragma unroll
        for (int j = 0; j < 8; ++j) wfl[j * D + k] = F.in[I_WIN][(size_t)k * IN_W + NU + j];
    }
    __syncthreads();
    bf16* XN = (bf16*)(F.ws + WS_XN); float* LF = (float*)(F.ws + WS_LF);
    const float* g = F.in[I_ANG];
    for (int m = gw; m < M; m += NGW) {
        const GAS f32x4* xr = (const GAS f32x4*)(F.in[I_X] + (size_t)m * D) + F.lane;
        f32x4 v[4]; float s2 = 0.f;
#pragma unroll
        for (int j = 0; j < 4; ++j) { v[j] = xr[64 * j]; s2 += (v[j].x * v[j].x + v[j].y * v[j].y) + (v[j].z * v[j].z + v[j].w * v[j].w); }
        const float rstd = 1.f / sqrtf(wave_sum(s2) * (1.f / D) + RMS_EPS);
        GAS unsigned long long* o8 = (GAS unsigned long long*)(XN + (size_t)m * D) + F.lane;
        float fl[8];
#pragma unroll
        for (int j = 0; j < 8; ++j) fl[j] = 0.f;
#pragma unroll
        for (int j = 0; j < 4; ++j) { const f32x4 gv = *(const f32x4*)(g + 4 * F.lane + 256 * j); v[j] = v[j] * rstd * gv;
            o8[64 * j] = (unsigned long long)pk2(v[j].x, v[j].y) | ((unsigned long long)pk2(v[j].z, v[j].w) << 32);
#pragma unroll
            for (int q = 0; q < 8; ++q) { const f32x4 w = *(const LAS f32x4*)(wfl + q * D + 4 * F.lane + 256 * j); fl[q] += (v[j].x * w.x + v[j].y * w.y) + (v[j].z * w.z + v[j].w * w.w); } }
        float mine = 0.f;
#pragma unroll
        for (int q = 0; q < 8; ++q) { const float s = wave_sum(fl[q]); if (F.lane == q) mine = s; }
        if (F.lane < 8) { const float z = mine + F.in[I_FB][F.lane]; const float ls = fminf(z, 0.f) - log1pf(__expf(-fabsf(z)));
            const int b = m / T, t = m % T; LF[(size_t)(b * NH + F.lane) * T + t] = ls * LOG2E; }
    }
}

__device__ __forceinline__ void p2_cumsum(Frame& F, int bh) {
    const float* lf = (const float*)(F.ws + WS_LF) + (size_t)bh * T; float* ck = (float*)(F.ws + WS_CK) + (size_t)bh * T;
    const int t0 = F.lane * 128; double run = 0.0;
    for (int i = 0; i < 128; ++i) run += (double)lf[t0 + i];
    double incl = run;
#pragma unroll
    for (int o = 1; o < 64; o <<= 1) { const double n = __shfl_up(incl, o); if (F.lane >= o) incl += n; }
    double acc = incl - run;
    for (int i = 0; i < 128; ++i) { acc += (double)lf[t0 + i]; ck[t0 + i] = (float)acc; }
}

__device__ __forceinline__ void p2_rwkv_prep_naive(Frame& F) {
    LAS float* lin = (LAS float*)(F.lds + RING_OFF);
    const bf16* U = (const bf16*)(F.ws + WS_U);
    bf16* Rr = (bf16*)(F.ws + WS_RW_R); bf16* Kr = (bf16*)(F.ws + WS_RW_K); bf16* Vr = (bf16*)(F.ws + WS_RW_V); bf16* KKr = (bf16*)(F.ws + WS_RW_KK); bf16* KAr = (bf16*)(F.ws + WS_RW_KA);
    float* Wr = (float*)(F.ws + WS_RW_W); bf16* Gr = (bf16*)(F.ws + WS_RW_G);
    const float* mu = F.in[I_MU];
    const int c = F.tid;
    const float w0 = F.in[I_W0][c], a0 = F.in[I_A0][c], k_k = F.in[I_KK][c], k_a = F.in[I_KA][c];
    const float mu_r = mu[C_R + c], mu_k = mu[C_K + c], mu_v = mu[C_V + c];
    for (int blk = F.vcu; blk < M / 128; blk += F.G)
    for (int m0 = blk * 128; m0 < blk * 128 + 128; m0 += 8) {
        for (int q = F.tid; q < 2048; q += NWAVES * 64) { const int tk = q >> 8, j = q & 255, m = m0 + tk, col = C_WL + j;
            const float u = bf2f(U[(size_t)m * NU + col]); const float up = (m % T == 0) ? 0.f : bf2f(U[(size_t)(m - 1) * NU + col]); const float us = u + (up - u) * mu[col];
            lin[tk * 256 + j] = j < 64 ? tanhf(us) : (j < 128 ? us : sigmoidf_(us)); }
        __syncthreads();
        float zw[8], za[8], gg[8];
#pragma unroll
        for (int tk = 0; tk < 8; ++tk) { zw[tk] = w0; za[tk] = a0; gg[tk] = 0.f; }
        for (int j = 0; j < 64; ++j) { const float wv = F.in[I_WUP][j * RW + c], av = F.in[I_AUP][j * RW + c];
#pragma unroll
            for (int tk = 0; tk < 8; ++tk) { zw[tk] += lin[tk * 256 + j] * wv; za[tk] += lin[tk * 256 + 64 + j] * av; } }
        for (int j = 0; j < 128; ++j) { const float gv = F.in[I_GUP][j * RW + c];
#pragma unroll
            for (int tk = 0; tk < 8; ++tk) gg[tk] += lin[tk * 256 + 128 + j] * gv; }
#pragma unroll
        for (int tk = 0; tk < 8; ++tk) { const int m = m0 + tk; const bool first = (m % T == 0);
            const bf16* ur = U + (size_t)m * NU; const bf16* up = ur - NU;
            float r = bf2f(ur[C_R + c]), k = bf2f(ur[C_K + c]), v = bf2f(ur[C_V + c]);
            const float rp = first ? 0.f : bf2f(up[C_R + c]), kp = first ? 0.f : bf2f(up[C_K + c]), vp = first ? 0.f : bf2f(up[C_V + c]);
            r += (rp - r) * mu_r; k += (kp - k) * mu_k; v += (vp - v) * mu_v;
            float kk = k * k_k; const float ss = wave_sum(kk * kk); kk = kk / fmaxf(sqrtf(ss), 1e-12f);
            const float a = sigmoidf_(za[tk]); const float lw = -0.6065306597126334f * sigmoidf_(zw[tk]); const float w = __expf(lw);
            const float k2 = k * (1.0f + (a - 1.0f) * k_a);
            const size_t o = (size_t)m * RW + c;
            Rr[o] = (bf16)f2bf(r); Kr[o] = (bf16)f2bf(k2); Vr[o] = (bf16)f2bf(v); KKr[o] = (bf16)f2bf(kk); KAr[o] = (bf16)f2bf(kk * a); Wr[o] = w; Gr[o] = (bf16)f2bf(gg[tk]); }
        __syncthreads();
    }
}

__device__ __forceinline__ void p3_rwkv_scan_naive(Frame& F, int bh) {
    const int b = bh / NH, h = bh % NH, lane = F.lane;
    LAS float* sh = (LAS float*)(F.lds + RING_OFF + F.wave * 16384);
    const bf16* Rr = (const bf16*)(F.ws + WS_RW_R); const bf16* Kr = (const bf16*)(F.ws + WS_RW_K); const bf16* Vr = (const bf16*)(F.ws + WS_RW_V); const bf16* KKr = (const bf16*)(F.ws + WS_RW_KK); const bf16* KAr = (const bf16*)(F.ws + WS_RW_KA);
    const float* Wr = (const float*)(F.ws + WS_RW_W); float* Yr = (float*)(F.ws + WS_RW_Y);
    float s[64];
#pragma unroll
    for (int j = 0; j < 64; ++j) s[j] = 0.f;
    const size_t base = (size_t)b * T * RW + h * HD + lane;
    float nr[8], nw[8], nk[8], nkk[8], nka[8], nv[8];
#pragma unroll
    for (int tk = 0; tk < 8; ++tk) { const size_t o = base + (size_t)tk * RW; nr[tk] = bf2f(Rr[o]); nw[tk] = Wr[o]; nk[tk] = bf2f(Kr[o]); nkk[tk] = bf2f(KKr[o]); nka[tk] = bf2f(KAr[o]); nv[tk] = bf2f(Vr[o]); }
    for (int t0 = 0; t0 < T; t0 += 8) {
#pragma unroll
        for (int tk = 0; tk < 8; ++tk) { sh[(tk * 6 + 0) * 64 + lane] = nr[tk]; sh[(tk * 6 + 1) * 64 + lane] = nw[tk]; sh[(tk * 6 + 2) * 64 + lane] = nk[tk]; sh[(tk * 6 + 3) * 64 + lane] = nkk[tk]; sh[(tk * 6 + 4) * 64 + lane] = nka[tk]; sh[(tk * 6 + 5) * 64 + lane] = nv[tk]; }
        if (t0 + 8 < T) {
#pragma unroll
            for (int tk = 0; tk < 8; ++tk) { const size_t o = base + (size_t)(t0 + 8 + tk) * RW; nr[tk] = bf2f(Rr[o]); nw[tk] = Wr[o]; nk[tk] = bf2f(Kr[o]); nkk[tk] = bf2f(KKr[o]); nka[tk] = bf2f(KAr[o]); nv[tk] = bf2f(Vr[o]); }
        }
        LDS_WAIT(); asm volatile("" ::: "memory");
#pragma unroll 1
        for (int tk = 0; tk < 8; ++tk) {
            const LAS f32x4* pr = (const LAS f32x4*)(sh + (tk * 6 + 0) * 64); const LAS f32x4* pw = (const LAS f32x4*)(sh + (tk * 6 + 1) * 64); const LAS f32x4* pk = (const LAS f32x4*)(sh + (tk * 6 + 2) * 64);
            const LAS f32x4* pkk = (const LAS f32x4*)(sh + (tk * 6 + 3) * 64); const LAS f32x4* pka = (const LAS f32x4*)(sh + (tk * 6 + 4) * 64);
            float sa = 0.f;
#pragma unroll
            for (int q = 0; q < 16; ++q) { const f32x4 kk4 = pkk[q]; sa += (s[4 * q] * kk4.x + s[4 * q + 1] * kk4.y) + (s[4 * q + 2] * kk4.z + s[4 * q + 3] * kk4.w); }
            const float v = sh[(tk * 6 + 5) * 64 + lane]; float y = 0.f;
#pragma unroll
            for (int q = 0; q < 16; ++q) { const f32x4 w4 = pw[q], k4 = pk[q], ka4 = pka[q], r4 = pr[q];
                s[4 * q] = s[4 * q] * w4.x + (v * k4.x - sa * ka4.x); s[4 * q + 1] = s[4 * q + 1] * w4.y + (v * k4.y - sa * ka4.y);
                s[4 * q + 2] = s[4 * q + 2] * w4.z + (v * k4.z - sa * ka4.z); s[4 * q + 3] = s[4 * q + 3] * w4.w + (v * k4.w - sa * ka4.w);
                y += (s[4 * q] * r4.x + s[4 * q + 1] * r4.y) + (s[4 * q + 2] * r4.z + s[4 * q + 3] * r4.w); }
            Yr[base + (size_t)(t0 + tk) * RW] = y;
        }
        asm volatile("" ::: "memory"); LDS_WAIT();
    }
}

__device__ __forceinline__ void p4_rwkv_out_naive(Frame& F) {
    const int gw = F.vcu * NWAVES + F.wave, NGW = F.G * NWAVES, lane = F.lane;
    const bf16* Rr = (const bf16*)(F.ws + WS_RW_R); const bf16* Kr = (const bf16*)(F.ws + WS_RW_K); const bf16* Vr = (const bf16*)(F.ws + WS_RW_V); const bf16* Gr = (const bf16*)(F.ws + WS_RW_G);
    const float* Yr = (const float*)(F.ws + WS_RW_Y); bf16* MIX = (bf16*)(F.ws + WS_MIX);
    for (int it = gw; it < M * NH; it += NGW) { const int m = it / NH, h = it % NH, c = h * HD + lane; const size_t o = (size_t)m * RW + c;
        const float y = Yr[o]; const float mean = wave_sum(y) * (1.f / HD); const float d = y - mean; const float var = wave_sum(d * d) * (1.f / HD);
        const float yn = d * (1.0f / sqrtf(var + GN_EPS)) * F.in[I_LNW][c] + F.in[I_LNB][c];
        const float r = bf2f(Rr[o]), k = bf2f(Kr[o]), v = bf2f(Vr[o]), g = bf2f(Gr[o]);
        const float bonus = wave_sum(r * k * F.in[I_RK][c]) * v;
        MIX[(size_t)m * D + c] = (bf16)f2bf((yn + bonus) * g); }
}

__device__ __forceinline__ void p6_route(Frame& F) {
    LAS float* rwl = (LAS float*)(F.lds + RING_OFF);
    LAS unsigned* lcnt = (LAS unsigned*)(F.lds + LCNT_OFF); LAS unsigned* lbase = (LAS unsigned*)(F.lds + LBASE_OFF);
    const float* X1 = F.out; bf16* XN = (bf16*)(F.ws + WS_XN); const float* g2 = F.in[I_FNG];
    int* ELIST = (int*)(F.ws + WS_ELIST); int* TOKSLOT = (int*)(F.ws + WS_TOKSLOT); float* GATE = (float*)(F.ws + WS_GATE);
    const int lane = F.lane;
    for (int i = F.tid; i < D * 8; i += NWAVES * 64) { const int k = i >> 3, ch = i & 7; const f32x4 v = *(const f32x4*)(F.in[I_RW] + (size_t)k * NE + ch * 4); *(LAS f32x4*)(rwl + (k * 8 + (ch ^ (k & 7))) * 4) = v; }
    if (F.tid < NE) lcnt[F.tid] = 0u;
    __syncthreads();
    for (int blk = F.vcu; blk < M / 128; blk += F.G) {
        int pe = 0, ptok = 0; float pg = 0.f;
        for (int j = 0; j < 16; ++j) { const int m = blk * 128 + F.wave * 16 + j;
            float ss = 0.f;
#pragma unroll
            for (int i = 0; i < 16; ++i) { const float x = X1[(size_t)m * D + lane + 64 * i]; ss += x * x; }
            const float rstd = 1.f / sqrtf(wave_sum(ss) * (1.f / D) + RMS_EPS);
            float acc[NE];
#pragma unroll
            for (int e = 0; e < NE; ++e) acc[e] = 0.f;
#pragma unroll 1
            for (int i = 0; i < 16; ++i) { const int k = lane + 64 * i; const float xn = X1[(size_t)m * D + k] * rstd * g2[k]; XN[(size_t)m * D + k] = (bf16)f2bf(xn);
#pragma unroll
                for (int ch = 0; ch < 8; ++ch) { const f32x4 w = *(const LAS f32x4*)(rwl + (k * 8 + (ch ^ (k & 7))) * 4);
                    acc[4 * ch] += xn * w.x; acc[4 * ch + 1] += xn * w.y; acc[4 * ch + 2] += xn * w.z; acc[4 * ch + 3] += xn * w.w; } }
#pragma unroll
            for (int e = 0; e < NE; ++e) acc[e] = wave_sum(acc[e]) + F.in[I_RB][e];
            float tv[4]; int ti[4];
#pragma unroll
            for (int kk = 0; kk < 4; ++kk) { float best = -INFINITY; int bi = 0;
#pragma unroll
                for (int e = 0; e < NE; ++e) { if (acc[e] > best) { best = acc[e]; bi = e; } }
                tv[kk] = best; ti[kk] = bi;
#pragma unroll
                for (int e = 0; e < NE; ++e) acc[e] = (e == bi) ? -INFINITY : acc[e]; }
            const float e0 = 1.f, e1 = __expf(tv[1] - tv[0]), e2 = __expf(tv[2] - tv[0]), e3 = __expf(tv[3] - tv[0]); const float inv = 1.f / (e0 + e1 + e2 + e3);
            if ((lane >> 2) == j) { const int kk = lane & 3; pe = kk == 0 ? ti[0] : kk == 1 ? ti[1] : kk == 2 ? ti[2] : ti[3]; pg = (kk == 0 ? e0 : kk == 1 ? e1 : kk == 2 ? e2 : e3) * inv; ptok = m; }
        }
        const unsigned lpos = atomicAdd((unsigned*)(lcnt + pe), 1u);
        __syncthreads();
        if (F.tid < NE) { const unsigned n = lcnt[F.tid]; lbase[F.tid] = n ? __hip_atomic_fetch_add((unsigned*)(F.ctl + CW_CNT + 64 * F.tid), n, RLX_AGENT) : 0u; }
        __syncthreads();
        const unsigned p = lbase[pe] + lpos;
        ELIST[(size_t)pe * M + p] = ptok; TOKSLOT[ptok * 4 + (lane & 3)] = (pe << 16) | (int)p; GATE[ptok * 4 + (lane & 3)] = pg;
        __syncthreads();
        if (F.tid < NE) lcnt[F.tid] = 0u;
        __syncthreads();
    }
}

__device__ __forceinline__ void moe_prefix(Frame& F) {
    LAS int* tpre = (LAS int*)(F.lds + TPRE_OFF); LAS int* ecnt = (LAS int*)(F.lds + ECNT_OFF);
    if (F.tid < NE) ecnt[F.tid] = (int)__hip_atomic_load((unsigned*)(F.ctl + CW_CNT + 64 * F.tid), RLX_AGENT);
    __syncthreads();
    if (F.tid == 0) { int run = 0; for (int e = 0; e < NE; ++e) { tpre[e] = run; run += (ecnt[e] + 255) >> 8; } tpre[NE] = run; }
    __syncthreads();
}
struct MoeOrder {
    const LAS int* tpre; const LAS int* ecnt; int nN, G, c;
    __device__ __forceinline__ bool next(int i, pg8::Unit& u) const {
        const int L = i * G + c; const int ntl = __builtin_amdgcn_readfirstlane(tpre[NE]); if (L >= ntl * nN) return false;
        const int pm = L / nN; int e = 0;
        for (int j = 1; j < NE; ++j) { if (__builtin_amdgcn_readfirstlane(tpre[j]) <= pm) e = j; }
        u.pm = pm; u.pn = L % nN; u.e = e; u.l0 = (pm - __builtin_amdgcn_readfirstlane(tpre[e])) * 256; u.cnt = __builtin_amdgcn_readfirstlane(ecnt[e]); return true;
    }
    __device__ __forceinline__ void a_ready(const pg8::Unit&) const {}
    __device__ __forceinline__ void done(const pg8::Unit&) const {}
};

__device__ __forceinline__ void p9_final(Frame& F) {
    const int gw = F.vcu * NWAVES + F.wave, NGW = F.G * NWAVES, lane = F.lane;
    const LAS int* tpre = (const LAS int*)(F.lds + TPRE_OFF);
    const bf16* Y2 = (const bf16*)(F.ws + WS_Y2); const int* TOKSLOT = (const int*)(F.ws + WS_TOKSLOT); const float* GATE = (const float*)(F.ws + WS_GATE);
    const float* gf = F.in[I_FIN];
    for (int m = gw; m < M; m += NGW) {
        GAS f32x4* xr = (GAS f32x4*)(F.out + (size_t)m * D) + lane;
        f32x4 v[4];
#pragma unroll
        for (int j = 0; j < 4; ++j) v[j] = xr[64 * j];
#pragma unroll
        for (int k = 0; k < 4; ++k) { const int ts = TOKSLOT[m * 4 + k]; const float gt = GATE[m * 4 + k]; const int e = ts >> 16, p = ts & 0xffff;
            const size_t row = (size_t)tpre[e] * 256 + p; const GAS unsigned long long* yr = (const GAS unsigned long long*)(Y2 + row * D) + lane;
#pragma unroll
            for (int j = 0; j < 4; ++j) { const unsigned long long w = yr[64 * j]; const unsigned lo = (unsigned)w, hi = (unsigned)(w >> 32);
                v[j].x += gt * __uint_as_float(lo << 16); v[j].y += gt * __uint_as_float(lo & 0xffff0000u); v[j].z += gt * __uint_as_float(hi << 16); v[j].w += gt * __uint_as_float(hi & 0xffff0000u); } }
        float s2 = 0.f;
#pragma unroll
        for (int j = 0; j < 4; ++j) s2 += (v[j].x * v[j].x + v[j].y * v[j].y) + (v[j].z * v[j].z + v[j].w * v[j].w);
        const float rstd = 1.f / sqrtf(wave_sum(s2) * (1.f / D) + RMS_EPS);
#pragma unroll
        for (int j = 0; j < 4; ++j) { const f32x4 gv = *(const f32x4*)(gf + 4 * lane + 256 * j); xr[64 * j] = v[j] * rstd * gv; }
    }
}

struct Args { const float* in[25]; float* out; unsigned char* ws; int ph_lo, ph_hi, li, pad; };
__global__ void __launch_bounds__(NWAVES * 64, 2) mk_fwd(Args args) {
    extern __shared__ __attribute__((aligned(16))) unsigned char lds[];
    Frame F;
    F.lds = (LAS unsigned char*)lds;
    F.MISC = (volatile LAS unsigned*)(F.lds + MISC_OFF);
    F.tid = threadIdx.x; F.lane = F.tid & 63; F.wave = __builtin_amdgcn_readfirstlane(F.tid >> 6);
    F.G = gridDim.x; { const int bx = blockIdx.x; F.vcu = (F.G % 8 == 0) ? (bx % 8) * (F.G / 8) + bx / 8 : bx; }
#pragma unroll
    for (int i = 0; i < 25; ++i) F.in[i] = args.in[i];
    F.out = args.out; F.ws = args.ws; F.ctl = (gu32*)(args.ws + WS_CTL);
    for (int u = F.tid; u < (LDS_BYTES - LDSCTL_OFF) / 4; u += NWAVES * 64) ((LAS unsigned*)(F.lds + LDSCTL_OFF))[u] = 0u;
    __syncthreads();
    XcdBarrier bar; bar.bar = (unsigned*)(F.ctl + CW_BAR); bar.x = 0; bar.st = nullptr;
    if (N_LAUNCHES != PER_PHASE) bar = xcd_barrier_post((unsigned*)(F.ctl + CW_BAR), F.MISC + 8);
#define GRID_BAR(seam) do { if (N_LAUNCHES == PER_PHASE) { if (F.tid == 0) __hip_atomic_store(F.ctl + CW_TMO, 0xBADBA0u | (unsigned)(seam), RLX_AGENT); } else { xcd_barrier(bar); } } while (0)
    const int lo = args.ph_lo, hi = args.ph_hi;
#define IN(k) (lo <= (k) && (k) < hi)
#define BOTH(k) (IN(k) && IN((k) + 1))
    bf16* WIN_T = (bf16*)(F.ws + WS_WIN); bf16* WOUT_T = (bf16*)(F.ws + WS_WOUT); bf16* W1_T = (bf16*)(F.ws + WS_W1); bf16* W2_T = (bf16*)(F.ws + WS_W2);
    bf16* XN = (bf16*)(F.ws + WS_XN); bf16* U = (bf16*)(F.ws + WS_U); bf16* MIX = (bf16*)(F.ws + WS_MIX); bf16* ACT = (bf16*)(F.ws + WS_ACT); bf16* Y2 = (bf16*)(F.ws + WS_Y2);

    if (IN(0)) { p0_prologue(F); if (BOTH(0)) GRID_BAR(0); }

    if (IN(1)) {
        pg8::Gemm g{XN, WIN_T, D, 0, nullptr, 0}; pg8::StaticOrder S; S.init(M, NU, F.G, (int)blockIdx.x);
        pg8::EpiU E{U, NU, C_FQ / 256, C_FK / 256, attn_body::C2};
        pg8::gemm_phase<pg8::EpiU, pg8::StaticOrder, false, PG8_ALIGN, PG8_SP2>(F.lds + RING_OFF, g, S, E);
        if (BOTH(1)) GRID_BAR(1);
    }

    if (IN(2)) {
        if (F.wave == 0 && F.vcu < BATCH * NH) p2_cumsum(F, F.vcu);
        p2_rwkv_prep_naive(F);
        if (BOTH(2)) GRID_BAR(2);
    }

    if (IN(3)) {
        const attn_body::AttnTensors AT{(const attn_body::bf16*)(U + C_FQ), (const attn_body::bf16*)(U + C_FK), (const attn_body::bf16*)(U + C_FV), (attn_body::bf16*)(MIX + RW),
                                        (const float*)(F.ws + WS_CK), F.in[I_OG]};
        const attn_body::StaticOrder S((int)F.G, (int)blockIdx.x);
        attn_body::attn_phase<attn_body::StaticOrder>((char*)lds + RING_OFF, AT, S);
        if (F.wave == 0 && F.vcu < BATCH * NH) p3_rwkv_scan_naive(F, F.vcu);
        if (BOTH(3)) GRID_BAR(3);
    }

    if (IN(4)) { p4_rwkv_out_naive(F); if (BOTH(4)) GRID_BAR(4); }

    if (IN(5)) {
        pg8::Gemm g{MIX, WOUT_T, D, 0, nullptr, 0}; pg8::StaticOrder S; S.init(M, D, F.G, (int)blockIdx.x);
        pg8::EpiRes E{F.in[I_X], F.out, D};
        pg8::gemm_phase<pg8::EpiRes, pg8::StaticOrder, false, PG8_ALIGN, PG8_SP2>(F.lds + RING_OFF, g, S, E);
        if (BOTH(5)) GRID_BAR(5);
    }

    if (IN(6)) { p6_route(F); if (BOTH(6)) GRID_BAR(6); }

    if (IN(7)) {
        moe_prefix(F);
        pg8::Gemm g{XN, W1_T, D, (size_t)NH1 * D, (const int*)(F.ws + WS_ELIST), M};
        MoeOrder S{(const LAS int*)(F.lds + TPRE_OFF), (const LAS int*)(F.lds + ECNT_OFF), NH1 / 256, F.G, (int)blockIdx.x};
        pg8::EpiSwiglu E{ACT, DFF, F.in[I_B1], NH1};
        pg8::gemm_phase<pg8::EpiSwiglu, MoeOrder, true, PG8_ALIGN, PG8_SP2>(F.lds + RING_OFF, g, S, E);
        if (BOTH(7)) GRID_BAR(7);
    }

    if (IN(8)) {
        if (!IN(7)) moe_prefix(F);
        pg8::Gemm g{ACT, W2_T, DFF, (size_t)D * DFF, nullptr, 0};
        MoeOrder S{(const LAS int*)(F.lds + TPRE_OFF), (const LAS int*)(F.lds + ECNT_OFF), D / 256, F.G, (int)blockIdx.x};
        pg8::EpiBias E{Y2, D, F.in[I_B2], D};
        pg8::gemm_phase<pg8::EpiBias, MoeOrder, false, PG8_ALIGN, PG8_SP2>(F.lds + RING_OFF, g, S, E);
        if (BOTH(8)) GRID_BAR(8);
    }

    if (IN(9)) { if (!IN(8)) moe_prefix(F); p9_final(F); }
#undef IN
#undef BOTH
}

extern "C" void kernel_launch(void* const* d_in, const int* in_sizes, int n_in, void* d_out, int out_size, void* d_ws, size_t ws_size, hipStream_t stream) {
    static int grid = 0;
    if (grid == 0) {
        if (n_in != 25 || in_sizes[0] != M * D || out_size != M * D || ws_size < WS_END) { fprintf(stderr, "kernel_launch: unexpected shapes (n_in %d, in0 %d, out %d, ws %zu); nothing launched\n", n_in, n_in > 0 ? in_sizes[0] : -1, out_size, ws_size); grid = -1; return; }
        int dev = 0, cus = 0, per_cu = 0;
        if (hipGetDevice(&dev) != hipSuccess || hipDeviceGetAttribute(&cus, hipDeviceAttributeMultiprocessorCount, dev) != hipSuccess) { grid = -1; return; }
        if (hipFuncSetAttribute((const void*)mk_fwd, hipFuncAttributeMaxDynamicSharedMemorySize, LDS_BYTES) != hipSuccess) { fprintf(stderr, "kernel_launch: hipFuncSetAttribute failed\n"); grid = -1; return; }
        if (hipOccupancyMaxActiveBlocksPerMultiprocessor(&per_cu, (const void*)mk_fwd, NWAVES * 64, LDS_BYTES) != hipSuccess || per_cu < 1) fprintf(stderr, "kernel_launch: occupancy query reports %d\n", per_cu);
        (void)hipGetLastError();
        grid = cus;
        if (grid != 256) { fprintf(stderr, "kernel_launch: built for 256 CUs, found %d\n", grid); }
    }
    if (grid < 0) return;
    if (hipMemsetAsync((char*)d_ws + WS_CTL, 0, CTL_ZERO_BYTES, stream) != hipSuccess) return;
    Args a{};
    for (int i = 0; i < 25; ++i) a.in[i] = (const float*)d_in[i];
    a.out = (float*)d_out; a.ws = (unsigned char*)d_ws;
    for (int li = 0; li < N_LAUNCHES; ++li) {
        a.ph_lo = (N_LAUNCHES == PER_PHASE) ? li : 0; a.ph_hi = (N_LAUNCHES == PER_PHASE) ? li + 1 : PER_PHASE; a.li = li;
        hipLaunchKernelGGL(mk_fwd, dim3(grid), dim3(NWAVES * 64), LDS_BYTES, stream, a);
    }
}
```

```cpp
#ifndef DUP_MASK
#define DUP_MASK 0
#endif
#define DUPN(k) (((DUP_MASK) >> (k)) & 1 ? 2 : 1)
#ifndef TS_PROBE
#define TS_PROBE (-1)
#endif
#define TS_MULT 4
#include <hip/hip_runtime.h>
#include <cstdio>
#include <cstdint>
namespace pg8 {
#define PG8_LAS __attribute__((address_space(3)))
typedef unsigned short bf16_t;
typedef short bf16x8 __attribute__((ext_vector_type(8)));
typedef float f32x4 __attribute__((ext_vector_type(4)));
typedef unsigned u32x4 __attribute__((ext_vector_type(4)));
typedef int i32x4 __attribute__((ext_vector_type(4)));
typedef int i32x8 __attribute__((ext_vector_type(8)));
constexpr int BM = 256, BK = 64, HALF = 128, HTB = HALF * BK * 2  , STAGE_BYTES = 8 * HTB, NXCD = 8, WGM = 8;

__host__ __device__ __forceinline__ int lds_byte(int r, int c) { const int st = (r >> 4) * 2 + (c >> 5), rr = r & 15, cc = c & 31, ob = rr * 64 + cc * 2; return st * 1024 + (ob ^ (((ob >> 9) & 1) << 5)); }
__host__ __device__ __forceinline__ void stage_rc(int b, int& R, int& C) { const int st = b / 1024, sb = b % 1024, swz = sb ^ (((sb >> 9) & 1) << 5); R = (st >> 1) * 16 + swz / 64; C = (st & 1) * 32 + (swz % 64) / 2; }
__host__ __device__ __forceinline__ int perm32(int rho) { const int n = rho >> 4, i = rho & 15; return 8 * (i >> 2) + 4 * n + (i & 3); }

struct Unit { int pm, pn, e, l0, cnt; };
struct Gemm { const bf16_t* A; const bf16_t* Bt; int K; size_t bstride; const int* rows; int rows_stride; };

struct StaticOrder {
    int nM, nN, nwg, G, c;
    __host__ __device__ void init(int M, int N, int G_, int c_) { nM = M / BM; nN = N / BM; nwg = nM * nN; G = G_; c = c_; }
    __host__ __device__ bool next(int i, Unit& u) const {
        const long L = (long)i * G + c; if (L >= nwg) return false;
        int wgid = (int)L; { const int q = nwg / NXCD, r = nwg % NXCD, xcd = wgid % NXCD, off = wgid / NXCD; wgid = (xcd < r ? xcd * (q + 1) : r * (q + 1) + (xcd - r) * q) + off; }
        const int nig = WGM * nN, gid = wgid / nig, fm = gid * WGM, gsz = (nM - fm) < WGM ? (nM - fm) : WGM;
        u.pm = fm + ((wgid % nig) % gsz); u.pn = (wgid % nig) / gsz; u.e = 0; u.l0 = 0; u.cnt = 256; return true;
    }
    __device__ __forceinline__ void a_ready(const Unit&) const {}
    __device__ __forceinline__ void done(const Unit&) const {}
};

__device__ __forceinline__ unsigned cvt_pk_bf16(float lo, float hi) { unsigned r; asm volatile("v_cvt_pk_bf16_f32 %0, %1, %2" : "=v"(r) : "v"(lo), "v"(hi)); return r; }
typedef float f32x2 __attribute__((ext_vector_type(2)));
typedef unsigned u32x2 __attribute__((ext_vector_type(2)));
struct EpiU {
    static constexpr bool PERM = true, AFTER_DRAIN = false;
    bf16_t* O; int ldc; int q_lo, q_hi; float qscale;
    __device__ __forceinline__ void operator()(const f32x4 (&acc)[2][2][4][2], const Unit& u, int wr, int wc, int fr, int fq) const {
        const int row0 = u.pm * BM + wr * 64 + fr; const int col0 = u.pn * BM + wc * 32 + 8 * fq;
        const float sc = (u.pn >= q_lo && u.pn < q_hi) ? qscale : 1.f;
#pragma unroll
        for (int ai = 0; ai < 2; ++ai)
#pragma unroll
            for (int m = 0; m < 4; ++m) { bf16_t* rowp = O + (size_t)(row0 + ai * HALF + m * 16) * ldc + col0;
#pragma unroll
                for (int bj = 0; bj < 2; ++bj) { const f32x4 v0 = acc[ai][bj][m][0] * sc, v1 = acc[ai][bj][m][1] * sc;
                    u32x4 w; w.x = cvt_pk_bf16(v0[0], v0[1]); w.y = cvt_pk_bf16(v0[2], v0[3]); w.z = cvt_pk_bf16(v1[0], v1[1]); w.w = cvt_pk_bf16(v1[2], v1[3]);
                    *(u32x4*)(rowp + bj * HALF) = w; } }
    }
};
struct EpiRes {
    static constexpr bool PERM = false, AFTER_DRAIN = false;
    const float* base; bf16_t* out; int ldc;
    __device__ __forceinline__ void operator()(const f32x4 (&acc)[2][2][4][2], const Unit& u, int wr, int wc, int fr, int fq) const {
        const int col0 = u.pn * BM + wc * 32 + 4 * fq;
#pragma unroll
        for (int ai = 0; ai < 2; ++ai) {
            f32x4 pre[4][2][2];
#pragma unroll
            for (int m = 0; m < 4; ++m) { const size_t off = (size_t)(u.pm * BM + ai * HALF + wr * 64 + m * 16 + fr) * ldc + col0;
#pragma unroll
                for (int bj = 0; bj < 2; ++bj)
#pragma unroll
                    for (int n = 0; n < 2; ++n) pre[m][bj][n] = *(const f32x4*)(base + off + bj * HALF + n * 16); }
#pragma unroll
            for (int m = 0; m < 4; ++m) { const size_t off = (size_t)(u.pm * BM + ai * HALF + wr * 64 + m * 16 + fr) * ldc + col0;
#pragma unroll
                for (int bj = 0; bj < 2; ++bj)
#pragma unroll
                    for (int n = 0; n < 2; ++n) { const f32x4 v = pre[m][bj][n] + acc[ai][bj][m][n];
                        u32x2 w; w.x = cvt_pk_bf16(v[0], v[1]); w.y = cvt_pk_bf16(v[2], v[3]); *(u32x2*)(out + off + bj * HALF + n * 16) = w; } }
        }
    }
};
struct EpiSwiglu {
    static constexpr bool PERM = true, AFTER_DRAIN = false;
    unsigned char* O; int ldc; const float* bias; int nb;
    __device__ __forceinline__ static f32x2 act2(f32x4 h) {
        f32x2 g = {fminf(h[0], 7.0f), fminf(h[2], 7.0f)}, l = {fminf(fmaxf(h[1], -7.0f), 7.0f), fminf(fmaxf(h[3], -7.0f), 7.0f)};
        const f32x2 z = g * (-1.702f * 1.4426950408889634f);
        f32x2 e = {__builtin_amdgcn_exp2f(z.x), __builtin_amdgcn_exp2f(z.y)}; e = e + 1.0f;
        const f32x2 s = {__builtin_amdgcn_rcpf(e.x), __builtin_amdgcn_rcpf(e.y)};
        return (g * s) * (l + 1.0f);
    }
    __device__ __forceinline__ void operator()(const f32x4 (&acc)[2][2][4][2], const Unit& u, int wr, int wc, int fr, int fq) const {
        const int row0 = u.pm * BM + wr * 64 + fr; const int col0 = u.pn * BM + wc * 32 + 8 * fq;
        const float* bp = bias + (size_t)u.e * nb + col0;
        f32x4 bv[2][2];
#pragma unroll
        for (int bj = 0; bj < 2; ++bj)
#pragma unroll
            for (int n = 0; n < 2; ++n) bv[bj][n] = *(const f32x4*)(bp + bj * HALF + 4 * n);
#pragma unroll
        for (int ai = 0; ai < 2; ++ai)
#pragma unroll
            for (int m = 0; m < 4; ++m) { unsigned char* rowp = O + (size_t)(row0 + ai * HALF + m * 16) * ldc + (col0 >> 1);
#pragma unroll
                for (int bj = 0; bj < 2; ++bj) { const f32x4 v0 = acc[ai][bj][m][0] + bv[bj][0], v1 = acc[ai][bj][m][1] + bv[bj][1];
                    const f32x2 a0 = act2(v0), a1 = act2(v1);
                    int w = __builtin_amdgcn_cvt_pk_fp8_f32(a0.x, a0.y, 0, false); w = __builtin_amdgcn_cvt_pk_fp8_f32(a1.x, a1.y, w, true);
                    *(int*)(rowp + bj * (HALF / 2)) = w; } }
    }
};
struct EpiBias {
    static constexpr bool PERM = true, AFTER_DRAIN = false;
    unsigned char* O; int ldc; const float* bias; int nb;
    __device__ __forceinline__ void operator()(const f32x4 (&acc)[2][2][4][2], const Unit& u, int wr, int wc, int fr, int fq) const {
        const int row0 = u.pm * BM + wr * 64 + fr; const int col0 = u.pn * BM + wc * 32 + 8 * fq;
        const float* bp = bias + (size_t)u.e * nb + col0;
        f32x4 bv[2][2];
#pragma unroll
        for (int bj = 0; bj < 2; ++bj)
#pragma unroll
            for (int n = 0; n < 2; ++n) bv[bj][n] = *(const f32x4*)(bp + bj * HALF + 4 * n);
#pragma unroll
        for (int ai = 0; ai < 2; ++ai)
#pragma unroll
            for (int m = 0; m < 4; ++m) { unsigned char* rowp = O + (size_t)(row0 + ai * HALF + m * 16) * ldc + col0;
#pragma unroll
                for (int bj = 0; bj < 2; ++bj) { const f32x4 v0 = (acc[ai][bj][m][0] + bv[bj][0]) * 4.0f, v1 = (acc[ai][bj][m][1] + bv[bj][1]) * 4.0f;
                    int w0 = __builtin_amdgcn_cvt_pk_fp8_f32(v0[0], v0[1], 0, false); w0 = __builtin_amdgcn_cvt_pk_fp8_f32(v0[2], v0[3], w0, true);
                    int w1 = __builtin_amdgcn_cvt_pk_fp8_f32(v1[0], v1[1], 0, false); w1 = __builtin_amdgcn_cvt_pk_fp8_f32(v1[2], v1[3], w1, true);
                    u32x2 w; w.x = (unsigned)w0; w.y = (unsigned)w1; *(u32x2*)(rowp + bj * HALF) = w; } }
    }
};

template <class Epi, class Sched, bool GATHER, bool ALIGN_EPI = false, bool SP2 = false, int FP8SCALE = 0>
__device__ __forceinline__ void gemm_phase(PG8_LAS unsigned char* lds, const Gemm g, const Sched& S, const Epi& E) {
    const int tid = threadIdx.x, wid = __builtin_amdgcn_readfirstlane(tid >> 6), lane = tid & 63, wr = wid >> 2, wc = wid & 3, fr = lane & 15, fq = lane >> 4;
    const int K = g.K, nt = K / BK;
    unsigned voffA[2], voffB[2]; int sR[2], sC[2];
#pragma unroll
    for (int i = 0; i < 2; ++i) { int R, C; stage_rc(tid * 16 + i * 8192, R, C); const int Rb = Epi::PERM ? ((R & ~31) + perm32(R & 31)) : R; sR[i] = R; sC[i] = C;
        voffA[i] = (unsigned)(R * K + C) * 2u; voffB[i] = (unsigned)(Rb * K + C) * 2u; }
    unsigned vC[2][2], vN[2][2], vS[2][2];
#define PG8_GOFF(U, V) do { _Pragma("unroll") for (int _h = 0; _h < 2; ++_h) _Pragma("unroll") for (int _i = 0; _i < 2; ++_i) { int _ix = (U).l0 + _h * HALF + sR[_i]; _ix = _ix < (U).cnt ? _ix : (U).cnt - 1; \
        const int _tok = g.rows[(size_t)(U).e * g.rows_stride + _ix]; V[_h][_i] = (unsigned)(_tok * K + sC[_i]) * 2u; } } while (0)
#define PG8_STAGE_A(bufoff, gbase, h, VG) do { if constexpr (GATHER) { PG8_STAGE(bufoff, gbase, VG[h]); } else { PG8_STAGE(bufoff, (gbase) + (h) * hstep, voffA); } } while (0)
    const size_t kstep = (size_t)(BK * 2);
    const size_t hstep = (size_t)HALF * K * 2;
    const size_t tstep = 2 * hstep;
    const unsigned ldsw = (unsigned)wid * 1024u;
    const int aoff = lds_byte(wr * 64 + fr, fq * 8), boff = lds_byte(wc * 32 + fr, fq * 8);
#define PG8_SA(b, h) (((b) * 2 + (h)) * HTB)
#define PG8_SB(b, h) ((4 + (b) * 2 + (h)) * HTB)
#define PG8_STAGE(bufoff, gbase, voff) do { _Pragma("unroll") for (int _i = 0; _i < 2; ++_i) \
        __builtin_amdgcn_global_load_lds((const unsigned*)((const char*)(gbase) + (voff)[_i]), (PG8_LAS unsigned*)(lds + (bufoff) + ldsw + _i * 8192), 16, 0, 0); } while (0)
#define PG8_CAT(lo, hi) __builtin_shufflevector(lo, hi, 0, 1, 2, 3, 4, 5, 6, 7)
#define PG8_LDA(dst, b, h) do { _Pragma("unroll") for (int m = 0; m < 4; ++m) dst[m] = PG8_CAT(*(const PG8_LAS i32x4*)(lds + PG8_SA(b, h) + aoff + m * 2048), *(const PG8_LAS i32x4*)(lds + PG8_SA(b, h) + aoff + m * 2048 + 1024)); } while (0)
#define PG8_LDB(dst, b, h) do { _Pragma("unroll") for (int n = 0; n < 2; ++n) dst[n] = PG8_CAT(*(const PG8_LAS i32x4*)(lds + PG8_SB(b, h) + boff + n * 2048), *(const PG8_LAS i32x4*)(lds + PG8_SB(b, h) + boff + n * 2048 + 1024)); } while (0)
#define PG8_HALF(v, k) __builtin_bit_cast(bf16x8, __builtin_shufflevector(v, v, 4 * (k), 4 * (k) + 1, 4 * (k) + 2, 4 * (k) + 3))
#define PG8_MMA(ai, bj, At, Bt) do { __builtin_amdgcn_s_setprio(1); _Pragma("unroll") for (int m = 0; m < 4; ++m) _Pragma("unroll") for (int n = 0; n < 2; ++n) { \
        if constexpr (FP8SCALE != 0) { asm volatile("v_mfma_scale_f32_16x16x128_f8f6f4 %0, %1, %2, %0, %3, %4 op_sel_hi:[0,0,0]" : "+v"(acc[ai][bj][m][n]) : "v"(Bt[n]), "v"(At[m]), "v"(sclw), "v"(sclx)); } \
        else { acc[ai][bj][m][n] = __builtin_amdgcn_mfma_f32_16x16x32_bf16(PG8_HALF(Bt[n], 0), PG8_HALF(At[m], 0), acc[ai][bj][m][n], 0, 0, 0); acc[ai][bj][m][n] = __builtin_amdgcn_mfma_f32_16x16x32_bf16(PG8_HALF(Bt[n], 1), PG8_HALF(At[m], 1), acc[ai][bj][m][n], 0, 0, 0); } } __builtin_amdgcn_s_setprio(0); } while (0)
#define PG8_WAIT_V(n) asm volatile("s_waitcnt vmcnt(" #n ")" ::: "memory")
#define PG8_WAIT_L(n) asm volatile("s_waitcnt lgkmcnt(" #n ")" ::: "memory")
#define PG8_BAR __builtin_amdgcn_s_barrier()
#define PG8_SCHED __builtin_amdgcn_sched_barrier(0)
    Unit cur, nxt; int ui = 0;
    if (!S.next(0, cur)) return;
    f32x4 acc[2][2][4][2];
#pragma unroll
    for (int a = 0; a < 2; ++a)
#pragma unroll
        for (int b = 0; b < 2; ++b)
#pragma unroll
            for (int m = 0; m < 4; ++m)
#pragma unroll
                for (int n = 0; n < 2; ++n) acc[a][b][m][n] = (f32x4){0.f, 0.f, 0.f, 0.f};
    i32x8 At[4], B0[2], B1[2];
    const int sclw = FP8SCALE * 0x01010101, sclx = 0x7f7f7f7f;
    const char* cA = (const char*)g.A + (GATHER ? (size_t)0 : (size_t)cur.pm * tstep); const char* cB = (const char*)g.Bt + ((size_t)cur.e * g.bstride) * 2 + (size_t)cur.pn * tstep;
    if constexpr (GATHER) { PG8_GOFF(cur, vC); }
    S.a_ready(cur);
    if constexpr (SP2) {
        PG8_STAGE(PG8_SB(0, 0), cB, voffB); PG8_STAGE(PG8_SB(0, 1), cB + hstep, voffB); PG8_STAGE_A(PG8_SA(0, 0), cA, 0, vC); PG8_STAGE_A(PG8_SA(0, 1), cA, 1, vC);
        if (wr == 1) PG8_BAR;
        PG8_WAIT_V(2); PG8_BAR;
        PG8_STAGE(PG8_SB(1, 0), cB + kstep, voffB); PG8_STAGE_A(PG8_SA(1, 0), cA + kstep, 0, vC); PG8_STAGE(PG8_SB(1, 1), cB + hstep + kstep, voffB);
        PG8_WAIT_V(6); PG8_BAR;
    } else {
        PG8_STAGE(PG8_SB(0, 0), cB, voffB); PG8_STAGE_A(PG8_SA(0, 0), cA, 0, vC); PG8_STAGE(PG8_SB(0, 1), cB + hstep, voffB); PG8_STAGE_A(PG8_SA(0, 1), cA, 1, vC);
        if (wr == 1) PG8_BAR;
        PG8_WAIT_V(4); PG8_BAR;
        PG8_STAGE(PG8_SB(1, 0), cB + kstep, voffB); PG8_STAGE_A(PG8_SA(1, 0), cA + kstep, 0, vC); PG8_STAGE(PG8_SB(1, 1), cB + hstep + kstep, voffB);
        PG8_WAIT_V(6); PG8_BAR;
    }
    for (;;) {
        const bool has_next = S.next(ui + 1, nxt);
        const char* nA = (has_next && !GATHER) ? (const char*)g.A + (size_t)nxt.pm * tstep : cA; const char* nB = has_next ? (const char*)g.Bt + ((size_t)nxt.e * g.bstride) * 2 + (size_t)nxt.pn * tstep : cB;
        if constexpr (GATHER) { if (has_next) { PG8_GOFF(nxt, vN); } else { _Pragma("unroll") for (int h_ = 0; h_ < 2; ++h_) _Pragma("unroll") for (int i_ = 0; i_ < 2; ++i_) vN[h_][i_] = vC[h_][i_]; } }
        for (int t = 0; t < nt; t += 2) {
            const bool last = (t == nt - 2);
            const char* a1 = cA + (size_t)(t + 1) * kstep;
            const char* a2 = last ? nA : cA + (size_t)(t + 2) * kstep;
            if constexpr (GATHER) { _Pragma("unroll") for (int h_ = 0; h_ < 2; ++h_) _Pragma("unroll") for (int i_ = 0; i_ < 2; ++i_) vS[h_][i_] = last ? vN[h_][i_] : vC[h_][i_]; } const char* b2 = last ? nB : cB + (size_t)(t + 2) * kstep;
            const char* a3 = a2 + kstep; const char* b3 = b2 + kstep;
            if (last && has_next) S.a_ready(nxt);
            if constexpr (SP2) {
            PG8_LDB(B0, 0, 0); PG8_LDB(B1, 0, 1); PG8_SCHED; PG8_LDA(At, 0, 0); PG8_STAGE_A(PG8_SA(1, 1), a1, 1, vC);
            PG8_WAIT_V(8); PG8_WAIT_L(0); PG8_BAR; PG8_MMA(0, 0, At, B0); PG8_MMA(0, 1, At, B1); PG8_BAR; PG8_SCHED;
            PG8_LDA(At, 0, 1); PG8_STAGE(PG8_SB(0, 0), b2, voffB); PG8_STAGE(PG8_SB(0, 1), b2 + hstep, voffB); PG8_STAGE_A(PG8_SA(0, 0), a2, 0, vS);
            PG8_WAIT_V(8); PG8_WAIT_L(0); PG8_BAR; PG8_MMA(1, 0, At, B0); PG8_MMA(1, 1, At, B1); PG8_BAR; PG8_SCHED;
            PG8_LDB(B0, 1, 0); PG8_LDB(B1, 1, 1); PG8_SCHED; PG8_LDA(At, 1, 0); PG8_STAGE_A(PG8_SA(0, 1), a2, 1, vS);
            PG8_WAIT_V(8); PG8_WAIT_L(0); PG8_BAR; PG8_MMA(0, 0, At, B0); PG8_MMA(0, 1, At, B1); PG8_BAR; PG8_SCHED;
            PG8_LDA(At, 1, 1); PG8_STAGE(PG8_SB(1, 0), b3, voffB); PG8_STAGE(PG8_SB(1, 1), b3 + hstep, voffB); PG8_STAGE_A(PG8_SA(1, 0), a3, 0, vS);
            PG8_WAIT_V(8); PG8_WAIT_L(0); PG8_BAR; PG8_MMA(1, 0, At, B0); PG8_MMA(1, 1, At, B1); PG8_BAR; PG8_SCHED;
            } else {
            PG8_LDB(B0, 0, 0); PG8_SCHED; PG8_LDA(At, 0, 0); PG8_STAGE_A(PG8_SA(1, 1), a1, 1, vC);
            PG8_WAIT_L(8); PG8_BAR; PG8_WAIT_L(0); PG8_MMA(0, 0, At, B0); PG8_BAR; PG8_SCHED;
            PG8_LDB(B1, 0, 1); PG8_STAGE(PG8_SB(0, 0), b2, voffB);
            PG8_BAR; PG8_WAIT_L(0); PG8_MMA(0, 1, At, B1); PG8_BAR;
            PG8_LDA(At, 0, 1); PG8_STAGE_A(PG8_SA(0, 0), a2, 0, vS);
            PG8_BAR; PG8_WAIT_L(0); PG8_MMA(1, 0, At, B0); PG8_BAR; PG8_SCHED;
            PG8_STAGE(PG8_SB(0, 1), b2 + hstep, voffB);
            PG8_WAIT_V(6); PG8_BAR; PG8_MMA(1, 1, At, B1); PG8_BAR;
            PG8_LDB(B0, 1, 0); PG8_SCHED; PG8_LDA(At, 1, 0); PG8_STAGE_A(PG8_SA(0, 1), a2, 1, vS);
            PG8_WAIT_L(8); PG8_BAR; PG8_WAIT_L(0); PG8_MMA(0, 0, At, B0); PG8_BAR; PG8_SCHED;
            PG8_LDB(B1, 1, 1); PG8_STAGE(PG8_SB(1, 0), b3, voffB);
            PG8_BAR; PG8_WAIT_L(0); PG8_MMA(0, 1, At, B1); PG8_BAR;
            PG8_LDA(At, 1, 1); PG8_STAGE_A(PG8_SA(1, 0), a3, 0, vS);
            PG8_BAR; PG8_WAIT_L(0); PG8_MMA(1, 0, At, B0); PG8_BAR; PG8_SCHED;
            PG8_STAGE(PG8_SB(1, 1), b3 + hstep, voffB);
            PG8_WAIT_V(6); PG8_BAR; PG8_MMA(1, 1, At, B1); PG8_BAR;
            }
        }
        if constexpr (FP8SCALE != 0) { asm volatile("s_nop 15\n\ts_nop 15" ::: "memory"); }
        if constexpr (ALIGN_EPI) { if (wr == 0) PG8_BAR; }
        if constexpr (!Epi::AFTER_DRAIN) { E(acc, cur, wr, wc, fr, fq); S.done(cur); }
        if (!has_next) break;
#pragma unroll
        for (int a = 0; a < 2; ++a)
#pragma unroll
            for (int b = 0; b < 2; ++b)
#pragma unroll
                for (int m = 0; m < 4; ++m)
#pragma unroll
                    for (int n = 0; n < 2; ++n) acc[a][b][m][n] = (f32x4){0.f, 0.f, 0.f, 0.f};
        cur = nxt; cA = nA; cB = nB; ++ui;
        if constexpr (GATHER) { _Pragma("unroll") for (int h_ = 0; h_ < 2; ++h_) _Pragma("unroll") for (int i_ = 0; i_ < 2; ++i_) vC[h_][i_] = vN[h_][i_]; }
        if constexpr (ALIGN_EPI) { if (wr == 1) PG8_BAR; }
    }
    PG8_WAIT_V(0);
    if constexpr (!ALIGN_EPI) { if (wr == 0) PG8_BAR; }
    PG8_BAR;
    if constexpr (Epi::AFTER_DRAIN) { E.fused(acc, cur, wr, wc, fr, fq, lds, wid, lane); S.done(cur); }
#undef PG8_SA
#undef PG8_GOFF
#undef PG8_STAGE_A
#undef PG8_SB
#undef PG8_STAGE
#undef PG8_LDA
#undef PG8_LDB
#undef PG8_MMA
#undef PG8_CAT
#undef PG8_HALF
#undef PG8_WAIT_V
#undef PG8_WAIT_L
#undef PG8_BAR
#undef PG8_SCHED
}
}
#ifndef PG8_SP2
#define PG8_SP2 true
#endif
#ifndef PG8_ALIGN
#define PG8_ALIGN true
#endif
#include <hip/hip_bf16.h>
#include <cmath>
namespace attn_body {
using bf16=__hip_bfloat16;
using bf16x8=__attribute__((ext_vector_type(8)))short;
using s16x4=__attribute__((ext_vector_type(4)))short;
using f32x16=__attribute__((ext_vector_type(16)))float;
using u32x4=__attribute__((ext_vector_type(4)))unsigned;
constexpr int BATCH=4,NHEAD=8,SEQ=8192,D=64,PQ=3328,PO=1024;
constexpr int NW=8,QBLK=32,QB=QBLK*NW,KVBLK=64,NQB=SEQ/QB;
constexpr int ATTN_UNIT_ROWS=QB;
__device__ __forceinline__ int crow(int r,int hi){return (r&3)+8*(r>>2)+4*hi;}
#define SBAR() __builtin_amdgcn_sched_barrier(0)
__device__ __forceinline__ void cmask(f32x16&p0,f32x16&p1,int jb,int qrel,int hi){
  const float NEG=-INFINITY; int kb=64*jb+4*hi;
  #pragma unroll
  for(int r=0;r<16;++r){int kv=kb+(r&3)+8*(r>>2); if(kv>qrel)p0[r]=NEG; if(kv+32>qrel)p1[r]=NEG;}
}

constexpr int NSLOT=3, SLOTB=8192;
constexpr int LDS_K=0, LDS_V=NSLOT*SLOTB, LDS_WS=2*NSLOT*SLOTB, LDS_OST=LDS_WS+NW*64*4, LDS_CK=LDS_OST+NW*4096, LDS_BYTES=LDS_CK+SEQ*4;
constexpr float C2=0.125f*1.4426950408889634f;
__device__ __forceinline__ void glds16(const void*gsrc,unsigned lds_dst){unsigned keep;
  asm volatile("s_mov_b32 %0, m0\n\ts_mov_b32 m0, %2\n\ts_nop 0\n\tglobal_load_lds_dwordx4 %1, off\n\ts_mov_b32 m0, %0":"=&s"(keep):"v"(gsrc),"s"(lds_dst):"memory");}
__device__ __forceinline__ float max3f(float a,float b,float c){float r;asm("v_max3_f32 %0, %1, %2, %3":"=v"(r):"v"(a),"v"(b),"v"(c));return r;}
__device__ __forceinline__ float max2f(float a,float b){float r;asm("v_max_f32_e32 %0, %1, %2":"=v"(r):"v"(a),"v"(b));return r;}
__device__ __forceinline__ float fadd_s(float a,float b){float r;asm("v_add_f32_e32 %0, %1, %2":"=v"(r):"v"(a),"v"(b));return r;}
__device__ __forceinline__ float fsub_s(float a,float b){float r;asm("v_sub_f32_e32 %0, %1, %2":"=v"(r):"v"(a),"v"(b));return r;}
typedef float f32x2_t __attribute__((ext_vector_type(2))); typedef __bf16 bf16x2_t __attribute__((ext_vector_type(2)));
__device__ __forceinline__ unsigned cvtpk_s(float lo,float hi){f32x2_t v={lo,hi};bf16x2_t b=__builtin_convertvector(v,bf16x2_t);return __builtin_bit_cast(unsigned,b);}
#define WAIT_BAR(N) asm volatile("s_waitcnt vmcnt(" #N ") lgkmcnt(0)\n\ts_barrier":::"memory")

__device__ __forceinline__ void qkt(f32x16&p0,f32x16&p1,const char*Kslot,const bf16x8*qr,int r32,int hi){
  const char*kb=Kslot+hi*1024+r32*16;
  #pragma unroll
  for(int d0=0;d0<4;++d0){
    const bf16x8 b0=*reinterpret_cast<const bf16x8*>(kb+d0*2048);
    const bf16x8 b1=*reinterpret_cast<const bf16x8*>(kb+d0*2048+512);
    p0=__builtin_amdgcn_mfma_f32_32x32x16_bf16(b0,qr[d0],p0,0,0,0);p1=__builtin_amdgcn_mfma_f32_32x32x16_bf16(b1,qr[d0],p1,0,0,0);}
}
typedef __attribute__((address_space(3))) const char* lds_cptr;
typedef __attribute__((address_space(3))) float* lds_f32p; typedef __attribute__((address_space(3))) const float* lds_cf32p; typedef float f32x4_t __attribute__((ext_vector_type(4)));
typedef short v4i16_t __attribute__((ext_vector_type(4)));
__device__ __forceinline__ void kload8(bf16x8*kf,lds_cptr kp){
  kf[0]=*(const __attribute__((address_space(3))) bf16x8*)(kp);      kf[1]=*(const __attribute__((address_space(3))) bf16x8*)(kp+512);
  kf[2]=*(const __attribute__((address_space(3))) bf16x8*)(kp+2048); kf[3]=*(const __attribute__((address_space(3))) bf16x8*)(kp+2560);
  kf[4]=*(const __attribute__((address_space(3))) bf16x8*)(kp+4096); kf[5]=*(const __attribute__((address_space(3))) bf16x8*)(kp+4608);
  kf[6]=*(const __attribute__((address_space(3))) bf16x8*)(kp+6144); kf[7]=*(const __attribute__((address_space(3))) bf16x8*)(kp+6656);
}
__device__ __forceinline__ void kload2(bf16x8*kf,lds_cptr kp,int j){ kf[2*j]=*(const __attribute__((address_space(3))) bf16x8*)(kp+j*2048); kf[2*j+1]=*(const __attribute__((address_space(3))) bf16x8*)(kp+j*2048+512); }
__device__ __forceinline__ s16x4 vtr(lds_cptr p){ return __builtin_bit_cast(s16x4,__builtin_amdgcn_ds_read_tr16_b64_v4i16((__attribute__((address_space(3))) v4i16_t*)p)); }
__device__ __forceinline__ float rowmax(const f32x16&p0,const f32x16&p1){
  float a=max3f(p0[0],p0[1],p1[0]),b=max3f(p0[2],p0[3],p1[1]);a=max3f(a,p1[2],p1[3]);
  #pragma unroll
  for(int r=4;r<16;r+=4){a=max3f(a,p0[r],p0[r+1]);b=max3f(b,p0[r+2],p0[r+3]);a=max3f(a,p1[r],p1[r+1]);b=max3f(b,p1[r+2],p1[r+3]);}
  const float m=max2f(a,b);
  auto rr=__builtin_amdgcn_permlane32_swap(__float_as_uint(m),__float_as_uint(m),false,false);
  return max2f(__uint_as_float(rr[0]),__uint_as_float(rr[1]));
}
__device__ __forceinline__ void pv(f32x16*o,int vb,bf16x8 pa0,bf16x8 pa1,bf16x8 pa2,bf16x8 pa3){
  #pragma unroll
  for(int d0=0;d0<2;++d0){s16x4 lo[4],hi[4];
    #pragma unroll
    for(int ks=0;ks<4;++ks){
      asm volatile("ds_read_b64_tr_b16 %0,%1 offset:%c2":"=&v"(lo[ks]):"v"(vb),"i"(d0*4096+ks*1024):"memory");
      asm volatile("ds_read_b64_tr_b16 %0,%1 offset:%c2":"=&v"(hi[ks]):"v"(vb),"i"(d0*4096+ks*1024+512):"memory");}
    asm volatile("s_waitcnt lgkmcnt(0)":::"memory");SBAR();
    #define PK(k) (bf16x8){lo[k][0],lo[k][1],lo[k][2],lo[k][3],hi[k][0],hi[k][1],hi[k][2],hi[k][3]}
    o[d0]=__builtin_amdgcn_mfma_f32_32x32x16_bf16(pa0,PK(0),o[d0],0,0,0);
    o[d0]=__builtin_amdgcn_mfma_f32_32x32x16_bf16(pa1,PK(1),o[d0],0,0,0);
    o[d0]=__builtin_amdgcn_mfma_f32_32x32x16_bf16(pa2,PK(2),o[d0],0,0,0);
    o[d0]=__builtin_amdgcn_mfma_f32_32x32x16_bf16(pa3,PK(3),o[d0],0,0,0);
    #undef PK
  }
}

#ifndef ATTN_STORE16
#define ATTN_STORE16(p,v) (*(u32x4*)(p)=(v))
#endif
template<int THRL> __device__ __forceinline__ void attn_unit(int b,int h,int qb,int kt0,const bf16*Q,const bf16*__restrict__ K,const bf16*__restrict__ V,bf16*O,const float*__restrict__ CKG,const float*__restrict__ OG,char*shm){
  const int tid=threadIdx.x,lane=tid&63,r32=lane&31,hi=lane>>5; const int wid=__builtin_amdgcn_readfirstlane(tid>>6);
  const long rowbase=(long)b*SEQ; const int q0=qb*QB; const lds_cptr shm3_=(lds_cptr)shm;
  const bf16*Qw=Q+(rowbase+q0+wid*QBLK)*PQ+h*D;
  const bf16*Kh=K+(rowbase+(long)kt0*KVBLK)*PQ+h*D,*Vh=V+(rowbase+(long)kt0*KVBLK)*PQ+h*D;
  const unsigned lds0=(unsigned)(uintptr_t)shm;
  float*wsf=(float*)(shm+LDS_WS)+wid*64;
  const bf16*ksrc=Kh+(long)lane*PQ+wid*8;
  const bf16*vsrc=Vh+(long)(16*(wid&3)+(lane>>2))*PQ+(wid>>2)*32+(lane&3)*8;
  const unsigned kdst=lds0+LDS_K+wid*1024, vdst=lds0+LDS_V+wid*1024;
  #define DMA_K(t,slot) glds16(ksrc+(long)(t)*KVBLK*PQ,(unsigned)__builtin_amdgcn_readfirstlane(kdst+(slot)))
  #define DMA_V(t,slot) glds16(vsrc+(long)(t)*KVBLK*PQ,(unsigned)__builtin_amdgcn_readfirstlane(vdst+(slot)))
  const int vb0=(int)(lds0+LDS_V)+((lane>>4)&1)*32+(lane&3)*8+(4*hi+((lane&15)>>2))*64;
  const char*Kbase=shm+LDS_K; bf16x8 kf[8];
  const lds_cptr shm3=(lds_cptr)shm; const lds_cptr kp0=shm3+LDS_K+hi*1024+r32*16; const lds_cptr vp0=shm3+LDS_V+((lane>>4)&1)*32+(lane&3)*8+(4*hi+((lane&15)>>2))*64;
  const int NT=(q0+QB)/KVBLK-kt0;
  { const float*ckg=CKG+((long)(b*NHEAD+h))*SEQ+kt0*KVBLK; lds_f32p ckl=(lds_f32p)(shm3_+LDS_CK);
    f32x4_t cv_[4];
    _Pragma("unroll") for(int it=0;it<4;++it)cv_[it]=*(const f32x4_t*)(ckg+tid*4+it*NW*64*4);
    _Pragma("unroll") for(int it=0;it<4;++it)*(__attribute__((address_space(3))) f32x4_t*)(ckl+tid*4+it*NW*64*4)=cv_[it]; }
  const lds_cf32p ckb=(lds_cf32p)(shm3_+LDS_CK)+4*hi;
  DMA_K(0,0);DMA_V(0,0);DMA_K(1,SLOTB);
  bf16x8 qr[4];
  #pragma unroll
  for(int d0=0;d0<4;++d0)qr[d0]=*reinterpret_cast<const bf16x8*>(&Qw[(long)r32*PQ+d0*16+hi*8]);
  float mhat=0.f,l_reg=0.f;f32x16 o[2];o[0]=f32x16{};o[1]=f32x16{};float negmh=0.f;
  #define BIAS(C0,C1,t) do{ const lds_cf32p cp_=ckb+(t)*KVBLK; \
    _Pragma("unroll") for(int g_=0;g_<4;++g_){ const f32x4_t a_=*(const __attribute__((address_space(3))) f32x4_t*)(cp_+8*g_); const f32x4_t b_=*(const __attribute__((address_space(3))) f32x4_t*)(cp_+8*g_+32); \
      _Pragma("unroll") for(int j_=0;j_<4;++j_){ C0[4*g_+j_]=negmh-a_[j_]; C1[4*g_+j_]=negmh-b_[j_]; } if(g_&1){SBAR();} } }while(0)
  const int qrel=wid*QBLK+r32;
  #define CMASK(P0,P1,t) do{int jb_=(t)-(NT-4); if(jb_>=0)cmask(P0,P1,jb_,qrel,hi);}while(0)
  bool resc=false;
  #define START(P0,P1) do{ const float rm=rowmax(P0,P1); resc=false; \
    { const float dl=rm; mhat=fadd_s(mhat,dl); \
      _Pragma("unroll") for(int r=0;r<16;++r){P0[r]=fsub_s(P0[r],dl);P1[r]=fsub_s(P1[r],dl);} \
      negmh=-mhat; } \
    _Pragma("unroll") for(int r=0;r<16;++r)P0[r]=__builtin_amdgcn_exp2f(P0[r]); }while(0)
  #define RESC() do{ if(resc){ asm volatile("s_waitcnt lgkmcnt(0)":::"memory"); \
      _Pragma("unroll") for(int d_=0;d_<2;++d_) _Pragma("unroll") for(int r=0;r<16;++r)o[d_][r]*=wsf[crow(r,hi)]; } }while(0)
  f32x16 pA0,pA1,pB0,pB1;
  int sl_prev=0,sl_cur=0,sl_next=SLOTB;
  #define ROT() do{sl_prev=sl_cur;sl_cur=sl_next;sl_next=(sl_next==(NSLOT-1)*SLOTB)?0:sl_next+SLOTB;}while(0)
  DMA_K(2,2*SLOTB);
  WAIT_BAR(3);
  BIAS(pA0,pA1,0); qkt(pA0,pA1,Kbase,qr,r32,hi);asm volatile("s_nop 15\n\ts_nop 7":"+v"(pA0),"+v"(pA1));CMASK(pA0,pA1,0);
  START(pA0,pA1);
  _Pragma("unroll") for(int r=0;r<16;++r)pA1[r]=__builtin_amdgcn_exp2f(pA1[r]);
  WAIT_BAR(0);
  DMA_K(3,0);DMA_V(1,SLOTB);
  ROT();
  kload8(kf,kp0+sl_cur);
  WAIT_BAR(2);
  s16x4 vlo[8],vhi[8]; u32x4 pw0,pw1,pw2,pw3;
  #define PKW(P,B) cvtpk_s(P[B],P[B+1])
  #define PAF(k) __builtin_bit_cast(bf16x8,pw##k)
  #define VFR(i) (bf16x8){vlo[i][0],vlo[i][1],vlo[i][2],vlo[i][3],vhi[i][0],vhi[i][1],vhi[i][2],vhi[i][3]}
  #define PIN(x) asm volatile("":"+v"(x))
  #define MX3(a,b,c) __builtin_fmaxf(__builtin_fmaxf((a),(b)),(c))
  #define GAPA(MF,A0,A1,A2,A3,W0,W1,PW) do{ MF; sacc+=A0; sacc+=A1; sacc+=A2; sacc+=A3; PIN(sacc); W0; W1; PIN(PW); SBAR(); }while(0)
  #define EX(v) __builtin_amdgcn_exp2f(v)
  #define GAPB(MF,X,B) do{ MF; X[B]=EX(X[B]); X[B+1]=EX(X[B+1]); X[B+2]=EX(X[B+2]); X[B+3]=EX(X[B+3]); PIN(X); SBAR(); }while(0)
  #define VRD(i) do{ vlo[i]=vtr(vp_+(((i)>>2)*4096+((i)&3)*1024)); vhi[i]=vtr(vp_+(((i)>>2)*4096+((i)&3)*1024+512)); }while(0)
  #define KRD(G,j) do{ if(G){ kload2(kf,kp0+sl_next,j); SBAR(); } }while(0)
  #define STEP(C0,C1,P0,P1,t,GK,GV,GL) do{ SBAR(); BIAS(C0,C1,t); SBAR(); \
    const lds_cptr vp_=vp0+sl_prev; \
    VRD(0); SBAR(); float sacc=(P0[0]+P0[1]); \
    GAPA(C0=__builtin_amdgcn_mfma_f32_32x32x16_bf16(kf[0],qr[0],C0,0,0,0), P0[2],P0[3],P0[4],P0[5],     pw0[0]=PKW(P0,0), pw0[1]=PKW(P0,2), pw0); \
    VRD(4); SBAR(); GAPA(C1=__builtin_amdgcn_mfma_f32_32x32x16_bf16(kf[1],qr[0],C1,0,0,0), P0[6],P0[7],P0[8],P0[9],     pw0[2]=PKW(P0,4), pw0[3]=PKW(P0,6), pw0); \
    VRD(1); SBAR(); GAPA(C0=__builtin_amdgcn_mfma_f32_32x32x16_bf16(kf[2],qr[1],C0,0,0,0),   P0[10],P0[11],P0[12],P0[13], pw1[0]=PKW(P0,8), pw1[1]=PKW(P0,10), pw1); \
    VRD(5); SBAR(); GAPA(C1=__builtin_amdgcn_mfma_f32_32x32x16_bf16(kf[3],qr[1],C1,0,0,0),   P0[14],P0[15],P1[0],P1[1],   pw1[2]=PKW(P0,12),pw1[3]=PKW(P0,14), pw1); \
    VRD(2); SBAR(); GAPA(C0=__builtin_amdgcn_mfma_f32_32x32x16_bf16(kf[4],qr[2],C0,0,0,0),   P1[2],P1[3],P1[4],P1[5],     pw2[0]=PKW(P1,0), pw2[1]=PKW(P1,2), pw2); \
    VRD(6); SBAR(); GAPA(C1=__builtin_amdgcn_mfma_f32_32x32x16_bf16(kf[5],qr[2],C1,0,0,0),   P1[6],P1[7],P1[8],P1[9],     pw2[2]=PKW(P1,4), pw2[3]=PKW(P1,6), pw2); \
    VRD(3); SBAR(); GAPA(C0=__builtin_amdgcn_mfma_f32_32x32x16_bf16(kf[6],qr[3],C0,0,0,0),   P1[10],P1[11],P1[12],P1[13], pw3[0]=PKW(P1,8), pw3[1]=PKW(P1,10), pw3); \
    VRD(7); SBAR(); GAPA(C1=__builtin_amdgcn_mfma_f32_32x32x16_bf16(kf[7],qr[3],C1,0,0,0),   P1[14],P1[15],0.f,0.f,       pw3[2]=PKW(P1,12),pw3[3]=PKW(P1,14), pw3); \
    l_reg+=sacc; \
    if(GK){DMA_K((t)+3,sl_cur);} if(GV){DMA_V((t)+1,sl_next);} \
    CMASK(C0,C1,t); \
    { float a=MX3(C0[0],C0[1],C1[0]),b=MX3(C0[2],C0[3],C1[1]); a=MX3(a,C1[2],C1[3]); \
      _Pragma("unroll") for(int r=4;r<16;r+=4){a=MX3(a,C0[r],C0[r+1]);b=MX3(b,C0[r+2],C0[r+3]);a=MX3(a,C1[r],C1[r+1]);b=MX3(b,C1[r+2],C1[r+3]);} \
      float rm=__builtin_fmaxf(a,b); { auto rr=__builtin_amdgcn_permlane32_swap(__float_as_uint(rm),__float_as_uint(rm),false,false); rm=__builtin_fmaxf(__uint_as_float(rr[0]),__uint_as_float(rr[1])); } \
      resc=false; \
      if(__builtin_expect(__any(rm>(float)THRL),0)){ const float dl=__builtin_fmaxf(rm,0.f); mhat+=dl; \
        _Pragma("unroll") for(int r=0;r<16;++r){C0[r]-=dl;C1[r]-=dl;} \
        negmh=-mhat; \
        const float f=__builtin_amdgcn_exp2f(-dl); l_reg*=f; if(hi==0)wsf[r32]=f; resc=true; } } \
    SBAR(); \
    GAPB(o[0]=__builtin_amdgcn_mfma_f32_32x32x16_bf16(PAF(0),VFR(0),o[0],0,0,0), C0,0); \
    GAPB(o[1]=__builtin_amdgcn_mfma_f32_32x32x16_bf16(PAF(0),VFR(4),o[1],0,0,0), C0,4); \
    KRD(GL,0); GAPB(o[0]=__builtin_amdgcn_mfma_f32_32x32x16_bf16(PAF(1),VFR(1),o[0],0,0,0), C0,8); \
    KRD(GL,1); GAPB(o[1]=__builtin_amdgcn_mfma_f32_32x32x16_bf16(PAF(1),VFR(5),o[1],0,0,0), C0,12); \
    KRD(GL,2); GAPB(o[0]=__builtin_amdgcn_mfma_f32_32x32x16_bf16(PAF(2),VFR(2),o[0],0,0,0), C1,0); \
    KRD(GL,3); GAPB(o[1]=__builtin_amdgcn_mfma_f32_32x32x16_bf16(PAF(2),VFR(6),o[1],0,0,0), C1,4); \
    GAPB(o[0]=__builtin_amdgcn_mfma_f32_32x32x16_bf16(PAF(3),VFR(3),o[0],0,0,0), C1,8); \
    GAPB(o[1]=__builtin_amdgcn_mfma_f32_32x32x16_bf16(PAF(3),VFR(7),o[1],0,0,0), C1,12); \
    }while(0)
  int t=1;
  #undef CMASK
  #define CMASK(P0,P1,t) do{}while(0)
  for(;t+5<NT;t+=2){
    STEP(pB0,pB1,pA0,pA1,t,true,true,true);     WAIT_BAR(2); RESC(); ROT();
    STEP(pA0,pA1,pB0,pB1,t+1,true,true,true);   WAIT_BAR(2); RESC(); ROT();
  }
  #undef CMASK
  #define CMASK(P0,P1,t) do{int jb_=(t)-(NT-4); if(jb_>=0)cmask(P0,P1,jb_,qrel,hi);}while(0)
  #define ENDW(tt) do{ if((tt)+3<NT){WAIT_BAR(2);} else if((tt)+2<NT){WAIT_BAR(1);} else {WAIT_BAR(0);} }while(0)
  for(;t+1<NT;t+=2){
    STEP(pB0,pB1,pA0,pA1,t,(t+3<NT),(t+1<NT),(t+1<NT));       ENDW(t);   RESC(); ROT();
    STEP(pA0,pA1,pB0,pB1,t+1,(t+4<NT),(t+2<NT),(t+2<NT));     ENDW(t+1); RESC(); ROT();
  }
  STEP(pB0,pB1,pA0,pA1,NT-1,false,false,false); RESC();
  { float sacc=pB0[0]+pB0[1]; _Pragma("unroll") for(int r=2;r<16;++r)sacc+=pB0[r]; _Pragma("unroll") for(int r=0;r<16;++r)sacc+=pB1[r]; l_reg+=sacc;
    pw0=(u32x4){PKW(pB0,0),PKW(pB0,2),PKW(pB0,4),PKW(pB0,6)};pw1=(u32x4){PKW(pB0,8),PKW(pB0,10),PKW(pB0,12),PKW(pB0,14)};pw2=(u32x4){PKW(pB1,0),PKW(pB1,2),PKW(pB1,4),PKW(pB1,6)};pw3=(u32x4){PKW(pB1,8),PKW(pB1,10),PKW(pB1,12),PKW(pB1,14)};
    SBAR(); pv(o,vb0+sl_cur,PAF(0),PAF(1),PAF(2),PAF(3)); }
  #undef PKW
  #undef PAF
  #undef VFR
  #undef PIN
  #undef MX3
  #undef GAPA
  #undef GAPB
  #undef EX
  #undef VRD
  #undef KRD
  #undef STEP
  #undef ENDW
  {auto rr=__builtin_amdgcn_permlane32_swap(__float_as_uint(l_reg),__float_as_uint(l_reg),false,false);l_reg=__uint_as_float(rr[0])+__uint_as_float(rr[1]);}
  if(hi==0)wsf[32+r32]=l_reg;asm volatile("s_waitcnt lgkmcnt(0)":::"memory");
  float rli[16];
  #pragma unroll
  for(int r=0;r<16;++r)rli[r]=__builtin_amdgcn_rcpf(wsf[32+crow(r,hi)]);
  bf16*Ow=O+(rowbase+q0+wid*QBLK)*PO+h*D;
  { bf16*stg=(bf16*)(shm+LDS_OST)+wid*2048;
    #pragma unroll
    for(int r=0;r<16;++r){const int orow=crow(r,hi);
      #pragma unroll
      for(int d0=0;d0<2;++d0)stg[orow*64+d0*32+r32]=__float2bfloat16(o[d0][r]*rli[r]);}
    asm volatile("s_waitcnt lgkmcnt(0)":::"memory");
    #pragma unroll
    for(int i=0;i<4;++i){const int row=i*8+(lane>>3),ch=lane&7; const u32x4 v=*(const u32x4*)(stg+row*64+ch*8);
      float f[8]; _Pragma("unroll") for(int j=0;j<4;++j){ f[2*j]=__uint_as_float(v[j]<<16); f[2*j+1]=__uint_as_float(v[j]&0xffff0000u); }
      float ss=0.f; _Pragma("unroll") for(int j=0;j<8;++j)ss+=f[j]*f[j];
      ss+=__shfl_xor(ss,1); ss+=__shfl_xor(ss,2); ss+=__shfl_xor(ss,4);
      const float rs=__builtin_amdgcn_rsqf(ss*(1.0f/64.0f)+1e-5f);
      const f32x4_t g0=*(const f32x4_t*)(OG+h*D+ch*8), g1=*(const f32x4_t*)(OG+h*D+ch*8+4);
      u32x4 w; w[0]=cvtpk_s(f[0]*rs*g0[0],f[1]*rs*g0[1]); w[1]=cvtpk_s(f[2]*rs*g0[2],f[3]*rs*g0[3]); w[2]=cvtpk_s(f[4]*rs*g1[0],f[5]*rs*g1[1]); w[3]=cvtpk_s(f[6]*rs*g1[2],f[7]*rs*g1[3]);
      ATTN_STORE16(Ow+(long)row*PO+ch*8,w);} }
  asm volatile("s_waitcnt lgkmcnt(0)\n\ts_barrier":::"memory");
  #undef DMA_K
  #undef DMA_V
  #undef CMASK
  #undef START
  #undef RESC
  #undef ROT
  #undef BIAS
}
constexpr int ATTN_LDS_BYTES=LDS_BYTES;
struct AttnTensors { const bf16* Q; const bf16* K; const bf16* V; bf16* O; const float* CK; const float* OG; };
struct AttnUnit { int bh; int qb; };
struct StaticOrder {
  int vcu;
  __device__ __forceinline__ explicit StaticOrder(int grid,int block):vcu((block%8)*(grid/8)+block/8){}
  __device__ __forceinline__ bool next(int i,AttnUnit&u)const{ if(i>=4)return false; const int s=vcu&7; u.bh=vcu>>3; u.qb=(i==0)?s:(i==1)?15-s:(i==2)?16+s:31-s; return true; }
  __device__ __forceinline__ void a_ready(const AttnUnit&)const{}
  __device__ __forceinline__ void done(const AttnUnit&)const{}
};
template<class Sched,int THRL=8> __device__ __forceinline__ void attn_phase(char*lds,const AttnTensors&T,const Sched&S){
  AttnUnit u;
  for(int i=0;S.next(i,u);++i){ S.a_ready(u); attn_unit<THRL>(u.bh/NHEAD,u.bh%NHEAD,u.qb,0,T.Q,T.K,T.V,T.O,T.CK,T.OG,lds); S.done(u); }
}
#undef SBAR
#undef WAIT_BAR
}
namespace rw {
typedef short bf16x8 __attribute__((ext_vector_type(8)));
typedef float f32x4 __attribute__((ext_vector_type(4)));
typedef unsigned u32x2 __attribute__((ext_vector_type(2)));
typedef unsigned u32x4 __attribute__((ext_vector_type(4)));
#define RW_LAS __attribute__((address_space(3)))
constexpr int PT = 72, MB = 64 * PT * 2;
constexpr int O_AH = 0, O_RH = MB, O_BH = 2 * MB, O_KH = 3 * MB, O_AHT = 4 * MB, O_VT = 5 * MB, O_BTT = 6 * MB, O_KTT = 7 * MB, O_Z = 8 * MB;
constexpr int O_Z0 = O_Z, O_Z1 = O_Z + MB, O_Z2 = O_Z + 2 * MB, O_Z3 = O_Z + 3 * MB, O_Z4 = O_Z + 4 * MB;
constexpr int ZP = 68, ZB = 64 * ZP * 4;
constexpr int O_ZW = O_Z, O_ZA = O_Z + ZB, O_ZG = O_Z + 2 * ZB, O_WTOT = O_ZG + MB;
constexpr int XP = 264, O_X = 0;
constexpr int O_LW = O_Z4 + MB;
constexpr int PART_A_LDS = O_LW + 32768;
static_assert(64 * XP * 2 <= O_Z, "X overlays only the hat matrices");
static_assert(O_WTOT + 2048 <= O_Z4 + MB, "rwkv LDS map");
constexpr int UNIT_QT = 0, UNIT_YI = 8192, UNIT_ML = 16384, UNIT_NT = 24576, UNIT_P = 40960, UNIT_BYTES = 41216;

__device__ __forceinline__ unsigned pk(float lo, float hi) { typedef float f2 __attribute__((ext_vector_type(2))); typedef __bf16 b2 __attribute__((ext_vector_type(2))); f2 v = {lo, hi}; return __builtin_bit_cast(unsigned, __builtin_convertvector(v, b2)); }
__device__ __forceinline__ unsigned short f2b(float f) { return (unsigned short)(pk(f, 0.f) & 0xffffu); }
__device__ __forceinline__ float b2f(unsigned short b) { return __uint_as_float((unsigned)b << 16); }
__device__ __forceinline__ float sigm(float x) { return __builtin_amdgcn_rcpf(1.0f + __expf(-x)); }

__device__ __forceinline__ void mm_nt(f32x4 (&acc)[2], const RW_LAS unsigned char* lds, int xo, int yo, int ti, int ch, int c, int g) {
#pragma unroll
    for (int s = 0; s < 2; ++s) {
        const bf16x8 a = *(const RW_LAS bf16x8*)(lds + xo + ((16 * ti + c) * PT + 32 * s + 8 * g) * 2);
#pragma unroll
        for (int n = 0; n < 2; ++n) { const bf16x8 b = *(const RW_LAS bf16x8*)(lds + yo + ((32 * ch + 16 * n + c) * PT + 32 * s + 8 * g) * 2); acc[n] = __builtin_amdgcn_mfma_f32_16x16x32_bf16(a, b, acc[n], 0, 0, 0); }
    }
}
#define RW_ZERO(a) do { a[0] = (f32x4){0.f, 0.f, 0.f, 0.f}; a[1] = (f32x4){0.f, 0.f, 0.f, 0.f}; } while (0)
__device__ __forceinline__ void st_nat(RW_LAS unsigned char* lds, int off, const f32x4& v, int row0, int col) {
#pragma unroll
    for (int r = 0; r < 4; ++r) *(RW_LAS unsigned short*)(lds + off + ((row0 + r) * PT + col) * 2) = f2b(v[r]);
}
__device__ __forceinline__ void st_tr(RW_LAS unsigned char* lds, int off, const f32x4& v, int row0, int col) {
    u32x2 w; w.x = pk(v[0], v[1]); w.y = pk(v[2], v[3]); *(RW_LAS u32x2*)(lds + off + (col * PT + row0) * 2) = w;
}

struct PartA { const float* const __attribute__((address_space(4)))* in; unsigned char* ws; size_t o_u, o_lora, o_rec, o_bon, o_gg; };
#define PA_U ((const unsigned short*)(A.ws + A.o_u))
#define PA_WUPT ((const unsigned short*)(A.ws + A.o_lora))
#define PA_AUPT (PA_WUPT + 512 * 64)
#define PA_GUPT (PA_WUPT + 2 * 512 * 64)
#define PA_REC (A.ws + A.o_rec)
#define PA_BON ((unsigned short*)(A.ws + A.o_bon))
#define PA_GG ((unsigned short*)(A.ws + A.o_gg))

#define RW_BAR() asm volatile("s_waitcnt lgkmcnt(0)\n\ts_barrier" ::: "memory")
__device__ __forceinline__ void part_a_block(const PartA& A, RW_LAS unsigned char* lds, int bh, int chunk0, int nun, int tid_in, volatile RW_LAS unsigned* tsw) {
    constexpr int NU_ = 3328, T_ = 8192;
#if TS_PROBE >= 100
    unsigned long long ts_last = __builtin_amdgcn_s_memrealtime(), ts_acc = 0ull;
#define RW_TS(k) do { const unsigned long long n_ = __builtin_amdgcn_s_memrealtime(); if ((k) == TS_PROBE - 100) ts_acc += n_ - ts_last; ts_last = n_; } while (0)
#else
#define RW_TS(k) do { } while (0)
#endif
    u32x4 xc[4], xp[4]; unsigned short er[9], ek[9], ev[9];
#define RW_PREFETCH_X(CH) do { const int tid_ = tid_in, b_ = bh >> 3; const size_t m0_ = (size_t)b_ * T_ + (size_t)(CH) * 64; \
        { const int t_ = tid_ & 63, cb_ = (tid_ >> 6) * 32; const unsigned short* ur_ = PA_U + (m0_ + t_) * NU_ + 1536 + cb_; const bool first_ = ((CH) == 0 && t_ == 0); \
          const unsigned short* up_ = first_ ? ur_ : ur_ - NU_;         \
          _Pragma("unroll") for (int q = 0; q < 4; ++q) { xc[q] = *(const u32x4*)(ur_ + 8 * q); xp[q] = *(const u32x4*)(up_ + 8 * q); } \
          if (first_) { _Pragma("unroll") for (int q = 0; q < 4; ++q) xp[q] = (u32x4){0u, 0u, 0u, 0u}; } } } while (0)
#define RW_PREFETCH_E(CH) do { const int tid_ = tid_in, lane_ = tid_ & 63, w_ = tid_ >> 6, b_ = bh >> 3, h_ = bh & 7; const size_t m0_ = (size_t)b_ * T_ + (size_t)(CH) * 64; \
        { const unsigned short* u0_ = PA_U + (m0_ + 8 * w_) * NU_ + h_ * 64 + lane_; const bool first_ = ((CH) == 0 && w_ == 0); \
          const unsigned short* p0_ = first_ ? u0_ : u0_ - NU_; er[0] = p0_[0]; ek[0] = p0_[512]; ev[0] = p0_[1024]; \
          _Pragma("unroll") for (int i = 0; i < 8; ++i) { er[i + 1] = u0_[(size_t)i * NU_]; ek[i + 1] = u0_[(size_t)i * NU_ + 512]; ev[i + 1] = u0_[(size_t)i * NU_ + 1024]; } \
          if (first_) { er[0] = 0; ek[0] = 0; ev[0] = 0; } } } while (0)
    { const int lane_ = tid_in & 63, w_ = tid_in >> 6, ch_ = w_ & 1, c_ = lane_ & 15, g_ = lane_ >> 4;
#pragma unroll
      for (int q = 0; q < 4; ++q) { const int f = 4 * (w_ >> 1) + q; const int n = f & 1, col_ = (bh & 7) * 64 + 32 * ch_ + 16 * n + c_;
          const unsigned short* src = f < 4 ? PA_WUPT + col_ * 64 + 32 * (f >> 1) + 8 * g_ : f < 8 ? PA_AUPT + col_ * 64 + 32 * ((f - 4) >> 1) + 8 * g_ : PA_GUPT + col_ * 128 + 32 * ((f - 8) >> 1) + 8 * g_;
          *(RW_LAS bf16x8*)(lds + O_LW + ((ch_ * 16 + f) * 64 + lane_) * 16) = *(const bf16x8*)src; } }
#define RW_LOAD_LORA() do { const int ch_ = (tid_in >> 6) & 1, lane_ = tid_in & 63; _Pragma("unroll") for (int n = 0; n < 2; ++n) { \
        _Pragma("unroll") for (int s = 0; s < 2; ++s) { fw[s][n] = *(const RW_LAS bf16x8*)(lds + O_LW + ((ch_ * 16 + 2 * s + n) * 64 + lane_) * 16); fa[s][n] = *(const RW_LAS bf16x8*)(lds + O_LW + ((ch_ * 16 + 4 + 2 * s + n) * 64 + lane_) * 16); } \
        _Pragma("unroll") for (int s = 0; s < 4; ++s) fg[s][n] = *(const RW_LAS bf16x8*)(lds + O_LW + ((ch_ * 16 + 8 + 2 * s + n) * 64 + lane_) * 16); } } while (0)
    RW_PREFETCH_X(chunk0);
    const int pc_cc = (bh & 7) * 64 + (tid_in & 63);
    const float pc_mur = A.in[3][pc_cc], pc_muk = A.in[3][512 + pc_cc], pc_muv = A.in[3][1024 + pc_cc], pc_w0 = A.in[4][pc_cc], pc_a0 = A.in[6][pc_cc], pc_kk = A.in[9][pc_cc], pc_ka = A.in[10][pc_cc], pc_rk = A.in[11][pc_cc];
  for (int kk_ = 0; kk_ < nun; ++kk_) {
    const int chunk = chunk0 + kk_; int tid = tid_in;
    constexpr int RW_ = 512;
    asm volatile("" : "+v"(tid));
    const int lane = tid & 63, w = __builtin_amdgcn_readfirstlane(tid >> 6), ti = w >> 1, ch = w & 1, c = lane & 15, g = lane >> 4;
    const int b = bh >> 3, h = bh & 7; const size_t m0 = (size_t)b * T_ + (size_t)chunk * 64;
    unsigned char* rec = PA_REC + (size_t)(bh * 128 + chunk) * UNIT_BYTES;
    bf16x8 fw[2][2], fa[2][2], fg[4][2];
    { const int t = lane, cb = 32 * w;
      const f32x4* mup = (const f32x4*)(A.in[3] + 1536 + cb);
      f32x4 mu4[8];
#pragma unroll
      for (int q = 0; q < 8; ++q) mu4[q] = mup[q];
      float xs[32];
#pragma unroll
      for (int q = 0; q < 4; ++q)
#pragma unroll
          for (int e = 0; e < 4; ++e) { const float c0 = __uint_as_float(xc[q][e] << 16), c1 = __uint_as_float(xc[q][e] & 0xffff0000u), p0 = __uint_as_float(xp[q][e] << 16), p1 = __uint_as_float(xp[q][e] & 0xffff0000u);
              const int j = 8 * q + 2 * e; xs[j] = c0 + (p0 - c0) * mu4[j >> 2][j & 3]; xs[j + 1] = c1 + (p1 - c1) * mu4[(j + 1) >> 2][(j + 1) & 3]; }
      if (w < 2) {
#pragma unroll
          for (int j = 0; j < 32; ++j) xs[j] = 1.0f - 2.0f * __builtin_amdgcn_rcpf(1.0f + __expf(2.0f * xs[j]));
      } else if (w >= 4) {
#pragma unroll
          for (int j = 0; j < 32; ++j) xs[j] = __builtin_amdgcn_rcpf(1.0f + __expf(-xs[j]));
      }
#pragma unroll
      for (int q = 0; q < 4; ++q) { u32x4 o; o.x = pk(xs[8 * q], xs[8 * q + 1]); o.y = pk(xs[8 * q + 2], xs[8 * q + 3]); o.z = pk(xs[8 * q + 4], xs[8 * q + 5]); o.w = pk(xs[8 * q + 6], xs[8 * q + 7]);
          *(RW_LAS u32x4*)(lds + O_X + (t * XP + cb + 8 * q) * 2) = o; }
      if (kk_ + 1 < nun) { RW_PREFETCH_X(chunk + 1); } }
    RW_BAR(); RW_TS(0);
    RW_LOAD_LORA();
    RW_PREFETCH_E(chunk);
    { f32x4 zw[2], za[2], zg[2]; RW_ZERO(zw); RW_ZERO(za); RW_ZERO(zg);
#pragma unroll
      for (int s = 0; s < 2; ++s) {
          const bf16x8 aw = *(const RW_LAS bf16x8*)(lds + O_X + ((16 * ti + c) * XP + 32 * s + 8 * g) * 2), aa = *(const RW_LAS bf16x8*)(lds + O_X + ((16 * ti + c) * XP + 64 + 32 * s + 8 * g) * 2);
#pragma unroll
          for (int n = 0; n < 2; ++n) { zw[n] = __builtin_amdgcn_mfma_f32_16x16x32_bf16(aw, fw[s][n], zw[n], 0, 0, 0); za[n] = __builtin_amdgcn_mfma_f32_16x16x32_bf16(aa, fa[s][n], za[n], 0, 0, 0); } }
#pragma unroll
      for (int s = 0; s < 4; ++s) { const bf16x8 ag = *(const RW_LAS bf16x8*)(lds + O_X + ((16 * ti + c) * XP + 128 + 32 * s + 8 * g) * 2);
#pragma unroll
          for (int n = 0; n < 2; ++n) zg[n] = __builtin_amdgcn_mfma_f32_16x16x32_bf16(ag, fg[s][n], zg[n], 0, 0, 0); }
#pragma unroll
      for (int n = 0; n < 2; ++n)
#pragma unroll
          for (int r = 0; r < 4; ++r) { const int o = ((16 * ti + 4 * g + r) * ZP + 32 * ch + 16 * n + c) * 4;
              *(RW_LAS float*)(lds + O_ZW + o) = zw[n][r]; *(RW_LAS float*)(lds + O_ZA + o) = za[n][r]; *(RW_LAS unsigned short*)(lds + O_ZG + ((16 * ti + 4 * g + r) * PT + 32 * ch + 16 * n + c) * 2) = f2b(zg[n][r]); } }
    RW_BAR(); RW_TS(1);
    { const int cc = h * 64 + lane;
      float r[8], k[8], v[8], lw[8], av[8];
      { float pr = b2f(er[0]), pk_ = b2f(ek[0]), pv = b2f(ev[0]);
        const float mur = pc_mur, muk = pc_muk, muv = pc_muv;
#pragma unroll
        for (int i = 0; i < 8; ++i) { const float cr = b2f(er[i + 1]), ck = b2f(ek[i + 1]), cv = b2f(ev[i + 1]);
            r[i] = cr + (pr - cr) * mur; k[i] = ck + (pk_ - ck) * muk; v[i] = cv + (pv - cv) * muv; pr = cr; pk_ = ck; pv = cv; } }
      const float w0 = pc_w0, a0 = pc_a0, k_k = pc_kk, k_a = pc_ka, r_k = pc_rk;
      float run = 0.f, kkr[8], k2[8];
#pragma unroll
      for (int i = 0; i < 8; ++i) { const int t = 8 * w + i; const float zw = *(const RW_LAS float*)(lds + O_ZW + (t * ZP + lane) * 4) + w0, za = *(const RW_LAS float*)(lds + O_ZA + (t * ZP + lane) * 4) + a0;
          lw[i] = -0.6065306597126334f * sigm(zw); run += lw[i]; av[i] = sigm(za); kkr[i] = k[i] * k_k; k2[i] = k[i] * (1.0f + (av[i] - 1.0f) * k_a); }
      *(RW_LAS float*)(lds + O_WTOT + (w * 64 + lane) * 4) = run;
#pragma unroll
      for (int i = 0; i < 8; ++i) { *(RW_LAS float*)(lds + O_ZW + ((8 * w + i) * ZP + lane) * 4) = kkr[i] * kkr[i]; *(RW_LAS float*)(lds + O_ZA + ((8 * w + i) * ZP + lane) * 4) = r[i] * k2[i] * r_k; }
      float red[16];
      { const int q = lane >> 2, part = lane & 3; const RW_LAS float* rp = (const RW_LAS float*)(lds + ((q < 8) ? O_ZW : O_ZA) + ((8 * w + (q & 7)) * ZP + part * 16) * 4);
        const f32x4 s0 = *(const RW_LAS f32x4*)(rp), s1 = *(const RW_LAS f32x4*)(rp + 4), s2 = *(const RW_LAS f32x4*)(rp + 8), s3 = *(const RW_LAS f32x4*)(rp + 12);
        float s = ((s0.x + s0.y) + (s0.z + s0.w)) + ((s1.x + s1.y) + (s1.z + s1.w)) + ((s2.x + s2.y) + (s2.z + s2.w)) + ((s3.x + s3.y) + (s3.z + s3.w));
        s += __uint_as_float(__builtin_amdgcn_update_dpp(0, __float_as_uint(s), 0xB1, 0xF, 0xF, true));
        s += __uint_as_float(__builtin_amdgcn_update_dpp(0, __float_as_uint(s), 0x4E, 0xF, 0xF, true));
        asm volatile("s_waitcnt lgkmcnt(0)" ::: "memory");
        if (part == 0) *(RW_LAS float*)(lds + O_ZW + ((8 * w) * ZP + q) * 4) = s;
        const RW_LAS f32x4* rr = (const RW_LAS f32x4*)(lds + O_ZW + ((8 * w) * ZP) * 4);
#pragma unroll
        for (int j = 0; j < 4; ++j) { const f32x4 x = rr[j]; red[4 * j] = x.x; red[4 * j + 1] = x.y; red[4 * j + 2] = x.z; red[4 * j + 3] = x.w; } }
      RW_BAR(); RW_TS(2);
      float off = 0.f, tot = 0.f;
#pragma unroll
      for (int j = 0; j < 8; ++j) { const float x = *(const RW_LAS float*)(lds + O_WTOT + (j * 64 + lane) * 4); tot += x; if (j < w) off += x; }
      float cum = off; unsigned aht[4], vt[4], btt[4], ktt[4], bon[4], ggs[4]; float ahp = 0.f, vp = 0.f, btp = 0.f, ktp = 0.f, bop = 0.f, ggp = 0.f;
      const float etot = __expf(tot); float e1 = __expf(off);
#pragma unroll
      for (int i = 0; i < 8; ++i) { const int t = 8 * w + i; cum += lw[i];
          const float kk = kkr[i] * __builtin_amdgcn_rsqf(fmaxf(red[i], 1e-24f));
          const float bb = -kk * av[i];
          const float ex = e1; e1 = __expf(cum); const float e2 = __builtin_amdgcn_rcpf(e1), et = etot * e2;
          const float ah = kk * ex, rh = r[i] * e1, bh_ = bb * e2, kh = k2[i] * e2, bt = bb * et, kt = k2[i] * et;
          const int o = (t * PT + lane) * 2;
          *(RW_LAS unsigned short*)(lds + O_AH + o) = f2b(ah); *(RW_LAS unsigned short*)(lds + O_RH + o) = f2b(rh); *(RW_LAS unsigned short*)(lds + O_BH + o) = f2b(bh_); *(RW_LAS unsigned short*)(lds + O_KH + o) = f2b(kh);
          if (i & 1) { aht[i >> 1] = pk(ahp, ah); vt[i >> 1] = pk(vp, v[i]); btt[i >> 1] = pk(btp, bt); ktt[i >> 1] = pk(ktp, kt); } else { ahp = ah; vp = v[i]; btp = bt; ktp = kt; }
          const float bo = red[8 + i] * v[i], gg_ = b2f(*(const RW_LAS unsigned short*)(lds + O_ZG + (t * PT + lane) * 2));
          if (i & 1) { bon[i >> 1] = pk(bop, bo); ggs[i >> 1] = pk(ggp, gg_); } else { bop = bo; ggp = gg_; } }
      { const size_t uo = (size_t)(bh * 128 + chunk) * 4096;
        const int e0 = (((lane >> 4) * 4 + (w >> 1)) * 64 + (lane & 15) + 16 * (2 * (w & 1))) * 4;
        *(u32x2*)(PA_BON + uo + e0) = (u32x2){bon[0], bon[1]}; *(u32x2*)(PA_BON + uo + e0 + 64) = (u32x2){bon[2], bon[3]};
        *(u32x2*)(PA_GG + uo + e0) = (u32x2){ggs[0], ggs[1]}; *(u32x2*)(PA_GG + uo + e0 + 64) = (u32x2){ggs[2], ggs[3]}; }
      const int ot = (lane * PT + 8 * w) * 2;
      *(RW_LAS u32x4*)(lds + O_AHT + ot) = (u32x4){aht[0], aht[1], aht[2], aht[3]}; *(RW_LAS u32x4*)(lds + O_VT + ot) = (u32x4){vt[0], vt[1], vt[2], vt[3]};
      *(RW_LAS u32x4*)(lds + O_BTT + ot) = (u32x4){btt[0], btt[1], btt[2], btt[3]}; *(RW_LAS u32x4*)(lds + O_KTT + ot) = (u32x4){ktt[0], ktt[1], ktt[2], ktt[3]};
      if (w == 7) *(float*)(rec + UNIT_P + lane * 4) = etot; }
    RW_BAR(); RW_TS(3);

    const int row0 = 16 * ti + 4 * g;
    { f32x4 ab[2], ak[2], rb[2], rk[2]; RW_ZERO(ab); RW_ZERO(ak); RW_ZERO(rb); RW_ZERO(rk);
      mm_nt(ab, lds, O_AH, O_BH, ti, ch, c, g); mm_nt(ak, lds, O_AH, O_KH, ti, ch, c, g); mm_nt(rb, lds, O_RH, O_BH, ti, ch, c, g); mm_nt(rk, lds, O_RH, O_KH, ti, ch, c, g);
#pragma unroll
      for (int n = 0; n < 2; ++n) { const int col = 32 * ch + 16 * n + c, ct = 2 * ch + n;
          f32x4 ao, sk, irb, irk;
#pragma unroll
          for (int r = 0; r < 4; ++r) { const int t = row0 + r; ao[r] = (ti > ct) ? ab[n][r] : 0.f; sk[r] = (t > col) ? ak[n][r] : 0.f; irb[r] = (t >= col) ? rb[n][r] : 0.f; irk[r] = (t >= col) ? rk[n][r] : 0.f; }
          st_tr(lds, O_Z0, ao, row0, col); st_nat(lds, O_Z1, sk, row0, col); st_nat(lds, O_Z2, irb, row0, col); st_nat(lds, O_Z3, irk, row0, col);
          if (ti == ct) {
#pragma unroll
              for (int r = 0; r < 4; ++r) *(RW_LAS float*)(lds + O_Z4 + ((row0 + r) * 16 + c) * 4) = (4 * g + r > c) ? ab[n][r] : 0.f; } } }
    RW_BAR(); RW_TS(4);
    { f32x4 a[2]; RW_ZERO(a); mm_nt(a, lds, O_Z1, O_VT, ti, ch, c, g);
#pragma unroll
      for (int n = 0; n < 2; ++n) st_tr(lds, O_BH, a[n], row0, 32 * ch + 16 * n + c);
      for (int i = tid; i < MB / 16; i += 512) { *(RW_LAS u32x4*)(lds + O_KH + i * 16) = (u32x4){0u, 0u, 0u, 0u}; *(RW_LAS u32x4*)(lds + O_AH + i * 16) = (u32x4){0u, 0u, 0u, 0u}; } }
    RW_BAR(); RW_TS(5);
    if (w == 0) { float d[16];
#pragma unroll
      for (int t = 0; t < 16; ++t) { float s = (t == c) ? 1.f : 0.f;
          f32x4 av4[4];
#pragma unroll
          for (int q = 0; q < 4; ++q) if (4 * q < t) av4[q] = *(const RW_LAS f32x4*)(lds + O_Z4 + ((16 * g + t) * 16 + 4 * q) * 4);
#pragma unroll
          for (int q = 0; q < t; ++q) s += av4[q >> 2][q & 3] * d[q];
          d[t] = s; asm volatile("" ::: "memory"); }
#pragma unroll
      for (int t = 0; t < 16; ++t) *(RW_LAS unsigned short*)(lds + O_KH + ((16 * g + t) * PT + 16 * g + c) * 2) = f2b(d[t]);
      u32x4 lo, hi; lo.x = pk(d[0], d[1]); lo.y = pk(d[2], d[3]); lo.z = pk(d[4], d[5]); lo.w = pk(d[6], d[7]); hi.x = pk(d[8], d[9]); hi.y = pk(d[10], d[11]); hi.z = pk(d[12], d[13]); hi.w = pk(d[14], d[15]);
      *(RW_LAS u32x4*)(lds + O_AH + ((16 * g + c) * PT + 16 * g) * 2) = lo; *(RW_LAS u32x4*)(lds + O_AH + ((16 * g + c) * PT + 16 * g + 8) * 2) = hi; }
    RW_BAR(); RW_TS(6);
    f32x4 gac[2], g2[2], hh[2];
    RW_ZERO(gac); mm_nt(gac, lds, O_KH, O_Z0, ti, ch, c, g);
#pragma unroll
    for (int n = 0; n < 2; ++n) { st_nat(lds, O_Z1, gac[n], row0, 32 * ch + 16 * n + c); st_tr(lds, O_Z4, gac[n], row0, 32 * ch + 16 * n + c); }
    RW_BAR(); RW_TS(7);
    RW_ZERO(g2); mm_nt(g2, lds, O_Z1, O_Z4, ti, ch, c, g);
#pragma unroll
    for (int n = 0; n < 2; ++n) st_tr(lds, O_Z0, g2[n], row0, 32 * ch + 16 * n + c);
    RW_BAR(); RW_TS(7);
    RW_ZERO(hh); mm_nt(hh, lds, O_Z1, O_Z0, ti, ch, c, g);
#pragma unroll
    for (int n = 0; n < 2; ++n) { const int col = 32 * ch + 16 * n + c;
#pragma unroll
        for (int r = 0; r < 4; ++r) hh[n][r] += gac[n][r] + g2[n][r] + ((row0 + r == col) ? 1.f : 0.f);
        st_nat(lds, O_Z4, hh[n], row0, col); }
    RW_BAR(); RW_TS(7);
    { f32x4 tt[2]; RW_ZERO(tt); mm_nt(tt, lds, O_Z4, O_AH, ti, ch, c, g);
      RW_BAR(); RW_TS(7);
#pragma unroll
      for (int n = 0; n < 2; ++n) st_nat(lds, O_Z1, tt[n], row0, 32 * ch + 16 * n + c); }
    RW_BAR(); RW_TS(7);
    { f32x4 ww[2], uu[2]; RW_ZERO(ww); RW_ZERO(uu); mm_nt(ww, lds, O_Z1, O_AHT, ti, ch, c, g); mm_nt(uu, lds, O_Z1, O_BH, ti, ch, c, g);
#pragma unroll
      for (int n = 0; n < 2; ++n) { st_tr(lds, O_Z0, ww[n], row0, 32 * ch + 16 * n + c); st_tr(lds, O_KH, uu[n], row0, 32 * ch + 16 * n + c); } }
    RW_BAR(); RW_TS(8);
    { f32x4 qt[2], ml[2], yi[2], nt[2]; RW_ZERO(qt); RW_ZERO(ml); RW_ZERO(yi); RW_ZERO(nt);
      mm_nt(qt, lds, O_Z0, O_Z2, ti, ch, c, g); mm_nt(ml, lds, O_Z0, O_BTT, ti, ch, c, g);
      mm_nt(yi, lds, O_Z2, O_KH, ti, ch, c, g); mm_nt(yi, lds, O_Z3, O_VT, ti, ch, c, g);
      mm_nt(nt, lds, O_BTT, O_KH, ti, ch, c, g); mm_nt(nt, lds, O_KTT, O_VT, ti, ch, c, g);
#pragma unroll
      for (int n = 0; n < 2; ++n) { const int col = 32 * ch + 16 * n + c;
          const u32x2 rv = *(const RW_LAS u32x2*)(lds + O_RH + (col * PT + row0) * 2);
          f32x4 q = qt[n]; q[0] += __uint_as_float(rv.x << 16); q[1] += __uint_as_float(rv.x & 0xffff0000u); q[2] += __uint_as_float(rv.y << 16); q[3] += __uint_as_float(rv.y & 0xffff0000u);
          const int fo = ((((col >> 4) * 2 + (ti >> 1)) * 64) + (col & 15) + 16 * g) * 8 + (ti & 1) * 4;
          u32x2 o; o.x = pk(q[0], q[1]); o.y = pk(q[2], q[3]); *(u32x2*)(rec + UNIT_QT + fo * 2) = o;
          o.x = pk(ml[n][0], ml[n][1]); o.y = pk(ml[n][2], ml[n][3]); *(u32x2*)(rec + UNIT_ML + fo * 2) = o;
          const int ao = (((2 * ch + n) * 4 + ti) * 64 + lane) * 4;
          o.x = pk(yi[n][0], yi[n][1]); o.y = pk(yi[n][2], yi[n][3]); *(u32x2*)(rec + UNIT_YI + ao * 2) = o;
          *(f32x4*)(rec + UNIT_NT + ao * 4) = nt[n]; } }
    RW_BAR(); RW_TS(9);
  }
#if TS_PROBE >= 100
    if (blockIdx.x == 0 && tid_in == 0) { tsw[0] = (unsigned)ts_acc; tsw[1] = (unsigned)(ts_acc >> 32); }
#endif
#undef RW_TS
#undef RW_PREFETCH_X
#undef RW_PREFETCH_E
#undef RW_LOAD_LORA
}

constexpr int PB_STAGE = 25600, PB_D = 5;
__device__ __forceinline__ void part_b_block(const unsigned char* REC, unsigned short* SREC, RW_LAS unsigned char* lds, int bh, int tid) {
    const int lane = tid & 63, w = __builtin_amdgcn_readfirstlane(tid >> 6), g = lane >> 4;
    const unsigned char* rec0 = REC + (size_t)(bh * 128) * UNIT_BYTES + UNIT_ML;
#define PB_SBAR() asm volatile("s_barrier" ::: "memory")
    if (w >= 4) {
        const int lw = w - 4;
#define PB_ISSUE(CH, SLOT) do { const unsigned char* src_ = rec0 + (size_t)(CH) * UNIT_BYTES + lane * 16; RW_LAS unsigned char* dst_ = lds + (SLOT) * PB_STAGE; \
            _Pragma("unroll") for (int p_ = 0; p_ < 7; ++p_) { const int pc_ = lw + 4 * p_; if (pc_ < 25) __builtin_amdgcn_global_load_lds((const unsigned*)(src_ + pc_ * 1024), (RW_LAS unsigned*)(dst_ + pc_ * 1024), 16, 0, 0); } } while (0)
        for (int c0 = 0; c0 < PB_D; ++c0) PB_ISSUE(c0, c0);
        int slot = 0;
        for (int chunk = 0; chunk < 128; ++chunk) {
            if (chunk <= 128 - PB_D) { if (lw == 0) asm volatile("s_waitcnt vmcnt(28)" ::: "memory"); else asm volatile("s_waitcnt vmcnt(24)" ::: "memory"); }
            else asm volatile("s_waitcnt vmcnt(0)" ::: "memory");
            PB_SBAR();
            PB_SBAR();
            if (chunk + PB_D < 128) PB_ISSUE(chunk + PB_D, slot);
            slot = (slot + 1 == PB_D) ? 0 : slot + 1;
        }
#undef PB_ISSUE
    } else {
        const int vs = w;
        f32x4 st[4];
#pragma unroll
        for (int i = 0; i < 4; ++i) st[i] = (f32x4){0.f, 0.f, 0.f, 0.f};
        unsigned short* sr = SREC + (size_t)(bh * 128) * 4096 + (vs * 2 * 64 + lane) * 8;
        int slot = 0;
        for (int chunk = 0; chunk < 128; ++chunk) {
            PB_SBAR();
            const RW_LAS unsigned char* sb = lds + slot * PB_STAGE;
            bf16x8 mf[4][2]; f32x4 nt[4], pp[4];
#pragma unroll
            for (int i = 0; i < 4; ++i) { mf[i][0] = *(const RW_LAS bf16x8*)(sb + (((i * 2 + 0) * 64) + lane) * 16); mf[i][1] = *(const RW_LAS bf16x8*)(sb + (((i * 2 + 1) * 64) + lane) * 16);
                nt[i] = *(const RW_LAS f32x4*)(sb + 8192 + ((vs * 4 + i) * 64 + lane) * 16); pp[i] = *(const RW_LAS f32x4*)(sb + 24576 + (16 * i + 4 * g) * 4); }
            asm volatile("s_waitcnt lgkmcnt(0)" ::: "memory");
            PB_SBAR();
            bf16x8 bf[2];
#pragma unroll
            for (int s = 0; s < 2; ++s) { u32x4 t_; t_.x = pk(st[2 * s][0], st[2 * s][1]); t_.y = pk(st[2 * s][2], st[2 * s][3]); t_.z = pk(st[2 * s + 1][0], st[2 * s + 1][1]); t_.w = pk(st[2 * s + 1][2], st[2 * s + 1][3]); bf[s] = __builtin_bit_cast(bf16x8, t_);
                *(u32x4*)(sr + (size_t)chunk * 4096 + s * 512) = t_; }
#pragma unroll
            for (int i = 0; i < 4; ++i) { f32x4 a_ = st[i] * pp[i] + nt[i];
                a_ = __builtin_amdgcn_mfma_f32_16x16x32_bf16(mf[i][0], bf[0], a_, 0, 0, 0); a_ = __builtin_amdgcn_mfma_f32_16x16x32_bf16(mf[i][1], bf[1], a_, 0, 0, 0); st[i] = a_; }
            slot = (slot + 1 == PB_D) ? 0 : slot + 1;
        }
    }
#undef PB_SBAR
}

struct PartC { const unsigned char* REC; const unsigned short* SREC; const unsigned short* BON; const unsigned short* GG; const float* ln_w; const float* ln_b; unsigned short* MIX; };
__device__ __forceinline__ void part_c_wave(const PartC& C, RW_LAS unsigned char* stage  , int unit, int i, int lane) {
    constexpr int T_ = 8192;
    const int c = lane & 15, g = lane >> 4, bh = unit >> 7, chunk = unit & 127, b = bh >> 3, h = bh & 7;
    const unsigned char* rec = C.REC + (size_t)unit * UNIT_BYTES; const unsigned short* sr = C.SREC + (size_t)unit * 4096;
    const bf16x8 q0 = *(const bf16x8*)(rec + UNIT_QT + (((i * 2 + 0) * 64) + lane) * 16), q1 = *(const bf16x8*)(rec + UNIT_QT + (((i * 2 + 1) * 64) + lane) * 16);
    f32x4 y[4]; u32x2 bo[4], gg[4];
#pragma unroll
    for (int n = 0; n < 4; ++n) { const bf16x8 s0 = *(const bf16x8*)(sr + ((n * 2 + 0) * 64 + lane) * 8), s1 = *(const bf16x8*)(sr + ((n * 2 + 1) * 64 + lane) * 8);
        const u32x2 yi = *(const u32x2*)(rec + UNIT_YI + ((n * 4 + i) * 64 + lane) * 8);
        bo[n] = *(const u32x2*)(C.BON + (size_t)unit * 4096 + ((n * 4 + i) * 64 + lane) * 4); gg[n] = *(const u32x2*)(C.GG + (size_t)unit * 4096 + ((n * 4 + i) * 64 + lane) * 4);
        f32x4 a; a[0] = __uint_as_float(yi.x << 16); a[1] = __uint_as_float(yi.x & 0xffff0000u); a[2] = __uint_as_float(yi.y << 16); a[3] = __uint_as_float(yi.y & 0xffff0000u);
        a = __builtin_amdgcn_mfma_f32_16x16x32_bf16(q0, s0, a, 0, 0, 0); a = __builtin_amdgcn_mfma_f32_16x16x32_bf16(q1, s1, a, 0, 0, 0); y[n] = a; }
    float lw[4], lb[4];
#pragma unroll
    for (int n = 0; n < 4; ++n) { lw[n] = C.ln_w[h * 64 + 16 * n + c]; lb[n] = C.ln_b[h * 64 + 16 * n + c]; }
#pragma unroll
    for (int r = 0; r < 4; ++r) {
        float s = (y[0][r] + y[1][r]) + (y[2][r] + y[3][r]);
        s += __shfl_xor(s, 1); s += __shfl_xor(s, 2); s += __shfl_xor(s, 4); s += __shfl_xor(s, 8);
        const float mean = s * (1.0f / 64.0f); float d[4], q = 0.f;
#pragma unroll
        for (int n = 0; n < 4; ++n) { d[n] = y[n][r] - mean; q += d[n] * d[n]; }
        q += __shfl_xor(q, 1); q += __shfl_xor(q, 2); q += __shfl_xor(q, 4); q += __shfl_xor(q, 8);
        const float rs = 1.0f / sqrtf(q * (1.0f / 64.0f) + 64e-5f);
#pragma unroll
        for (int n = 0; n < 4; ++n) { const unsigned bw = (r & 2) ? bo[n].y : bo[n].x, gw_ = (r & 2) ? gg[n].y : gg[n].x;
            const float bv = (r & 1) ? __uint_as_float(bw & 0xffff0000u) : __uint_as_float(bw << 16), gv = (r & 1) ? __uint_as_float(gw_ & 0xffff0000u) : __uint_as_float(gw_ << 16);
            *(RW_LAS unsigned short*)(stage + ((4 * g + r) * 64 + 16 * n + c) * 2) = f2b((d[n] * rs * lw[n] + lb[n] + bv) * gv); }
    }
    asm volatile("s_waitcnt lgkmcnt(0)" ::: "memory");
    unsigned short* mix = C.MIX + ((size_t)b * T_ + (size_t)chunk * 64 + 16 * i) * 1024 + h * 64;
#pragma unroll
    for (int rr = 0; rr < 2; ++rr) { const int row = (lane >> 3) + 8 * rr; const u32x4 v = *(const RW_LAS u32x4*)(stage + (row * 64 + (lane & 7) * 8) * 2); *(u32x4*)(mix + (size_t)row * 1024 + (lane & 7) * 8) = v; }
    asm volatile("s_waitcnt lgkmcnt(0)" ::: "memory");
}
#undef RW_ZERO
}

constexpr int NWAVES = 8;
#ifndef MK_N_LAUNCHES
#define MK_N_LAUNCHES 1
#endif
constexpr int PER_PHASE = 10;
constexpr int N_LAUNCHES = MK_N_LAUNCHES;

constexpr int BATCH = 4, T = 8192, D = 1024, M = BATCH * T;
constexpr int IN_W = 3336, NU = 3328;
constexpr int RW = 512, NH = 8, HD = 64;
constexpr int C_R = 0, C_K = 512, C_V = 1024, C_WL = 1536, C_AL = 1600, C_GL = 1664, C_FQ = 1792, C_FK = 2304, C_FV = 2816;
constexpr int NE = 32, TOPK = 4, DFF = 1024, NH1 = 2 * DFF;
constexpr int NSLOTS = M * TOPK + NE * 256;
constexpr float RMS_EPS = 1e-5f, GN_EPS = 64e-5f;
constexpr float LOG2E = 1.4426950408889634f;

constexpr size_t MiB = 1u << 20;
constexpr size_t WS_CTL = 0, CTL_ZERO_BYTES = 1 * MiB;
constexpr size_t WS_WIN = 2 * MiB, WS_WOUT = 9 * MiB, WS_W1 = 12 * MiB, WS_W2 = 140 * MiB;
constexpr size_t WS_XN = 204 * MiB;
constexpr size_t WS_U = 268 * MiB;
constexpr size_t WS_MIX = 476 * MiB;
constexpr size_t WS_X1 = 408 * MiB;
constexpr size_t WS_ACT = 268 * MiB;
constexpr size_t WS_Y2 = 540 * MiB;
constexpr size_t WS_LF = 812 * MiB, WS_CK = 813 * MiB;
constexpr size_t WS_ELIST = 814 * MiB;
constexpr size_t WS_TOKSLOT = 818 * MiB, WS_GATE = 819 * MiB;
constexpr size_t WS_RWT = 11 * MiB + 512 * 1024;
constexpr size_t WS_LORA = 11 * MiB;
constexpr size_t WS_REC = 540 * MiB;
constexpr size_t WS_BON = 820 * MiB, WS_GG = 852 * MiB, WS_SREC = 884 * MiB;
constexpr size_t WS_END = 916 * MiB;
static_assert(WS_REC + (size_t)4096 * rw::UNIT_BYTES <= 812 * MiB, "RWKV records fit the Y2 overlay");
constexpr int CW_TMO = 0, CW_CODE = 1;
constexpr int CW_BAR = 4096;
constexpr int CW_CNT = 8192;
constexpr int CW_AQ = 12288, CW_XQ = 12352, CW_XN = 12416;
constexpr int XW_LIMIT = 40;
constexpr int CW_QK = 12544;

constexpr int RING_OFF = 0, RING_BYTES = 131072;
constexpr int LDSCTL_OFF = 153600, MISC_OFF = LDSCTL_OFF + 320;
constexpr int LCNT_OFF = LDSCTL_OFF + 1024, LBASE_OFF = LCNT_OFF + 128, TPRE_OFF = LBASE_OFF + 128, ECNT_OFF = TPRE_OFF + 256;
constexpr int LDS_BYTES = 157696;
static_assert(rw::PART_A_LDS <= LDSCTL_OFF && RING_BYTES <= LDSCTL_OFF, "phase scratch below the control words");
static_assert(ECNT_OFF + 128 <= LDS_BYTES, "LDS map");

#define GAS __attribute__((address_space(1)))
#define LAS __attribute__((address_space(3)))
typedef unsigned short bf16;
typedef unsigned v4u __attribute__((ext_vector_type(4)));
typedef float f32x4 __attribute__((ext_vector_type(4)));
typedef short bf16x8 __attribute__((ext_vector_type(8)));
typedef GAS unsigned gu32;
typedef GAS unsigned long long gu64;
#define RLX_AGENT __ATOMIC_RELAXED, __HIP_MEMORY_SCOPE_AGENT
#define LDS_WAIT() asm volatile("s_waitcnt lgkmcnt(0)" ::: "memory")
#define VM_WAIT() asm volatile("s_waitcnt vmcnt(0)" ::: "memory")
__device__ __forceinline__ unsigned long long rt() { return __builtin_amdgcn_s_memrealtime(); }
__device__ __forceinline__ unsigned f2bf(float f) { unsigned u = __builtin_bit_cast(unsigned, f); return (u + 0x7fffu + ((u >> 16) & 1u)) >> 16; }
__device__ __forceinline__ unsigned pk2(float lo, float hi) { return f2bf(lo) | (f2bf(hi) << 16); }

#define XB_TMO      128
#define XB_XCNT(j)  (256  + 64 * (j))
#define XB_XSUB(j)  (1280 + 64 * (j))
#define XB_XGEN(j)  (2304 + 64 * (j))
#define XB_TOP      3328
#define XB_TOPGEN   3392
#define XCD_BAR_WORDS 3456
#define XB_SPIN_CAP (1u << 18)

__device__ __forceinline__ unsigned xb_ld(unsigned* p)              { return __hip_atomic_load(p, __ATOMIC_RELAXED, __HIP_MEMORY_SCOPE_AGENT); }
__device__ __forceinline__ unsigned xb_add(unsigned* p, unsigned v) { return __hip_atomic_fetch_add(p, v, __ATOMIC_RELAXED, __HIP_MEMORY_SCOPE_AGENT); }
__device__ __forceinline__ unsigned xb_xcc_id() { return (unsigned)__builtin_amdgcn_s_getreg((3 << 11) | 20) & 0xFu; }
#define XB_SPIN(cond, bar) do { unsigned _sp = 0; while (cond) { __builtin_amdgcn_s_sleep(1); \
    if ((++_sp & 255u) == 0u) { if (xb_ld(&(bar)[XB_TMO])) break; if (_sp > XB_SPIN_CAP) { atomicAdd(&(bar)[XB_TMO], 1u); break; } } } } while (0)

struct XcdBarrier {
    unsigned* bar; unsigned x;
    volatile LAS unsigned* st;
};

__device__ __forceinline__ XcdBarrier xcd_barrier_post(unsigned* bar, volatile LAS unsigned* st) {
    XcdBarrier b; b.bar = bar; b.x = xb_xcc_id(); b.st = st;
    if (threadIdx.x == 0) (void)xb_add(&bar[XB_XCNT(b.x)], 1u);
    return b;
}
__device__ __forceinline__ void xcd_barrier_complete(unsigned* bar, unsigned x, unsigned& nloc, unsigned& nx) {
    const unsigned G = gridDim.x * gridDim.y * gridDim.z;
    unsigned sum, cnt, mine, sp = 0u;
    for (;;) {
        sum = 0u; cnt = 0u; mine = 0u;
#pragma unroll
        for (unsigned j = 0; j < 16; ++j) { const unsigned c = xb_ld(&bar[XB_XCNT(j)]); sum += c; cnt += (c > 0u) ? 1u : 0u; mine = (j == x) ? c : mine; }
        if (sum == G) break;
        __builtin_amdgcn_s_sleep(1);
        if ((++sp & 255u) == 0u) { if (xb_ld(&bar[XB_TMO])) break; if (sp > XB_SPIN_CAP) { atomicAdd(&bar[XB_TMO], 1u); break; } }
    }
    nloc = mine > 0u ? mine : 1u; nx = cnt > 0u ? cnt : 1u;
}

__device__ __forceinline__ void xcd_barrier(const XcdBarrier& b) {
    asm volatile("s_waitcnt vmcnt(0)" ::: "memory");
    __syncthreads();
    if (threadIdx.x == 0) {
        unsigned* bar = b.bar;
        __builtin_amdgcn_s_waitcnt(0);
        unsigned nloc = b.st[0], nx = b.st[1];
        if (nloc == 0u) { xcd_barrier_complete(bar, b.x, nloc, nx); b.st[0] = nloc; b.st[1] = nx; }
        const unsigned old = xb_add(&bar[XB_XSUB(b.x)], 1u);
        const unsigned gen = old / nloc;
        if (old + 1u == (gen + 1u) * nloc) {
            __builtin_amdgcn_fence(__ATOMIC_RELEASE, "agent");
            asm volatile("s_waitcnt vmcnt(0)" ::: "memory");
            const unsigned og = xb_add(&bar[XB_TOP], 1u);
            const unsigned tg = og / nx;
            if (og + 1u == (tg + 1u) * nx) xb_add(&bar[XB_TOPGEN], 1u);
            else XB_SPIN(xb_ld(&bar[XB_TOPGEN]) == tg, bar);
            __builtin_amdgcn_fence(__ATOMIC_ACQUIRE, "agent");
            xb_add(&bar[XB_XGEN(b.x)], 1u);
            asm volatile("s_waitcnt vmcnt(0)" ::: "memory");
        } else {
            XB_SPIN(xb_ld(&bar[XB_XGEN(b.x)]) == gen, bar);
            __builtin_amdgcn_fence(__ATOMIC_ACQUIRE, "agent");
            asm volatile("s_waitcnt vmcnt(0)" ::: "memory");
        }
    }
    __syncthreads();
}
struct Frame {
    LAS unsigned char* lds;
    volatile LAS unsigned* MISC;
    gu32* ctl;
    int tid, lane, wave;
    int vcu, G;
    const float* const __attribute__((address_space(4)))* in;
    float* out; unsigned char* ws;
};
enum { I_X = 0, I_ANG, I_WIN, I_MU, I_W0, I_WUP, I_A0, I_AUP, I_GUP, I_KK, I_KA, I_RK, I_LNW, I_LNB, I_FB, I_OG, I_WOUT, I_FNG, I_RW, I_RB, I_W1, I_B1, I_W2, I_B2, I_FIN };

__device__ __forceinline__ float wave_sum(float v) {
#define WS_DPP(ctrl, rmask) v += __uint_as_float((unsigned)__builtin_amdgcn_update_dpp(0, (int)__float_as_uint(v), ctrl, rmask, 0xF, false))
    WS_DPP(0xB1, 0xF); WS_DPP(0x4E, 0xF); WS_DPP(0x141, 0xF); WS_DPP(0x140, 0xF);
    WS_DPP(0x142, 0xA); WS_DPP(0x143, 0xC);
#undef WS_DPP
    return __uint_as_float((unsigned)__builtin_amdgcn_readlane((int)__float_as_uint(v), 63));
}
__device__ __forceinline__ float bf2f(bf16 b) { return __uint_as_float((unsigned)b << 16); }
__device__ __forceinline__ float sigmoidf_(float x) { return 1.0f / (1.0f + __expf(-x)); }

struct XwRegs { f32x4 v[8]; };
__device__ __forceinline__ void p0_transpose_load(XwRegs& R, const float* W, int ldw, int ncols, int item, int lane) {
    const int nblk = ncols / 32, kb = item / nblk, nb = item % nblk, k0 = 64 * kb, n0 = 32 * nb;
#pragma unroll
    for (int i = 0; i < 8; ++i) { const int kk = 8 * i + (lane >> 3); R.v[i] = __builtin_nontemporal_load((const f32x4*)(W + (size_t)(k0 + kk) * ldw + n0 + 4 * (lane & 7))); }
}
template <bool FP8> __device__ __forceinline__ void p0_transpose_finish(const XwRegs& R, int K, int ncols, bf16* WT, LAS float* scr, int item, int lane) {
    const int nblk = ncols / 32, kb = item / nblk, nb = item % nblk, k0 = 64 * kb, n0 = 32 * nb;
#pragma unroll
    for (int i = 0; i < 8; ++i) { const int kk = 8 * i + (lane >> 3); LAS float* d = scr + kk * 33 + 4 * (lane & 7); d[0] = R.v[i].x; d[1] = R.v[i].y; d[2] = R.v[i].z; d[3] = R.v[i].w; }
    LDS_WAIT(); asm volatile("" ::: "memory");
    const int c = lane & 7;
#pragma unroll
    for (int j = 0; j < 4; ++j) { const int n = (lane >> 3) + 8 * j; const LAS float* s = scr + (8 * c) * 33 + n;
        if constexpr (FP8) { int w0 = __builtin_amdgcn_cvt_pk_fp8_f32(s[0 * 33] * 64.f, s[1 * 33] * 64.f, 0, false); w0 = __builtin_amdgcn_cvt_pk_fp8_f32(s[2 * 33] * 64.f, s[3 * 33] * 64.f, w0, true);
            int w1 = __builtin_amdgcn_cvt_pk_fp8_f32(s[4 * 33] * 64.f, s[5 * 33] * 64.f, 0, false); w1 = __builtin_amdgcn_cvt_pk_fp8_f32(s[6 * 33] * 64.f, s[7 * 33] * 64.f, w1, true);
            typedef int i32x2_ __attribute__((ext_vector_type(2))); *(i32x2_*)((unsigned char*)WT + (size_t)(n0 + n) * K + k0 + 8 * c) = (i32x2_){w0, w1}; }
        else { v4u o; o.x = pk2(s[0 * 33], s[1 * 33]); o.y = pk2(s[2 * 33], s[3 * 33]); o.z = pk2(s[4 * 33], s[5 * 33]); o.w = pk2(s[6 * 33], s[7 * 33]);
        *(GAS v4u*)(WT + (size_t)(n0 + n) * K + k0 + 8 * c) = o; } }
    LDS_WAIT(); asm volatile("" ::: "memory");
}
template <bool FP8> __device__ __forceinline__ void p0_transpose_item(const float* W, int K, int ldw, int ncols, bf16* WT, LAS float* scr, int item, int lane) {
    XwRegs R; p0_transpose_load(R, W, ldw, ncols, item, lane); p0_transpose_finish<FP8>(R, K, ncols, WT, scr, item, lane);
}

__device__ __forceinline__ void p0_prologue(Frame& F) {
    LAS float* scr = (LAS float*)(F.lds + RING_OFF + F.wave * 16384);
    const int gw = F.vcu * NWAVES + F.wave, NGW = F.G * NWAVES;
    constexpr int I_IN = (D / 64) * (NU / 32), I_O = (D / 64) * (D / 32), I_1 = (D / 64) * (NH1 / 32), I_2 = (DFF / 64) * (D / 32);
    constexpr int NITEMS = I_IN + I_O;
    bf16* WIN_T = (bf16*)(F.ws + WS_WIN); bf16* WOUT_T = (bf16*)(F.ws + WS_WOUT); bf16* W1_T = (bf16*)(F.ws + WS_W1); bf16* W2_T = (bf16*)(F.ws + WS_W2);
    for (int it = gw; it < NITEMS; it += NGW) {
        int r = it;
        if (r < I_IN) { p0_transpose_item<false>(F.in[I_WIN], D, IN_W, NU, WIN_T, scr, r, F.lane); continue; } r -= I_IN;
        p0_transpose_item<false>(F.in[I_WOUT], D, D, D, WOUT_T, scr, r, F.lane);
    }
    { bf16* WUPT = (bf16*)(F.ws + WS_LORA); bf16* AUPT = WUPT + RW * 64; bf16* GUPT = AUPT + RW * 64;
      for (int i = (F.vcu * NWAVES + F.wave) * 64 + F.lane; i < RW * 64; i += F.G * NWAVES * 64) { const int c = i >> 6, j = i & 63; WUPT[i] = (bf16)f2bf(F.in[I_WUP][j * RW + c]); AUPT[i] = (bf16)f2bf(F.in[I_AUP][j * RW + c]); }
      for (int i = (F.vcu * NWAVES + F.wave) * 64 + F.lane; i < RW * 128; i += F.G * NWAVES * 64) { const int c = i >> 7, j = i & 127; GUPT[i] = (bf16)f2bf(F.in[I_GUP][j * RW + c]); }
      bf16* RWH = (bf16*)(F.ws + WS_RWT); bf16* RWL = RWH + NE * D;
      for (int i = (F.vcu * NWAVES + F.wave) * 64 + F.lane; i < NE * D; i += F.G * NWAVES * 64) { const int e = i >> 10, k = i & 1023; const float w = F.in[I_RW][k * NE + e]; const unsigned h_ = f2bf(w); RWH[i] = (bf16)h_; RWL[i] = (bf16)f2bf(w - __uint_as_float(h_ << 16)); } }
    __syncthreads();
    LAS float* wfl = (LAS float*)(F.lds + RING_OFF);
    for (int k = F.tid; k < D; k += NWAVES * 64) {
#pragma unroll
        for (int j = 0; j < 8; ++j) wfl[j * D + k] = F.in[I_WIN][(size_t)k * IN_W + NU + j];
    }
    __syncthreads();
    bf16* XN = (bf16*)(F.ws + WS_XN); float* LF = (float*)(F.ws + WS_LF);
    const float* g = F.in[I_ANG];
    f32x4 gnv[4];
#pragma unroll
    for (int j = 0; j < 4; ++j) gnv[j] = *(const f32x4*)(g + 4 * F.lane + 256 * j);
    for (int m = gw; m < M; m += NGW) {
        const GAS f32x4* xr = (const GAS f32x4*)(F.in[I_X] + (size_t)m * D) + F.lane;
        f32x4 v[4]; float s2 = 0.f;
#pragma unroll
        for (int j = 0; j < 4; ++j) { v[j] = xr[64 * j]; s2 += (v[j].x * v[j].x + v[j].y * v[j].y) + (v[j].z * v[j].z + v[j].w * v[j].w); }
        const float rstd = 1.f / sqrtf(wave_sum(s2) * (1.f / D) + RMS_EPS);
        GAS unsigned long long* o8 = (GAS unsigned long long*)(XN + (size_t)m * D) + F.lane;
        float fl[8];
#pragma unroll
        for (int j = 0; j < 8; ++j) fl[j] = 0.f;
#pragma unroll
        for (int j = 0; j < 4; ++j) { const f32x4 gv = gnv[j]; v[j] = v[j] * rstd * gv;
            o8[64 * j] = (unsigned long long)pk2(v[j].x, v[j].y) | ((unsigned long long)pk2(v[j].z, v[j].w) << 32);
#pragma unroll
            for (int q = 0; q < 8; ++q) { const f32x4 w = *(const LAS f32x4*)(wfl + q * D + 4 * F.lane + 256 * j); fl[q] += (v[j].x * w.x + v[j].y * w.y) + (v[j].z * w.z + v[j].w * w.w); } }
        float mine = 0.f;
#pragma unroll
        for (int q = 0; q < 8; ++q) { const float s = wave_sum(fl[q]); if (F.lane == q) mine = s; }
        if (F.lane < 8) { const float z = mine + F.in[I_FB][F.lane]; const float ls = fminf(z, 0.f) - log1pf(__expf(-fabsf(z)));
            const int b = m / T, t = m % T; LF[(size_t)(b * NH + F.lane) * T + t] = ls * LOG2E; }
    }
}

constexpr int XW_I1 = (D / 64) * (NH1 / 32), XW_I2 = (DFF / 64) * (D / 32), XW_ITEMS = NE * (XW_I1 + XW_I2) / 32;
__device__ __forceinline__ void xw_item(Frame& F, int bi) {
    LAS float* scr = (LAS float*)(F.lds + RING_OFF + F.wave * 16384);
    unsigned char* W1_8 = F.ws + WS_W1; unsigned char* W2_8 = F.ws + WS_W2;
    const int r0 = bi * 32 + F.wave * 4;
    XwRegs R[4];
    if (r0 < NE * XW_I1) {
#pragma unroll
        for (int q = 0; q < 4; ++q) { const int r = r0 + q, e = r / XW_I1; p0_transpose_load(R[q], F.in[I_W1] + (size_t)e * D * NH1, NH1, NH1, r % XW_I1, F.lane); }
#pragma unroll
        for (int q = 0; q < 4; ++q) { const int r = r0 + q, e = r / XW_I1; p0_transpose_finish<true>(R[q], D, NH1, (bf16*)(W1_8 + (size_t)e * NH1 * D), scr, r % XW_I1, F.lane); }
    } else {
#pragma unroll
        for (int q = 0; q < 4; ++q) { const int r = r0 + q - NE * XW_I1, e = r / XW_I2; p0_transpose_load(R[q], F.in[I_W2] + (size_t)e * DFF * D, D, D, r % XW_I2, F.lane); }
#pragma unroll
        for (int q = 0; q < 4; ++q) { const int r = r0 + q - NE * XW_I1, e = r / XW_I2; p0_transpose_finish<true>(R[q], DFF, D, (bf16*)(W2_8 + (size_t)e * D * DFF), scr, r % XW_I2, F.lane); }
    }
}

__device__ __forceinline__ void p2_cumsum(Frame& F, int bh) {
    const float* lf = (const float*)(F.ws + WS_LF) + (size_t)bh * T; float* ck = (float*)(F.ws + WS_CK) + (size_t)bh * T;
    LAS double* wt = (LAS double*)(F.lds + RING_OFF);
    f32x4 v[4];
#pragma unroll
    for (int j = 0; j < 4; ++j) v[j] = *(const f32x4*)(lf + F.tid * 16 + 4 * j);
    double run = 0.0;
#pragma unroll
    for (int j = 0; j < 4; ++j) run += ((double)v[j].x + (double)v[j].y) + ((double)v[j].z + (double)v[j].w);
    double incl = run;
#pragma unroll
    for (int o = 1; o < 64; o <<= 1) { const double n = __shfl_up(incl, o); if (F.lane >= o) incl += n; }
    if (F.lane == 63) wt[F.wave] = incl;
    __syncthreads();
    double acc = incl - run;
    for (int j = 0; j < F.wave; ++j) acc += wt[j];
#pragma unroll
    for (int j = 0; j < 4; ++j) { f32x4 o; acc += (double)v[j].x; o.x = (float)acc; acc += (double)v[j].y; o.y = (float)acc; acc += (double)v[j].z; o.z = (float)acc; acc += (double)v[j].w; o.w = (float)acc; *(f32x4*)(ck + F.tid * 16 + 4 * j) = o; }
    __syncthreads();
}

__device__ __forceinline__ float row_max16(float v) {
#define RM_DPP(ctrl) v = fmaxf(v, __uint_as_float((unsigned)__builtin_amdgcn_update_dpp(0, (int)__float_as_uint(v), ctrl, 0xF, 0xF, true)))
    RM_DPP(0xB1); RM_DPP(0x4E); RM_DPP(0x141); RM_DPP(0x140);
#undef RM_DPP
    return v;
}
__device__ __forceinline__ int row_min16(int v) {
#define RM_DPP(ctrl) { const int o_ = __builtin_amdgcn_update_dpp(0, v, ctrl, 0xF, 0xF, true); v = o_ < v ? o_ : v; }
    RM_DPP(0xB1); RM_DPP(0x4E); RM_DPP(0x141); RM_DPP(0x140);
#undef RM_DPP
    return v;
}
__device__ __forceinline__ void p6_route(Frame& F) {
    typedef short bf16x8_ __attribute__((ext_vector_type(8)));
    LAS unsigned* lcnt = (LAS unsigned*)(F.lds + LCNT_OFF); LAS unsigned* lbase = (LAS unsigned*)(F.lds + LBASE_OFF);
    const bf16* X1 = (const bf16*)(F.ws + WS_X1); unsigned char* XN8 = F.ws + WS_XN; const float* g2 = F.in[I_FNG];
    const bf16* RWH = (const bf16*)(F.ws + WS_RWT); const bf16* RWL = RWH + NE * D;
    int* ELIST = (int*)(F.ws + WS_ELIST); int* TOKSLOT = (int*)(F.ws + WS_TOKSLOT); float* GATE = (float*)(F.ws + WS_GATE);
    const int lane = F.lane, c = lane & 15, g = lane >> 4;
    if (F.tid < NE) lcnt[F.tid] = 0u;
    __syncthreads();
    for (int blk = F.vcu; blk < M / 128; blk += F.G) {
        const int m0 = blk * 128 + F.wave * 16;
        const bf16* xr = X1 + (size_t)(m0 + c) * D + 8 * g;
        const float* gr = g2 + 8 * g;
        const bf16* bh0 = RWH + (size_t)c * D + 8 * g; const bf16* bh1 = bh0 + 16 * D; const bf16* bl0 = RWL + (size_t)c * D + 8 * g; const bf16* bl1 = bl0 + 16 * D;
        f32x4 a0 = {0.f, 0.f, 0.f, 0.f}, a1 = {0.f, 0.f, 0.f, 0.f}; float ss = 0.f;
#pragma unroll 4
        for (int s = 0; s < 32; ++s) {
            f32x4 x0, x1; { const v4u xw_ = *(const v4u*)(xr + 32 * s); x0 = (f32x4){__uint_as_float(xw_.x << 16), __uint_as_float(xw_.x & 0xffff0000u), __uint_as_float(xw_.y << 16), __uint_as_float(xw_.y & 0xffff0000u)}; x1 = (f32x4){__uint_as_float(xw_.z << 16), __uint_as_float(xw_.z & 0xffff0000u), __uint_as_float(xw_.w << 16), __uint_as_float(xw_.w & 0xffff0000u)}; } const f32x4 g0 = *(const f32x4*)(gr + 32 * s), g1 = *(const f32x4*)(gr + 32 * s + 4);
            const bf16x8_ wh0 = *(const bf16x8_*)(bh0 + 32 * s), wh1 = *(const bf16x8_*)(bh1 + 32 * s), wl0 = *(const bf16x8_*)(bl0 + 32 * s), wl1 = *(const bf16x8_*)(bl1 + 32 * s);
            ss += (x0.x * x0.x + x0.y * x0.y) + (x0.z * x0.z + x0.w * x0.w) + (x1.x * x1.x + x1.y * x1.y) + (x1.z * x1.z + x1.w * x1.w);
            const f32x4 y0 = x0 * g0, y1 = x1 * g1;
            v4u hi; hi.x = rw::pk(y0.x, y0.y); hi.y = rw::pk(y0.z, y0.w); hi.z = rw::pk(y1.x, y1.y); hi.w = rw::pk(y1.z, y1.w);
            v4u lo; lo.x = rw::pk(y0.x - __uint_as_float(hi.x << 16), y0.y - __uint_as_float(hi.x & 0xffff0000u)); lo.y = rw::pk(y0.z - __uint_as_float(hi.y << 16), y0.w - __uint_as_float(hi.y & 0xffff0000u));
            lo.z = rw::pk(y1.x - __uint_as_float(hi.z << 16), y1.y - __uint_as_float(hi.z & 0xffff0000u)); lo.w = rw::pk(y1.z - __uint_as_float(hi.w << 16), y1.w - __uint_as_float(hi.w & 0xffff0000u));
            const bf16x8_ ah = __builtin_bit_cast(bf16x8_, hi), al = __builtin_bit_cast(bf16x8_, lo);
            a0 = __builtin_amdgcn_mfma_f32_16x16x32_bf16(ah, wh0, a0, 0, 0, 0); a1 = __builtin_amdgcn_mfma_f32_16x16x32_bf16(ah, wh1, a1, 0, 0, 0);
            a0 = __builtin_amdgcn_mfma_f32_16x16x32_bf16(ah, wl0, a0, 0, 0, 0); a1 = __builtin_amdgcn_mfma_f32_16x16x32_bf16(ah, wl1, a1, 0, 0, 0);
            a0 = __builtin_amdgcn_mfma_f32_16x16x32_bf16(al, wh0, a0, 0, 0, 0); a1 = __builtin_amdgcn_mfma_f32_16x16x32_bf16(al, wh1, a1, 0, 0, 0);
        }
        ss += __shfl_xor(ss, 16); ss += __shfl_xor(ss, 32);
        const float rstd = 1.f / sqrtf(ss * (1.f / D) + RMS_EPS);
        { unsigned char* xo = XN8 + (size_t)(m0 + c) * D + 8 * g;
          for (int s0 = 0; s0 < 32; s0 += 4) { v4u xw4[4]; f32x4 ga[4], gb[4];
#pragma unroll
              for (int q = 0; q < 4; ++q) { xw4[q] = *(const v4u*)(xr + 32 * (s0 + q)); ga[q] = *(const f32x4*)(gr + 32 * (s0 + q)); gb[q] = *(const f32x4*)(gr + 32 * (s0 + q) + 4); }
#pragma unroll
              for (int q = 0; q < 4; ++q) { const v4u xw_ = xw4[q];
                  const f32x4 x0 = {__uint_as_float(xw_.x << 16), __uint_as_float(xw_.x & 0xffff0000u), __uint_as_float(xw_.y << 16), __uint_as_float(xw_.y & 0xffff0000u)}, x1 = {__uint_as_float(xw_.z << 16), __uint_as_float(xw_.z & 0xffff0000u), __uint_as_float(xw_.w << 16), __uint_as_float(xw_.w & 0xffff0000u)};
                  const f32x4 y0 = x0 * ga[q] * rstd, y1 = x1 * gb[q] * rstd;
                  int w0 = __builtin_amdgcn_cvt_pk_fp8_f32(y0.x, y0.y, 0, false); w0 = __builtin_amdgcn_cvt_pk_fp8_f32(y0.z, y0.w, w0, true);
                  int w1 = __builtin_amdgcn_cvt_pk_fp8_f32(y1.x, y1.y, 0, false); w1 = __builtin_amdgcn_cvt_pk_fp8_f32(y1.z, y1.w, w1, true);
                  typedef int i32x2_ __attribute__((ext_vector_type(2))); *(i32x2_*)(xo + 32 * (s0 + q)) = (i32x2_){w0, w1}; } } }
        const float rb0 = F.in[I_RB][c], rb1 = F.in[I_RB][16 + c];
        int pe = 0; float pg = 0.f;
#pragma unroll
        for (int r = 0; r < 4; ++r) { const float rs = __shfl(rstd, 4 * g + r); float v0 = a0[r] * rs + rb0, v1 = a1[r] * rs + rb1;
            float tv[4]; int ti[4];
#pragma unroll
            for (int k = 0; k < 4; ++k) { const bool first = v0 >= v1; const float bv = first ? v0 : v1; const int be = first ? c : 16 + c;
                const float mx = row_max16(bv); const int wi = row_min16(bv == mx ? be : 99);
                tv[k] = mx; ti[k] = wi; if (wi == c) v0 = -INFINITY; if (wi == 16 + c) v1 = -INFINITY; }
            const float e1 = __expf(tv[1] - tv[0]), e2 = __expf(tv[2] - tv[0]), e3 = __expf(tv[3] - tv[0]); const float inv = 1.f / (1.f + e1 + e2 + e3);
            if ((c >> 2) == r) { const int k = c & 3; pe = k == 0 ? ti[0] : k == 1 ? ti[1] : k == 2 ? ti[2] : ti[3]; pg = (k == 0 ? 1.f : k == 1 ? e1 : k == 2 ? e2 : e3) * inv; } }
        const int ptok = m0 + 4 * g + (c >> 2);
        const unsigned lpos = atomicAdd((unsigned*)(lcnt + pe), 1u);
        __syncthreads();
        if (F.tid < NE) { const unsigned n = lcnt[F.tid]; lbase[F.tid] = n ? __hip_atomic_fetch_add((unsigned*)(F.ctl + CW_CNT + 64 * F.tid), n, RLX_AGENT) : 0u; }
        __syncthreads();
        const unsigned p = lbase[pe] + lpos;
        ELIST[(size_t)pe * M + p] = ptok; TOKSLOT[ptok * 4 + (c & 3)] = (pe << 16) | (int)p; GATE[ptok * 4 + (c & 3)] = pg;
        __syncthreads();
        if (F.tid < NE) lcnt[F.tid] = 0u;
        __syncthreads();
    }
}

__device__ __forceinline__ void moe_prefix(Frame& F) {
    LAS int* tpre = (LAS int*)(F.lds + TPRE_OFF); LAS int* ecnt = (LAS int*)(F.lds + ECNT_OFF);
    if (F.tid < NE) ecnt[F.tid] = (int)__hip_atomic_load((unsigned*)(F.ctl + CW_CNT + 64 * F.tid), RLX_AGENT);
    __syncthreads();
    if (F.tid == 0) { int run = 0; for (int e = 0; e < NE; ++e) { tpre[e] = run; run += (ecnt[e] + 255) >> 8; } tpre[NE] = run; }
    __syncthreads();
}
struct MoeOrder {
    const LAS int* tpre; const LAS int* ecnt; int nN, G, c;
    __device__ __forceinline__ bool next(int i, pg8::Unit& u) const {
        const int ux = i * (G >> 3) + (c >> 3), pm = 8 * (ux / nN) + (c & 7); const int ntl = __builtin_amdgcn_readfirstlane(tpre[NE]); if (pm >= ntl) return false;
        const int L = ux; int e = 0;
        for (int j = 1; j < NE; ++j) { if (__builtin_amdgcn_readfirstlane(tpre[j]) <= pm) e = j; }
        u.pm = pm; u.pn = L % nN; u.e = e; u.l0 = (pm - __builtin_amdgcn_readfirstlane(tpre[e])) * 256; u.cnt = __builtin_amdgcn_readfirstlane(ecnt[e]); return true;
    }
    __device__ __forceinline__ void a_ready(const pg8::Unit&) const {}
    __device__ __forceinline__ void done(const pg8::Unit&) const {}
};

__device__ __forceinline__ void p9_final(Frame& F) {
    const int gw = F.vcu * NWAVES + F.wave, NGW = F.G * NWAVES, lane = F.lane;
    const LAS int* tpre = (const LAS int*)(F.lds + TPRE_OFF);
    const bf16* Y2 = (const bf16*)(F.ws + WS_Y2); const int* TOKSLOT = (const int*)(F.ws + WS_TOKSLOT); const float* GATE = (const float*)(F.ws + WS_GATE);
    const float* gf = F.in[I_FIN];
    int ts[4]; float gt[4];
    f32x4 gfv[4];
#pragma unroll
    for (int j = 0; j < 4; ++j) gfv[j] = *(const f32x4*)(gf + 4 * lane + 256 * j);
#pragma unroll
    for (int k = 0; k < 4; ++k) { ts[k] = TOKSLOT[gw * 4 + k]; gt[k] = GATE[gw * 4 + k]; }
    for (int m = gw; m < M; m += NGW) {
        GAS f32x4* xr = (GAS f32x4*)(F.out + (size_t)m * D) + lane;
        const GAS unsigned long long* x1r = (const GAS unsigned long long*)((const bf16*)(F.ws + WS_X1) + (size_t)m * D) + lane;
        f32x4 v[4];
#pragma unroll
        for (int j = 0; j < 4; ++j) { const unsigned long long w_ = x1r[64 * j]; const unsigned lo_ = (unsigned)w_, hi_ = (unsigned)(w_ >> 32);
            v[j] = (f32x4){__uint_as_float(lo_ << 16), __uint_as_float(lo_ & 0xffff0000u), __uint_as_float(hi_ << 16), __uint_as_float(hi_ & 0xffff0000u)}; }
        int yw[4][4]; float gc[4];
#pragma unroll
        for (int k = 0; k < 4; ++k) { const int e = ts[k] >> 16, p = ts[k] & 0xffff; gc[k] = gt[k] * 0.25f;
            const size_t row = (size_t)tpre[e] * 256 + p; const GAS int* yr = (const GAS int*)((const unsigned char*)Y2 + row * D) + lane;
#pragma unroll
            for (int j = 0; j < 4; ++j) yw[k][j] = yr[64 * j]; }
        { const int mn = (m + NGW < M) ? m + NGW : m;
#pragma unroll
          for (int k = 0; k < 4; ++k) { ts[k] = TOKSLOT[mn * 4 + k]; gt[k] = GATE[mn * 4 + k]; } }
#pragma unroll
        for (int k = 0; k < 4; ++k)
#pragma unroll
            for (int j = 0; j < 4; ++j) { const int w = yw[k][j]; const float g_ = gc[k];
                v[j].x += g_ * __builtin_amdgcn_cvt_f32_fp8(w, 0); v[j].y += g_ * __builtin_amdgcn_cvt_f32_fp8(w, 1); v[j].z += g_ * __builtin_amdgcn_cvt_f32_fp8(w, 2); v[j].w += g_ * __builtin_amdgcn_cvt_f32_fp8(w, 3); }
        float s2 = 0.f;
#pragma unroll
        for (int j = 0; j < 4; ++j) s2 += (v[j].x * v[j].x + v[j].y * v[j].y) + (v[j].z * v[j].z + v[j].w * v[j].w);
        const float rstd = 1.f / sqrtf(wave_sum(s2) * (1.f / D) + RMS_EPS);
#pragma unroll
        for (int j = 0; j < 4; ++j) xr[64 * j] = v[j] * rstd * gfv[j];
    }
}

struct Args { const float* in[25]; float* out; unsigned char* ws; int ph_lo, ph_hi, li, pad; };
__global__ void __launch_bounds__(NWAVES * 64, 2) mk_fwd(Args args) {
    extern __shared__ __attribute__((aligned(16))) unsigned char lds[];
    Frame F;
    F.lds = (LAS unsigned char*)lds;
    F.MISC = (volatile LAS unsigned*)(F.lds + MISC_OFF);
    F.tid = threadIdx.x; F.lane = F.tid & 63; F.wave = __builtin_amdgcn_readfirstlane(F.tid >> 6);
    F.G = gridDim.x; { const int bx = blockIdx.x; F.vcu = (F.G % 8 == 0) ? (bx % 8) * (F.G / 8) + bx / 8 : bx; }
    F.in = (const float* const __attribute__((address_space(4)))*)__builtin_amdgcn_kernarg_segment_ptr();
    F.out = args.out; F.ws = args.ws; F.ctl = (gu32*)(args.ws + WS_CTL);
    for (int u = F.tid; u < (LDS_BYTES - LDSCTL_OFF) / 4; u += NWAVES * 64) ((LAS unsigned*)(F.lds + LDSCTL_OFF))[u] = 0u;
    __syncthreads();
    XcdBarrier bar; bar.bar = (unsigned*)(F.ctl + CW_BAR); bar.x = 0; bar.st = nullptr;
    if (N_LAUNCHES != PER_PHASE) bar = xcd_barrier_post((unsigned*)(F.ctl + CW_BAR), F.MISC + 8);
#define GRID_BAR(seam) do { if (N_LAUNCHES == PER_PHASE) { if (F.tid == 0) __hip_atomic_store(F.ctl + CW_TMO, 0xBADBA0u | (unsigned)(seam), RLX_AGENT); } else { xcd_barrier(bar); } } while (0)
    const int lo = args.ph_lo, hi = args.ph_hi;
#define STAMP(k) do { if (TS_PROBE >= 0 && TS_PROBE < 100 && blockIdx.x == 0 && F.tid == 0) { const unsigned long long ts_ = __builtin_amdgcn_s_memrealtime(); F.MISC[32 + 2 * (k)] = (unsigned)ts_; F.MISC[33 + 2 * (k)] = (unsigned)(ts_ >> 32); } } while (0)
    STAMP(0);
#define IN(k) (lo <= (k) && (k) < hi)
#define BOTH(k) (IN(k) && IN((k) + 1))
    bf16* WIN_T = (bf16*)(F.ws + WS_WIN); bf16* WOUT_T = (bf16*)(F.ws + WS_WOUT); bf16* W1_T = (bf16*)(F.ws + WS_W1); bf16* W2_T = (bf16*)(F.ws + WS_W2);
    bf16* XN = (bf16*)(F.ws + WS_XN); bf16* U = (bf16*)(F.ws + WS_U); bf16* MIX = (bf16*)(F.ws + WS_MIX); bf16* ACT = (bf16*)(F.ws + WS_ACT); bf16* Y2 = (bf16*)(F.ws + WS_Y2);

    if (IN(0)) { _Pragma("unroll") for (int rep_ = 0; rep_ < DUPN(0); ++rep_) p0_prologue(F); if (BOTH(0)) GRID_BAR(0); STAMP(1); }

    if (IN(1)) {
        pg8::Gemm g{XN, WIN_T, D, 0, nullptr, 0}; pg8::StaticOrder S; S.init(M, NU, F.G, (int)blockIdx.x);
        pg8::EpiU E{U, NU, C_FQ / 256, C_FK / 256, attn_body::C2};
        _Pragma("unroll") for (int rep_ = 0; rep_ < DUPN(1); ++rep_) pg8::gemm_phase<pg8::EpiU, pg8::StaticOrder, false, PG8_ALIGN, PG8_SP2>(F.lds + RING_OFF, g, S, E);
        if (BOTH(1)) GRID_BAR(1); STAMP(2);
    }

    if (IN(2)) {
      _Pragma("unroll") for (int rep_ = 0; rep_ < DUPN(2); ++rep_) {
        _Pragma("unroll") for (int r2_ = 0; r2_ < DUPN(11); ++r2_) if (F.vcu < BATCH * NH) p2_cumsum(F, F.vcu);
        _Pragma("unroll") for (int r2_ = 0; r2_ < DUPN(10); ++r2_) { const int gw = F.vcu * NWAVES + F.wave, bh = gw & 31, b = bh / NH, h = bh % NH; float qm = 0.f, km = 0.f;
          {
            const bf16* ub = U + ((size_t)b * T + (size_t)(gw >> 5) * 128 + (F.lane >> 3)) * NU + h * HD + (F.lane & 7) * 8;
            v4u qv[16], kv[16];
#pragma unroll
            for (int i = 0; i < 16; ++i) { qv[i] = *(const v4u*)(ub + (size_t)i * 8 * NU + C_FQ); kv[i] = *(const v4u*)(ub + (size_t)i * 8 * NU + C_FK); }
#pragma unroll
            for (int i = 0; i < 16; ++i) { float sq = 0.f, sk = 0.f;
#pragma unroll
                for (int e = 0; e < 4; ++e) { const float q0 = __uint_as_float(qv[i][e] << 16), q1 = __uint_as_float(qv[i][e] & 0xffff0000u), k0 = __uint_as_float(kv[i][e] << 16), k1 = __uint_as_float(kv[i][e] & 0xffff0000u);
                    sq += q0 * q0 + q1 * q1; sk += k0 * k0 + k1 * k1; }
                qm = fmaxf(qm, sq + 0.f); km = fmaxf(km, sk); qv[i].x = __float_as_uint(sq); kv[i].x = __float_as_uint(sk); }
            qm = 0.f; km = 0.f;
#pragma unroll
            for (int i = 0; i < 16; ++i) { float sq = __uint_as_float(qv[i].x), sk = __uint_as_float(kv[i].x);
#define NR_DPP(v, ctrl) v += __uint_as_float((unsigned)__builtin_amdgcn_update_dpp(0, (int)__float_as_uint(v), ctrl, 0xF, 0xF, true))
                NR_DPP(sq, 0xB1); NR_DPP(sq, 0x4E); NR_DPP(sq, 0x141); NR_DPP(sk, 0xB1); NR_DPP(sk, 0x4E); NR_DPP(sk, 0x141);
#undef NR_DPP
                qm = fmaxf(qm, sq); km = fmaxf(km, sk); }
#pragma unroll
            for (int o = 8; o < 64; o <<= 1) { qm = fmaxf(qm, __shfl_xor(qm, o)); km = fmaxf(km, __shfl_xor(km, o)); } }
          if (F.lane == 0) { __hip_atomic_fetch_max((unsigned*)(F.ctl + CW_QK + 64 * bh), __float_as_uint(sqrtf(qm)), RLX_AGENT); __hip_atomic_fetch_max((unsigned*)(F.ctl + CW_QK + 64 * bh + 1), __float_as_uint(sqrtf(km)), RLX_AGENT); } }
        {
          const rw::PartA PA{F.in, F.ws, WS_U, WS_LORA, WS_REC, WS_BON, WS_GG};
          _Pragma("unroll") for (int r2_ = 0; r2_ < DUPN(9); ++r2_) for (int u = F.vcu * 16; u < 4096; u += F.G * 16)
              rw::part_a_block(PA, F.lds + RING_OFF, u >> 7, u & 127, 16, F.tid, F.MISC + 60); }
      }
        if (BOTH(2)) GRID_BAR(2); STAMP(3);
    }

    if (IN(3)) {
        const attn_body::AttnTensors AT{(const attn_body::bf16*)(U + C_FQ), (const attn_body::bf16*)(U + C_FK), (const attn_body::bf16*)(U + C_FV), (attn_body::bf16*)(MIX + RW),
                                        (const float*)(F.ws + WS_CK), F.in[I_OG]};
      {
        _Pragma("unroll") for (int r2_ = 0; r2_ < DUPN(16); ++r2_) if (F.vcu < BATCH * NH) rw::part_b_block(F.ws + WS_REC, (bf16*)(F.ws + WS_SREC), F.lds + RING_OFF, F.vcu, F.tid);
        __syncthreads();
        for (;;) {
            if (F.wave == 0) {
                int ln_ = (int)threadIdx.x; asm volatile("" : "+v"(ln_));
                unsigned jj = 0; if (ln_ == 0) { jj = __hip_atomic_fetch_add((unsigned*)(F.ctl + CW_AQ), 1u, RLX_AGENT); F.MISC[18] = 0u; }
                int j = (int)__builtin_amdgcn_readfirstlane(jj); int kt0 = 0;
                const int NQ_ = 1024 + XW_ITEMS; j = (j < NQ_) ? (((j % 5) < 2) ? (j / 5) * 2 + (j % 5) : 1024 + (j / 5) * 3 + (j % 5) - 2) : NQ_;
                if (j < BATCH * NH * (T / 256)) { const int bh = j & 31, qb = 31 - (j >> 5), q0 = qb * 256, ntf = (q0 + 256) / 64;
                    const float th = 2.0f * __uint_as_float(__hip_atomic_load((unsigned*)(F.ctl + CW_QK + 64 * bh), RLX_AGENT)) * __uint_as_float(__hip_atomic_load((unsigned*)(F.ctl + CW_QK + 64 * bh + 1), RLX_AGENT)) + 37.0f;
                    const float* ck = AT.CK + (size_t)bh * T; const int cand = 2 * ln_;
                    bool ok = false; if (cand >= 2 && cand <= ntf - 4) ok = (ck[64 * cand - 1] - ck[q0]) >= th;
                    kt0 = 2 * (int)__popcll(__ballot(ok)); }
                if (ln_ == 0) { F.MISC[16] = (unsigned)j; F.MISC[17] = (unsigned)kt0; } }
            __syncthreads();
            const int j = (int)F.MISC[16], kt0 = (int)F.MISC[17]; const unsigned lim = F.MISC[18];
            __syncthreads();
            if (j >= 1024 + XW_ITEMS) break;
            if (j >= 1024) { xw_item(F, j - 1024); if (lim && F.tid == 0) __hip_atomic_fetch_add((unsigned*)(F.ctl + CW_XN), 0xffffffffu, RLX_AGENT); continue; }
            const int bh = j & 31, qb = 31 - (j >> 5);
            attn_body::attn_unit<8>(bh / NH, bh % NH, qb, kt0, AT.Q, AT.K, AT.V, AT.O, AT.CK, AT.OG, (char*)lds + RING_OFF);
        }
      }
        if (BOTH(3)) GRID_BAR(3); STAMP(4);
    }

    if (IN(4)) {
        const rw::PartC PC{F.ws + WS_REC, (const bf16*)(F.ws + WS_SREC), (const bf16*)(F.ws + WS_BON), (const bf16*)(F.ws + WS_GG), F.in[I_LNW], F.in[I_LNB], MIX};
        _Pragma("unroll") for (int rep_ = 0; rep_ < DUPN(4); ++rep_) for (int u = F.vcu * 2 + (F.wave >> 2); u < 4096; u += F.G * 2) rw::part_c_wave(PC, F.lds + RING_OFF + F.wave * 2048, u, F.wave & 3, F.lane);
        if (BOTH(4)) GRID_BAR(4); STAMP(5);
    }

    if (IN(5)) {
        pg8::Gemm g{MIX, WOUT_T, D, 0, nullptr, 0}; pg8::StaticOrder S; S.init(M, D, F.G, (int)blockIdx.x);
        pg8::EpiRes E{F.in[I_X], (bf16*)(F.ws + WS_X1), D};
        _Pragma("unroll") for (int rep_ = 0; rep_ < DUPN(5); ++rep_) pg8::gemm_phase<pg8::EpiRes, pg8::StaticOrder, false, PG8_ALIGN, PG8_SP2>(F.lds + RING_OFF, g, S, E);
        if (BOTH(5)) GRID_BAR(5); STAMP(6);
    }

    if (IN(6)) { p6_route(F); if (BOTH(6)) GRID_BAR(6); STAMP(7); }

    if (IN(7)) {
        moe_prefix(F);
        pg8::Gemm g{XN, W1_T, D / 2, (size_t)NH1 * D / 2, (const int*)(F.ws + WS_ELIST), M};
        MoeOrder S{(const LAS int*)(F.lds + TPRE_OFF), (const LAS int*)(F.lds + ECNT_OFF), NH1 / 256, F.G, (int)blockIdx.x};
        pg8::EpiSwiglu E{(unsigned char*)ACT, DFF, F.in[I_B1], NH1};
        _Pragma("unroll") for (int rep_ = 0; rep_ < DUPN(7); ++rep_) pg8::gemm_phase<pg8::EpiSwiglu, MoeOrder, true, PG8_ALIGN, PG8_SP2, 121>(F.lds + RING_OFF, g, S, E);
        if (BOTH(7)) GRID_BAR(7); STAMP(8);
    }

    if (IN(8)) {
        if (!IN(7)) moe_prefix(F);
        pg8::Gemm g{ACT, W2_T, DFF / 2, (size_t)D * DFF / 2, nullptr, 0};
        MoeOrder S{(const LAS int*)(F.lds + TPRE_OFF), (const LAS int*)(F.lds + ECNT_OFF), D / 256, F.G, (int)blockIdx.x};
        pg8::EpiBias E{(unsigned char*)Y2, D, F.in[I_B2], D};
        _Pragma("unroll") for (int rep_ = 0; rep_ < DUPN(8); ++rep_) pg8::gemm_phase<pg8::EpiBias, MoeOrder, false, PG8_ALIGN, PG8_SP2, 121>(F.lds + RING_OFF, g, S, E);
        if (BOTH(8)) GRID_BAR(8); STAMP(9);
    }

    if (IN(9)) { if (!IN(8)) moe_prefix(F); p9_final(F); }
    STAMP(10);
    if (TS_PROBE >= 100 && blockIdx.x == 0 && F.tid == 0) {
        const unsigned long long span_ = (((unsigned long long)F.MISC[61] << 32) | F.MISC[60]) * TS_MULT, t0_ = __builtin_amdgcn_s_memrealtime();
        while (__builtin_amdgcn_s_memrealtime() - t0_ < span_) __builtin_amdgcn_s_sleep(8);
    }
    if (TS_PROBE >= 0 && TS_PROBE < 100 && blockIdx.x == 0 && F.tid == 0) {
        const unsigned long long a_ = ((unsigned long long)F.MISC[33 + 2 * TS_PROBE] << 32) | F.MISC[32 + 2 * TS_PROBE], b_ = ((unsigned long long)F.MISC[35 + 2 * TS_PROBE] << 32) | F.MISC[34 + 2 * TS_PROBE];
        const unsigned long long t0_ = __builtin_amdgcn_s_memrealtime(), span_ = (b_ - a_) * TS_MULT;
        while (__builtin_amdgcn_s_memrealtime() - t0_ < span_) __builtin_amdgcn_s_sleep(8);
    }
#undef IN
#undef BOTH
}

extern "C" void kernel_launch(void* const* d_in, const int* in_sizes, int n_in, void* d_out, int out_size, void* d_ws, size_t ws_size, hipStream_t stream) {
    static int grid = 0;
    if (grid == 0) {
        if (n_in != 25 || in_sizes[0] != M * D || out_size != M * D || ws_size < WS_END) { fprintf(stderr, "kernel_launch: unexpected shapes (n_in %d, in0 %d, out %d, ws %zu); nothing launched\n", n_in, n_in > 0 ? in_sizes[0] : -1, out_size, ws_size); grid = -1; return; }
        int dev = 0, cus = 0, per_cu = 0;
        if (hipGetDevice(&dev) != hipSuccess || hipDeviceGetAttribute(&cus, hipDeviceAttributeMultiprocessorCount, dev) != hipSuccess) { grid = -1; return; }
        if (hipFuncSetAttribute((const void*)mk_fwd, hipFuncAttributeMaxDynamicSharedMemorySize, LDS_BYTES) != hipSuccess) { fprintf(stderr, "kernel_launch: hipFuncSetAttribute failed\n"); grid = -1; return; }
        if (hipOccupancyMaxActiveBlocksPerMultiprocessor(&per_cu, (const void*)mk_fwd, NWAVES * 64, LDS_BYTES) != hipSuccess || per_cu < 1) fprintf(stderr, "kernel_launch: occupancy query reports %d\n", per_cu);
        (void)hipGetLastError();
        grid = cus;
        if (grid != 256) { fprintf(stderr, "kernel_launch: built for 256 CUs, found %d\n", grid); }
    }
    if (grid < 0) return;
    if (hipMemsetAsync((char*)d_ws + WS_CTL, 0, CTL_ZERO_BYTES, stream) != hipSuccess) return;
    Args a{};
    for (int i = 0; i < 25; ++i) a.in[i] = (const float*)d_in[i];
    a.out = (float*)d_out; a.ws = (unsigned char*)d_ws;
    for (int li = 0; li < N_LAUNCHES; ++li) {
        a.ph_lo = (N_LAUNCHES == PER_PHASE) ? li : 0; a.ph_hi = (N_LAUNCHES == PER_PHASE) ? li + 1 : PER_PHASE; a.li = li;
        hipLaunchKernelGGL(mk_fwd, dim3(grid), dim3(NWAVES * 64), LDS_BYTES, stream, a);
    }
}
```

```cpp
#ifndef DUP_MASK
#define DUP_MASK 0
#endif
#define DUPN(k) (((DUP_MASK) >> (k)) & 1 ? 2 : 1)
#ifndef TS_PROBE
#define TS_PROBE (-1)
#endif
#define TS_MULT 4
#include <hip/hip_runtime.h>
#include <cstdio>
#include <cstdint>
namespace pg8 {
#define PG8_LAS __attribute__((address_space(3)))
typedef unsigned short bf16_t;
typedef short bf16x8 __attribute__((ext_vector_type(8)));
typedef float f32x4 __attribute__((ext_vector_type(4)));
typedef unsigned u32x4 __attribute__((ext_vector_type(4)));
typedef int i32x4 __attribute__((ext_vector_type(4)));
typedef int i32x8 __attribute__((ext_vector_type(8)));
constexpr int BM = 256, BK = 64, HALF = 128, HTB = HALF * BK * 2  , STAGE_BYTES = 8 * HTB, NXCD = 8, WGM = 8;

__host__ __device__ __forceinline__ int lds_byte(int r, int c) { const int st = (r >> 4) * 2 + (c >> 5), rr = r & 15, cc = c & 31, ob = rr * 64 + cc * 2; return st * 1024 + (ob ^ (((ob >> 9) & 1) << 5)); }
__host__ __device__ __forceinline__ void stage_rc(int b, int& R, int& C) { const int st = b / 1024, sb = b % 1024, swz = sb ^ (((sb >> 9) & 1) << 5); R = (st >> 1) * 16 + swz / 64; C = (st & 1) * 32 + (swz % 64) / 2; }
__host__ __device__ __forceinline__ int perm32(int rho) { const int n = rho >> 4, i = rho & 15; return 8 * (i >> 2) + 4 * n + (i & 3); }

struct Unit { int pm, pn, e, l0, cnt; };
struct Gemm { const bf16_t* A; const bf16_t* Bt; int K; size_t bstride; const int* rows; int rows_stride; };

struct StaticOrder {
    int nM, nN, nwg, G, c;
    __host__ __device__ void init(int M, int N, int G_, int c_) { nM = M / BM; nN = N / BM; nwg = nM * nN; G = G_; c = c_; }
    __host__ __device__ bool next(int i, Unit& u) const {
        const long L = (long)i * G + c; if (L >= nwg) return false;
        int wgid = (int)L; { const int q = nwg / NXCD, r = nwg % NXCD, xcd = wgid % NXCD, off = wgid / NXCD; wgid = (xcd < r ? xcd * (q + 1) : r * (q + 1) + (xcd - r) * q) + off; }
        const int nig = WGM * nN, gid = wgid / nig, fm = gid * WGM, gsz = (nM - fm) < WGM ? (nM - fm) : WGM;
        u.pm = fm + ((wgid % nig) % gsz); u.pn = (wgid % nig) / gsz; u.e = 0; u.l0 = 0; u.cnt = 256; return true;
    }
    __device__ __forceinline__ void a_ready(const Unit&) const {}
    __device__ __forceinline__ void done(const Unit&) const {}
};

__device__ __forceinline__ unsigned cvt_pk_bf16(float lo, float hi) { unsigned r; asm volatile("v_cvt_pk_bf16_f32 %0, %1, %2" : "=v"(r) : "v"(lo), "v"(hi)); return r; }
typedef float f32x2 __attribute__((ext_vector_type(2)));
typedef unsigned u32x2 __attribute__((ext_vector_type(2)));
struct EpiU {
    static constexpr bool PERM = true, AFTER_DRAIN = false;
    bf16_t* O; int ldc; int q_lo, q_hi; float qscale;
    __device__ __forceinline__ void operator()(const f32x4 (&acc)[2][2][4][2], const Unit& u, int wr, int wc, int fr, int fq) const {
        const int row0 = u.pm * BM + wr * 64 + fr; const int col0 = u.pn * BM + wc * 32 + 8 * fq;
        const float sc = (u.pn >= q_lo && u.pn < q_hi) ? qscale : 1.f;
#pragma unroll
        for (int ai = 0; ai < 2; ++ai)
#pragma unroll
            for (int m = 0; m < 4; ++m) { bf16_t* rowp = O + (size_t)(row0 + ai * HALF + m * 16) * ldc + col0;
#pragma unroll
                for (int bj = 0; bj < 2; ++bj) { const f32x4 v0 = acc[ai][bj][m][0] * sc, v1 = acc[ai][bj][m][1] * sc;
                    u32x4 w; w.x = cvt_pk_bf16(v0[0], v0[1]); w.y = cvt_pk_bf16(v0[2], v0[3]); w.z = cvt_pk_bf16(v1[0], v1[1]); w.w = cvt_pk_bf16(v1[2], v1[3]);
                    *(u32x4*)(rowp + bj * HALF) = w; } }
    }
};
struct EpiRes {
    static constexpr bool PERM = false, AFTER_DRAIN = false;
    const float* base; bf16_t* out; int ldc;
    __device__ __forceinline__ void operator()(const f32x4 (&acc)[2][2][4][2], const Unit& u, int wr, int wc, int fr, int fq) const {
        const int col0 = u.pn * BM + wc * 32 + 4 * fq;
#pragma unroll
        for (int ai = 0; ai < 2; ++ai) {
            f32x4 pre[4][2][2];
#pragma unroll
            for (int m = 0; m < 4; ++m) { const size_t off = (size_t)(u.pm * BM + ai * HALF + wr * 64 + m * 16 + fr) * ldc + col0;
#pragma unroll
                for (int bj = 0; bj < 2; ++bj)
#pragma unroll
                    for (int n = 0; n < 2; ++n) pre[m][bj][n] = *(const f32x4*)(base + off + bj * HALF + n * 16); }
#pragma unroll
            for (int m = 0; m < 4; ++m) { const size_t off = (size_t)(u.pm * BM + ai * HALF + wr * 64 + m * 16 + fr) * ldc + col0;
#pragma unroll
                for (int bj = 0; bj < 2; ++bj)
#pragma unroll
                    for (int n = 0; n < 2; ++n) { const f32x4 v = pre[m][bj][n] + acc[ai][bj][m][n];
                        u32x2 w; w.x = cvt_pk_bf16(v[0], v[1]); w.y = cvt_pk_bf16(v[2], v[3]); *(u32x2*)(out + off + bj * HALF + n * 16) = w; } }
        }
    }
};
struct EpiSwiglu {
    static constexpr bool PERM = true, AFTER_DRAIN = false;
    unsigned char* O; int ldc; const float* bias; int nb;
    __device__ __forceinline__ static f32x2 act2(f32x4 h) {
        f32x2 g = {fminf(h[0], 7.0f), fminf(h[2], 7.0f)}, l = {fminf(fmaxf(h[1], -7.0f), 7.0f), fminf(fmaxf(h[3], -7.0f), 7.0f)};
        const f32x2 z = g * (-1.702f * 1.4426950408889634f);
        f32x2 e = {__builtin_amdgcn_exp2f(z.x), __builtin_amdgcn_exp2f(z.y)}; e = e + 1.0f;
        const f32x2 s = {__builtin_amdgcn_rcpf(e.x), __builtin_amdgcn_rcpf(e.y)};
        return (g * s) * (l + 1.0f);
    }
    __device__ __forceinline__ void operator()(const f32x4 (&acc)[2][2][4][2], const Unit& u, int wr, int wc, int fr, int fq) const {
        const int row0 = u.pm * BM + wr * 64 + fr; const int col0 = u.pn * BM + wc * 32 + 8 * fq;
        const float* bp = bias + (size_t)u.e * nb + col0;
        f32x4 bv[2][2];
#pragma unroll
        for (int bj = 0; bj < 2; ++bj)
#pragma unroll
            for (int n = 0; n < 2; ++n) bv[bj][n] = *(const f32x4*)(bp + bj * HALF + 4 * n);
#pragma unroll
        for (int ai = 0; ai < 2; ++ai)
#pragma unroll
            for (int m = 0; m < 4; ++m) { unsigned char* rowp = O + (size_t)(row0 + ai * HALF + m * 16) * ldc + (col0 >> 1);
#pragma unroll
                for (int bj = 0; bj < 2; ++bj) { const f32x4 v0 = acc[ai][bj][m][0] + bv[bj][0], v1 = acc[ai][bj][m][1] + bv[bj][1];
                    const f32x2 a0 = act2(v0), a1 = act2(v1);
                    int w = __builtin_amdgcn_cvt_pk_fp8_f32(a0.x, a0.y, 0, false); w = __builtin_amdgcn_cvt_pk_fp8_f32(a1.x, a1.y, w, true);
                    *(int*)(rowp + bj * (HALF / 2)) = w; } }
    }
};
struct EpiBias {
    static constexpr bool PERM = true, AFTER_DRAIN = false;
    unsigned char* O; int ldc; const float* bias; int nb;
    __device__ __forceinline__ void operator()(const f32x4 (&acc)[2][2][4][2], const Unit& u, int wr, int wc, int fr, int fq) const {
        const int row0 = u.pm * BM + wr * 64 + fr; const int col0 = u.pn * BM + wc * 32 + 8 * fq;
        const float* bp = bias + (size_t)u.e * nb + col0;
        f32x4 bv[2][2];
#pragma unroll
        for (int bj = 0; bj < 2; ++bj)
#pragma unroll
            for (int n = 0; n < 2; ++n) bv[bj][n] = *(const f32x4*)(bp + bj * HALF + 4 * n);
#pragma unroll
        for (int ai = 0; ai < 2; ++ai)
#pragma unroll
            for (int m = 0; m < 4; ++m) { unsigned char* rowp = O + (size_t)(row0 + ai * HALF + m * 16) * ldc + col0;
#pragma unroll
                for (int bj = 0; bj < 2; ++bj) { const f32x4 v0 = (acc[ai][bj][m][0] + bv[bj][0]) * 4.0f, v1 = (acc[ai][bj][m][1] + bv[bj][1]) * 4.0f;
                    int w0 = __builtin_amdgcn_cvt_pk_fp8_f32(v0[0], v0[1], 0, false); w0 = __builtin_amdgcn_cvt_pk_fp8_f32(v0[2], v0[3], w0, true);
                    int w1 = __builtin_amdgcn_cvt_pk_fp8_f32(v1[0], v1[1], 0, false); w1 = __builtin_amdgcn_cvt_pk_fp8_f32(v1[2], v1[3], w1, true);
                    u32x2 w; w.x = (unsigned)w0; w.y = (unsigned)w1; *(u32x2*)(rowp + bj * HALF) = w; } }
    }
};

template <class Epi, class Sched, bool GATHER, bool ALIGN_EPI = false, bool SP2 = false, int FP8SCALE = 0>
__device__ __forceinline__ void gemm_phase(PG8_LAS unsigned char* lds, const Gemm g, const Sched& S, const Epi& E) {
    const int tid = threadIdx.x, wid = __builtin_amdgcn_readfirstlane(tid >> 6), lane = tid & 63, wr = wid >> 2, wc = wid & 3, fr = lane & 15, fq = lane >> 4;
    const int K = g.K, nt = K / BK;
    unsigned voffA[2], voffB[2]; int sR[2], sC[2];
#pragma unroll
    for (int i = 0; i < 2; ++i) { int R, C; stage_rc(tid * 16 + i * 8192, R, C); const int Rb = Epi::PERM ? ((R & ~31) + perm32(R & 31)) : R; sR[i] = R; sC[i] = C;
        voffA[i] = (unsigned)(R * K + C) * 2u; voffB[i] = (unsigned)(Rb * K + C) * 2u; }
    unsigned vC[2][2], vN[2][2], vS[2][2];
#define PG8_GOFF(U, V) do { _Pragma("unroll") for (int _h = 0; _h < 2; ++_h) _Pragma("unroll") for (int _i = 0; _i < 2; ++_i) { int _ix = (U).l0 + _h * HALF + sR[_i]; _ix = _ix < (U).cnt ? _ix : (U).cnt - 1; \
        const int _tok = g.rows[(size_t)(U).e * g.rows_stride + _ix]; V[_h][_i] = (unsigned)(_tok * K + sC[_i]) * 2u; } } while (0)
#define PG8_STAGE_A(bufoff, gbase, h, VG) do { if constexpr (GATHER) { PG8_STAGE(bufoff, gbase, VG[h]); } else { PG8_STAGE(bufoff, (gbase) + (h) * hstep, voffA); } } while (0)
    const size_t kstep = (size_t)(BK * 2);
    const size_t hstep = (size_t)HALF * K * 2;
    const size_t tstep = 2 * hstep;
    const unsigned ldsw = (unsigned)wid * 1024u;
    const int aoff = lds_byte(wr * 64 + fr, fq * 8), boff = lds_byte(wc * 32 + fr, fq * 8);
#define PG8_SA(b, h) (((b) * 2 + (h)) * HTB)
#define PG8_SB(b, h) ((4 + (b) * 2 + (h)) * HTB)
#define PG8_STAGE(bufoff, gbase, voff) do { _Pragma("unroll") for (int _i = 0; _i < 2; ++_i) \
        __builtin_amdgcn_global_load_lds((const unsigned*)((const char*)(gbase) + (voff)[_i]), (PG8_LAS unsigned*)(lds + (bufoff) + ldsw + _i * 8192), 16, 0, 0); } while (0)
#define PG8_CAT(lo, hi) __builtin_shufflevector(lo, hi, 0, 1, 2, 3, 4, 5, 6, 7)
#define PG8_LDA(dst, b, h) do { _Pragma("unroll") for (int m = 0; m < 4; ++m) dst[m] = PG8_CAT(*(const PG8_LAS i32x4*)(lds + PG8_SA(b, h) + aoff + m * 2048), *(const PG8_LAS i32x4*)(lds + PG8_SA(b, h) + aoff + m * 2048 + 1024)); } while (0)
#define PG8_LDB(dst, b, h) do { _Pragma("unroll") for (int n = 0; n < 2; ++n) dst[n] = PG8_CAT(*(const PG8_LAS i32x4*)(lds + PG8_SB(b, h) + boff + n * 2048), *(const PG8_LAS i32x4*)(lds + PG8_SB(b, h) + boff + n * 2048 + 1024)); } while (0)
#define PG8_HALF(v, k) __builtin_bit_cast(bf16x8, __builtin_shufflevector(v, v, 4 * (k), 4 * (k) + 1, 4 * (k) + 2, 4 * (k) + 3))
#define PG8_MMA(ai, bj, At, Bt) do { __builtin_amdgcn_s_setprio(1); _Pragma("unroll") for (int m = 0; m < 4; ++m) _Pragma("unroll") for (int n = 0; n < 2; ++n) { \
        if constexpr (FP8SCALE != 0) { asm volatile("v_mfma_scale_f32_16x16x128_f8f6f4 %0, %1, %2, %0, %3, %4 op_sel_hi:[0,0,0]" : "+v"(acc[ai][bj][m][n]) : "v"(Bt[n]), "v"(At[m]), "v"(sclw), "v"(sclx)); } \
        else { acc[ai][bj][m][n] = __builtin_amdgcn_mfma_f32_16x16x32_bf16(PG8_HALF(Bt[n], 0), PG8_HALF(At[m], 0), acc[ai][bj][m][n], 0, 0, 0); acc[ai][bj][m][n] = __builtin_amdgcn_mfma_f32_16x16x32_bf16(PG8_HALF(Bt[n], 1), PG8_HALF(At[m], 1), acc[ai][bj][m][n], 0, 0, 0); } } __builtin_amdgcn_s_setprio(0); } while (0)
#define PG8_WAIT_V(n) asm volatile("s_waitcnt vmcnt(" #n ")" ::: "memory")
#define PG8_WAIT_L(n) asm volatile("s_waitcnt lgkmcnt(" #n ")" ::: "memory")
#define PG8_BAR __builtin_amdgcn_s_barrier()
#define PG8_SCHED __builtin_amdgcn_sched_barrier(0)
    Unit cur, nxt; int ui = 0;
    if (!S.next(0, cur)) return;
    f32x4 acc[2][2][4][2];
#pragma unroll
    for (int a = 0; a < 2; ++a)
#pragma unroll
        for (int b = 0; b < 2; ++b)
#pragma unroll
            for (int m = 0; m < 4; ++m)
#pragma unroll
                for (int n = 0; n < 2; ++n) acc[a][b][m][n] = (f32x4){0.f, 0.f, 0.f, 0.f};
    i32x8 At[4], B0[2], B1[2];
    const int sclw = FP8SCALE * 0x01010101, sclx = 0x7f7f7f7f;
    const char* cA = (const char*)g.A + (GATHER ? (size_t)0 : (size_t)cur.pm * tstep); const char* cB = (const char*)g.Bt + ((size_t)cur.e * g.bstride) * 2 + (size_t)cur.pn * tstep;
    if constexpr (GATHER) { PG8_GOFF(cur, vC); }
    S.a_ready(cur);
    if constexpr (SP2) {
        PG8_STAGE(PG8_SB(0, 0), cB, voffB); PG8_STAGE(PG8_SB(0, 1), cB + hstep, voffB); PG8_STAGE_A(PG8_SA(0, 0), cA, 0, vC); PG8_STAGE_A(PG8_SA(0, 1), cA, 1, vC);
        if (wr == 1) PG8_BAR;
        PG8_WAIT_V(2); PG8_BAR;
        PG8_STAGE(PG8_SB(1, 0), cB + kstep, voffB); PG8_STAGE_A(PG8_SA(1, 0), cA + kstep, 0, vC); PG8_STAGE(PG8_SB(1, 1), cB + hstep + kstep, voffB);
        PG8_WAIT_V(6); PG8_BAR;
    } else {
        PG8_STAGE(PG8_SB(0, 0), cB, voffB); PG8_STAGE_A(PG8_SA(0, 0), cA, 0, vC); PG8_STAGE(PG8_SB(0, 1), cB + hstep, voffB); PG8_STAGE_A(PG8_SA(0, 1), cA, 1, vC);
        if (wr == 1) PG8_BAR;
        PG8_WAIT_V(4); PG8_BAR;
        PG8_STAGE(PG8_SB(1, 0), cB + kstep, voffB); PG8_STAGE_A(PG8_SA(1, 0), cA + kstep, 0, vC); PG8_STAGE(PG8_SB(1, 1), cB + hstep + kstep, voffB);
        PG8_WAIT_V(6); PG8_BAR;
    }
    for (;;) {
        const bool has_next = S.next(ui + 1, nxt);
        const char* nA = (has_next && !GATHER) ? (const char*)g.A + (size_t)nxt.pm * tstep : cA; const char* nB = has_next ? (const char*)g.Bt + ((size_t)nxt.e * g.bstride) * 2 + (size_t)nxt.pn * tstep : cB;
        if constexpr (GATHER) { if (has_next) { PG8_GOFF(nxt, vN); } else { _Pragma("unroll") for (int h_ = 0; h_ < 2; ++h_) _Pragma("unroll") for (int i_ = 0; i_ < 2; ++i_) vN[h_][i_] = vC[h_][i_]; } }
        for (int t = 0; t < nt; t += 2) {
            const bool last = (t == nt - 2);
            const char* a1 = cA + (size_t)(t + 1) * kstep;
            const char* a2 = last ? nA : cA + (size_t)(t + 2) * kstep;
            if constexpr (GATHER) { _Pragma("unroll") for (int h_ = 0; h_ < 2; ++h_) _Pragma("unroll") for (int i_ = 0; i_ < 2; ++i_) vS[h_][i_] = last ? vN[h_][i_] : vC[h_][i_]; } const char* b2 = last ? nB : cB + (size_t)(t + 2) * kstep;
            const char* a3 = a2 + kstep; const char* b3 = b2 + kstep;
            if (last && has_next) S.a_ready(nxt);
            if constexpr (SP2) {
            PG8_LDB(B0, 0, 0); PG8_LDB(B1, 0, 1); PG8_SCHED; PG8_LDA(At, 0, 0); PG8_STAGE_A(PG8_SA(1, 1), a1, 1, vC);
            PG8_WAIT_V(8); PG8_WAIT_L(0); PG8_BAR; PG8_MMA(0, 0, At, B0); PG8_MMA(0, 1, At, B1); PG8_BAR; PG8_SCHED;
            PG8_LDA(At, 0, 1); PG8_STAGE(PG8_SB(0, 0), b2, voffB); PG8_STAGE(PG8_SB(0, 1), b2 + hstep, voffB); PG8_STAGE_A(PG8_SA(0, 0), a2, 0, vS);
            PG8_WAIT_V(8); PG8_WAIT_L(0); PG8_BAR; PG8_MMA(1, 0, At, B0); PG8_MMA(1, 1, At, B1); PG8_BAR; PG8_SCHED;
            PG8_LDB(B0, 1, 0); PG8_LDB(B1, 1, 1); PG8_SCHED; PG8_LDA(At, 1, 0); PG8_STAGE_A(PG8_SA(0, 1), a2, 1, vS);
            PG8_WAIT_V(8); PG8_WAIT_L(0); PG8_BAR; PG8_MMA(0, 0, At, B0); PG8_MMA(0, 1, At, B1); PG8_BAR; PG8_SCHED;
            PG8_LDA(At, 1, 1); PG8_STAGE(PG8_SB(1, 0), b3, voffB); PG8_STAGE(PG8_SB(1, 1), b3 + hstep, voffB); PG8_STAGE_A(PG8_SA(1, 0), a3, 0, vS);
            PG8_WAIT_V(8); PG8_WAIT_L(0); PG8_BAR; PG8_MMA(1, 0, At, B0); PG8_MMA(1, 1, At, B1); PG8_BAR; PG8_SCHED;
            } else {
            PG8_LDB(B0, 0, 0); PG8_SCHED; PG8_LDA(At, 0, 0); PG8_STAGE_A(PG8_SA(1, 1), a1, 1, vC);
            PG8_WAIT_L(8); PG8_BAR; PG8_WAIT_L(0); PG8_MMA(0, 0, At, B0); PG8_BAR; PG8_SCHED;
            PG8_LDB(B1, 0, 1); PG8_STAGE(PG8_SB(0, 0), b2, voffB);
            PG8_BAR; PG8_WAIT_L(0); PG8_MMA(0, 1, At, B1); PG8_BAR;
            PG8_LDA(At, 0, 1); PG8_STAGE_A(PG8_SA(0, 0), a2, 0, vS);
            PG8_BAR; PG8_WAIT_L(0); PG8_MMA(1, 0, At, B0); PG8_BAR; PG8_SCHED;
            PG8_STAGE(PG8_SB(0, 1), b2 + hstep, voffB);
            PG8_WAIT_V(6); PG8_BAR; PG8_MMA(1, 1, At, B1); PG8_BAR;
            PG8_LDB(B0, 1, 0); PG8_SCHED; PG8_LDA(At, 1, 0); PG8_STAGE_A(PG8_SA(0, 1), a2, 1, vS);
            PG8_WAIT_L(8); PG8_BAR; PG8_WAIT_L(0); PG8_MMA(0, 0, At, B0); PG8_BAR; PG8_SCHED;
            PG8_LDB(B1, 1, 1); PG8_STAGE(PG8_SB(1, 0), b3, voffB);
            PG8_BAR; PG8_WAIT_L(0); PG8_MMA(0, 1, At, B1); PG8_BAR;
            PG8_LDA(At, 1, 1); PG8_STAGE_A(PG8_SA(1, 0), a3, 0, vS);
            PG8_BAR; PG8_WAIT_L(0); PG8_MMA(1, 0, At, B0); PG8_BAR; PG8_SCHED;
            PG8_STAGE(PG8_SB(1, 1), b3 + hstep, voffB);
            PG8_WAIT_V(6); PG8_BAR; PG8_MMA(1, 1, At, B1); PG8_BAR;
            }
        }
        if constexpr (FP8SCALE != 0) { asm volatile("s_nop 15\n\ts_nop 15" ::: "memory"); }
        if constexpr (ALIGN_EPI) { if (wr == 0) PG8_BAR; }
        if constexpr (!Epi::AFTER_DRAIN) { E(acc, cur, wr, wc, fr, fq); S.done(cur); }
        if (!has_next) break;
#pragma unroll
        for (int a = 0; a < 2; ++a)
#pragma unroll
            for (int b = 0; b < 2; ++b)
#pragma unroll
                for (int m = 0; m < 4; ++m)
#pragma unroll
                    for (int n = 0; n < 2; ++n) acc[a][b][m][n] = (f32x4){0.f, 0.f, 0.f, 0.f};
        cur = nxt; cA = nA; cB = nB; ++ui;
        if constexpr (GATHER) { _Pragma("unroll") for (int h_ = 0; h_ < 2; ++h_) _Pragma("unroll") for (int i_ = 0; i_ < 2; ++i_) vC[h_][i_] = vN[h_][i_]; }
        if constexpr (ALIGN_EPI) { if (wr == 1) PG8_BAR; }
    }
    PG8_WAIT_V(0);
    if constexpr (!ALIGN_EPI) { if (wr == 0) PG8_BAR; }
    PG8_BAR;
    if constexpr (Epi::AFTER_DRAIN) { E.fused(acc, cur, wr, wc, fr, fq, lds, wid, lane); S.done(cur); }
#undef PG8_SA
#undef PG8_GOFF
#undef PG8_STAGE_A
#undef PG8_SB
#undef PG8_STAGE
#undef PG8_LDA
#undef PG8_LDB
#undef PG8_MMA
#undef PG8_CAT
#undef PG8_HALF
#undef PG8_WAIT_V
#undef PG8_WAIT_L
#undef PG8_BAR
#undef PG8_SCHED
}
}
#ifndef PG8_SP2
#define PG8_SP2 true
#endif
#ifndef PG8_ALIGN
#define PG8_ALIGN true
#endif
#include <hip/hip_bf16.h>
#include <cmath>
namespace attn_body {
using bf16=__hip_bfloat16;
using bf16x8=__attribute__((ext_vector_type(8)))short;
using s16x4=__attribute__((ext_vector_type(4)))short;
using f32x16=__attribute__((ext_vector_type(16)))float;
using u32x4=__attribute__((ext_vector_type(4)))unsigned;
constexpr int BATCH=4,NHEAD=8,SEQ=8192,D=64,PQ=3328,PO=1024;
constexpr int NW=8,QBLK=32,QB=QBLK*NW,KVBLK=64,NQB=SEQ/QB;
constexpr int ATTN_UNIT_ROWS=QB;
__device__ __forceinline__ int crow(int r,int hi){return (r&3)+8*(r>>2)+4*hi;}
#define SBAR() __builtin_amdgcn_sched_barrier(0)
__device__ __forceinline__ void cmask(f32x16&p0,f32x16&p1,int jb,int qrel,int hi){
  const float NEG=-INFINITY; int kb=64*jb+4*hi;
  #pragma unroll
  for(int r=0;r<16;++r){int kv=kb+(r&3)+8*(r>>2); if(kv>qrel)p0[r]=NEG; if(kv+32>qrel)p1[r]=NEG;}
}

constexpr int NSLOT=3, SLOTB=8192;
constexpr int LDS_K=0, LDS_V=NSLOT*SLOTB, LDS_WS=2*NSLOT*SLOTB, LDS_OST=LDS_WS+NW*64*4, LDS_CK=LDS_OST+NW*4096, LDS_BYTES=LDS_CK+SEQ*4;
constexpr float C2=0.125f*1.4426950408889634f;
__device__ __forceinline__ void glds16(const void*gsrc,unsigned lds_dst){unsigned keep;
  asm volatile("s_mov_b32 %0, m0\n\ts_mov_b32 m0, %2\n\ts_nop 0\n\tglobal_load_lds_dwordx4 %1, off\n\ts_mov_b32 m0, %0":"=&s"(keep):"v"(gsrc),"s"(lds_dst):"memory");}
__device__ __forceinline__ float max3f(float a,float b,float c){float r;asm("v_max3_f32 %0, %1, %2, %3":"=v"(r):"v"(a),"v"(b),"v"(c));return r;}
__device__ __forceinline__ float max2f(float a,float b){float r;asm("v_max_f32_e32 %0, %1, %2":"=v"(r):"v"(a),"v"(b));return r;}
__device__ __forceinline__ float fadd_s(float a,float b){float r;asm("v_add_f32_e32 %0, %1, %2":"=v"(r):"v"(a),"v"(b));return r;}
__device__ __forceinline__ float fsub_s(float a,float b){float r;asm("v_sub_f32_e32 %0, %1, %2":"=v"(r):"v"(a),"v"(b));return r;}
typedef float f32x2_t __attribute__((ext_vector_type(2))); typedef __bf16 bf16x2_t __attribute__((ext_vector_type(2)));
__device__ __forceinline__ unsigned cvtpk_s(float lo,float hi){f32x2_t v={lo,hi};bf16x2_t b=__builtin_convertvector(v,bf16x2_t);return __builtin_bit_cast(unsigned,b);}
#define WAIT_BAR(N) asm volatile("s_waitcnt vmcnt(" #N ") lgkmcnt(0)\n\ts_barrier":::"memory")

__device__ __forceinline__ void qkt(f32x16&p0,f32x16&p1,const char*Kslot,const bf16x8*qr,int r32,int hi){
  const char*kb=Kslot+hi*1024+r32*16;
  #pragma unroll
  for(int d0=0;d0<4;++d0){
    const bf16x8 b0=*reinterpret_cast<const bf16x8*>(kb+d0*2048);
    const bf16x8 b1=*reinterpret_cast<const bf16x8*>(kb+d0*2048+512);
    p0=__builtin_amdgcn_mfma_f32_32x32x16_bf16(b0,qr[d0],p0,0,0,0);p1=__builtin_amdgcn_mfma_f32_32x32x16_bf16(b1,qr[d0],p1,0,0,0);}
}
typedef __attribute__((address_space(3))) const char* lds_cptr;
typedef __attribute__((address_space(3))) float* lds_f32p; typedef __attribute__((address_space(3))) const float* lds_cf32p; typedef float f32x4_t __attribute__((ext_vector_type(4)));
typedef short v4i16_t __attribute__((ext_vector_type(4)));
__device__ __forceinline__ void kload8(bf16x8*kf,lds_cptr kp){
  kf[0]=*(const __attribute__((address_space(3))) bf16x8*)(kp);      kf[1]=*(const __attribute__((address_space(3))) bf16x8*)(kp+512);
  kf[2]=*(const __attribute__((address_space(3))) bf16x8*)(kp+2048); kf[3]=*(const __attribute__((address_space(3))) bf16x8*)(kp+2560);
  kf[4]=*(const __attribute__((address_space(3))) bf16x8*)(kp+4096); kf[5]=*(const __attribute__((address_space(3))) bf16x8*)(kp+4608);
  kf[6]=*(const __attribute__((address_space(3))) bf16x8*)(kp+6144); kf[7]=*(const __attribute__((address_space(3))) bf16x8*)(kp+6656);
}
__device__ __forceinline__ void kload2(bf16x8*kf,lds_cptr kp,int j){ kf[2*j]=*(const __attribute__((address_space(3))) bf16x8*)(kp+j*2048); kf[2*j+1]=*(const __attribute__((address_space(3))) bf16x8*)(kp+j*2048+512); }
__device__ __forceinline__ s16x4 vtr(lds_cptr p){ return __builtin_bit_cast(s16x4,__builtin_amdgcn_ds_read_tr16_b64_v4i16((__attribute__((address_space(3))) v4i16_t*)p)); }
__device__ __forceinline__ float rowmax(const f32x16&p0,const f32x16&p1){
  float a=max3f(p0[0],p0[1],p1[0]),b=max3f(p0[2],p0[3],p1[1]);a=max3f(a,p1[2],p1[3]);
  #pragma unroll
  for(int r=4;r<16;r+=4){a=max3f(a,p0[r],p0[r+1]);b=max3f(b,p0[r+2],p0[r+3]);a=max3f(a,p1[r],p1[r+1]);b=max3f(b,p1[r+2],p1[r+3]);}
  const float m=max2f(a,b);
  auto rr=__builtin_amdgcn_permlane32_swap(__float_as_uint(m),__float_as_uint(m),false,false);
  return max2f(__uint_as_float(rr[0]),__uint_as_float(rr[1]));
}
__device__ __forceinline__ void pv(f32x16*o,int vb,bf16x8 pa0,bf16x8 pa1,bf16x8 pa2,bf16x8 pa3){
  #pragma unroll
  for(int d0=0;d0<2;++d0){s16x4 lo[4],hi[4];
    #pragma unroll
    for(int ks=0;ks<4;++ks){
      asm volatile("ds_read_b64_tr_b16 %0,%1 offset:%c2":"=&v"(lo[ks]):"v"(vb),"i"(d0*4096+ks*1024):"memory");
      asm volatile("ds_read_b64_tr_b16 %0,%1 offset:%c2":"=&v"(hi[ks]):"v"(vb),"i"(d0*4096+ks*1024+512):"memory");}
    asm volatile("s_waitcnt lgkmcnt(0)":::"memory");SBAR();
    #define PK(k) (bf16x8){lo[k][0],lo[k][1],lo[k][2],lo[k][3],hi[k][0],hi[k][1],hi[k][2],hi[k][3]}
    o[d0]=__builtin_amdgcn_mfma_f32_32x32x16_bf16(pa0,PK(0),o[d0],0,0,0);
    o[d0]=__builtin_amdgcn_mfma_f32_32x32x16_bf16(pa1,PK(1),o[d0],0,0,0);
    o[d0]=__builtin_amdgcn_mfma_f32_32x32x16_bf16(pa2,PK(2),o[d0],0,0,0);
    o[d0]=__builtin_amdgcn_mfma_f32_32x32x16_bf16(pa3,PK(3),o[d0],0,0,0);
    #undef PK
  }
}

#ifndef ATTN_STORE16
#define ATTN_STORE16(p,v) (*(u32x4*)(p)=(v))
#endif
template<int THRL> __device__ __forceinline__ void attn_unit(int b,int h,int qb,int kt0,const bf16*Q,const bf16*__restrict__ K,const bf16*__restrict__ V,bf16*O,const float*__restrict__ CKG,const float*__restrict__ OG,char*shm){
  const int tid=threadIdx.x,lane=tid&63,r32=lane&31,hi=lane>>5; const int wid=__builtin_amdgcn_readfirstlane(tid>>6);
  const long rowbase=(long)b*SEQ; const int q0=qb*QB; const lds_cptr shm3_=(lds_cptr)shm;
  const bf16*Qw=Q+(rowbase+q0+wid*QBLK)*PQ+h*D;
  const bf16*Kh=K+(rowbase+(long)kt0*KVBLK)*PQ+h*D,*Vh=V+(rowbase+(long)kt0*KVBLK)*PQ+h*D;
  const unsigned lds0=(unsigned)(uintptr_t)shm;
  float*wsf=(float*)(shm+LDS_WS)+wid*64;
  const bf16*ksrc=Kh+(long)lane*PQ+wid*8;
  const bf16*vsrc=Vh+(long)(16*(wid&3)+(lane>>2))*PQ+(wid>>2)*32+(lane&3)*8;
  const unsigned kdst=lds0+LDS_K+wid*1024, vdst=lds0+LDS_V+wid*1024;
  #define DMA_K(t,slot) glds16(ksrc+(long)(t)*KVBLK*PQ,(unsigned)__builtin_amdgcn_readfirstlane(kdst+(slot)))
  #define DMA_V(t,slot) glds16(vsrc+(long)(t)*KVBLK*PQ,(unsigned)__builtin_amdgcn_readfirstlane(vdst+(slot)))
  const int vb0=(int)(lds0+LDS_V)+((lane>>4)&1)*32+(lane&3)*8+(4*hi+((lane&15)>>2))*64;
  const char*Kbase=shm+LDS_K; bf16x8 kf[8];
  const lds_cptr shm3=(lds_cptr)shm; const lds_cptr kp0=shm3+LDS_K+hi*1024+r32*16; const lds_cptr vp0=shm3+LDS_V+((lane>>4)&1)*32+(lane&3)*8+(4*hi+((lane&15)>>2))*64;
  const int NT=(q0+QB)/KVBLK-kt0;
  { const float*ckg=CKG+((long)(b*NHEAD+h))*SEQ+kt0*KVBLK; lds_f32p ckl=(lds_f32p)(shm3_+LDS_CK);
    f32x4_t cv_[4];
    _Pragma("unroll") for(int it=0;it<4;++it)cv_[it]=*(const f32x4_t*)(ckg+tid*4+it*NW*64*4);
    _Pragma("unroll") for(int it=0;it<4;++it)*(__attribute__((address_space(3))) f32x4_t*)(ckl+tid*4+it*NW*64*4)=cv_[it]; }
  const lds_cf32p ckb=(lds_cf32p)(shm3_+LDS_CK)+4*hi;
  DMA_K(0,0);DMA_V(0,0);DMA_K(1,SLOTB);
  bf16x8 qr[4];
  #pragma unroll
  for(int d0=0;d0<4;++d0)qr[d0]=*reinterpret_cast<const bf16x8*>(&Qw[(long)r32*PQ+d0*16+hi*8]);
  float mhat=0.f,l_reg=0.f;f32x16 o[2];o[0]=f32x16{};o[1]=f32x16{};float negmh=0.f;
  #define BIAS(C0,C1,t) do{ const lds_cf32p cp_=ckb+(t)*KVBLK; \
    _Pragma("unroll") for(int g_=0;g_<4;++g_){ const f32x4_t a_=*(const __attribute__((address_space(3))) f32x4_t*)(cp_+8*g_); const f32x4_t b_=*(const __attribute__((address_space(3))) f32x4_t*)(cp_+8*g_+32); \
      _Pragma("unroll") for(int j_=0;j_<4;++j_){ C0[4*g_+j_]=negmh-a_[j_]; C1[4*g_+j_]=negmh-b_[j_]; } if(g_&1){SBAR();} } }while(0)
  const int qrel=wid*QBLK+r32;
  #define CMASK(P0,P1,t) do{int jb_=(t)-(NT-4); if(jb_>=0)cmask(P0,P1,jb_,qrel,hi);}while(0)
  bool resc=false;
  #define START(P0,P1) do{ const float rm=rowmax(P0,P1); resc=false; \
    { const float dl=rm; mhat=fadd_s(mhat,dl); \
      _Pragma("unroll") for(int r=0;r<16;++r){P0[r]=fsub_s(P0[r],dl);P1[r]=fsub_s(P1[r],dl);} \
      negmh=-mhat; } \
    _Pragma("unroll") for(int r=0;r<16;++r)P0[r]=__builtin_amdgcn_exp2f(P0[r]); }while(0)
  #define RESC() do{ if(resc){ asm volatile("s_waitcnt lgkmcnt(0)":::"memory"); \
      _Pragma("unroll") for(int d_=0;d_<2;++d_) _Pragma("unroll") for(int r=0;r<16;++r)o[d_][r]*=wsf[crow(r,hi)]; } }while(0)
  f32x16 pA0,pA1,pB0,pB1;
  int sl_prev=0,sl_cur=0,sl_next=SLOTB;
  #define ROT() do{sl_prev=sl_cur;sl_cur=sl_next;sl_next=(sl_next==(NSLOT-1)*SLOTB)?0:sl_next+SLOTB;}while(0)
  DMA_K(2,2*SLOTB);
  WAIT_BAR(3);
  BIAS(pA0,pA1,0); qkt(pA0,pA1,Kbase,qr,r32,hi);asm volatile("s_nop 15\n\ts_nop 7":"+v"(pA0),"+v"(pA1));CMASK(pA0,pA1,0);
  START(pA0,pA1);
  _Pragma("unroll") for(int r=0;r<16;++r)pA1[r]=__builtin_amdgcn_exp2f(pA1[r]);
  WAIT_BAR(0);
  DMA_K(3,0);DMA_V(1,SLOTB);
  ROT();
  kload8(kf,kp0+sl_cur);
  WAIT_BAR(2);
  s16x4 vlo[8],vhi[8]; u32x4 pw0,pw1,pw2,pw3;
  #define PKW(P,B) cvtpk_s(P[B],P[B+1])
  #define PAF(k) __builtin_bit_cast(bf16x8,pw##k)
  #define VFR(i) (bf16x8){vlo[i][0],vlo[i][1],vlo[i][2],vlo[i][3],vhi[i][0],vhi[i][1],vhi[i][2],vhi[i][3]}
  #define PIN(x) asm volatile("":"+v"(x))
  #define MX3(a,b,c) __builtin_fmaxf(__builtin_fmaxf((a),(b)),(c))
  #define GAPA(MF,A0,A1,A2,A3,W0,W1,PW) do{ MF; sacc+=A0; sacc+=A1; sacc+=A2; sacc+=A3; PIN(sacc); W0; W1; PIN(PW); SBAR(); }while(0)
  #define EX(v) __builtin_amdgcn_exp2f(v)
  #define GAPB(MF,X,B) do{ MF; X[B]=EX(X[B]); X[B+1]=EX(X[B+1]); X[B+2]=EX(X[B+2]); X[B+3]=EX(X[B+3]); PIN(X); SBAR(); }while(0)
  #define VRD(i) do{ vlo[i]=vtr(vp_+(((i)>>2)*4096+((i)&3)*1024)); vhi[i]=vtr(vp_+(((i)>>2)*4096+((i)&3)*1024+512)); }while(0)
  #define KRD(G,j) do{ if(G){ kload2(kf,kp0+sl_next,j); SBAR(); } }while(0)
  #define STEP(C0,C1,P0,P1,t,GK,GV,GL) do{ SBAR(); BIAS(C0,C1,t); SBAR(); \
    const lds_cptr vp_=vp0+sl_prev; \
    VRD(0); SBAR(); float sacc=(P0[0]+P0[1]); \
    GAPA(C0=__builtin_amdgcn_mfma_f32_32x32x16_bf16(kf[0],qr[0],C0,0,0,0), P0[2],P0[3],P0[4],P0[5],     pw0[0]=PKW(P0,0), pw0[1]=PKW(P0,2), pw0); \
    VRD(4); SBAR(); GAPA(C1=__builtin_amdgcn_mfma_f32_32x32x16_bf16(kf[1],qr[0],C1,0,0,0), P0[6],P0[7],P0[8],P0[9],     pw0[2]=PKW(P0,4), pw0[3]=PKW(P0,6), pw0); \
    VRD(1); SBAR(); GAPA(C0=__builtin_amdgcn_mfma_f32_32x32x16_bf16(kf[2],qr[1],C0,0,0,0),   P0[10],P0[11],P0[12],P0[13], pw1[0]=PKW(P0,8), pw1[1]=PKW(P0,10), pw1); \
    VRD(5); SBAR(); GAPA(C1=__builtin_amdgcn_mfma_f32_32x32x16_bf16(kf[3],qr[1],C1,0,0,0),   P0[14],P0[15],P1[0],P1[1],   pw1[2]=PKW(P0,12),pw1[3]=PKW(P0,14), pw1); \
    VRD(2); SBAR(); GAPA(C0=__builtin_amdgcn_mfma_f32_32x32x16_bf16(kf[4],qr[2],C0,0,0,0),   P1[2],P1[3],P1[4],P1[5],     pw2[0]=PKW(P1,0), pw2[1]=PKW(P1,2), pw2); \
    VRD(6); SBAR(); GAPA(C1=__builtin_amdgcn_mfma_f32_32x32x16_bf16(kf[5],qr[2],C1,0,0,0),   P1[6],P1[7],P1[8],P1[9],     pw2[2]=PKW(P1,4), pw2[3]=PKW(P1,6), pw2); \
    VRD(3); SBAR(); GAPA(C0=__builtin_amdgcn_mfma_f32_32x32x16_bf16(kf[6],qr[3],C0,0,0,0),   P1[10],P1[11],P1[12],P1[13], pw3[0]=PKW(P1,8), pw3[1]=PKW(P1,10), pw3); \
    VRD(7); SBAR(); GAPA(C1=__builtin_amdgcn_mfma_f32_32x32x16_bf16(kf[7],qr[3],C1,0,0,0),   P1[14],P1[15],0.f,0.f,       pw3[2]=PKW(P1,12),pw3[3]=PKW(P1,14), pw3); \
    l_reg+=sacc; \
    if(GK){DMA_K((t)+3,sl_cur);} if(GV){DMA_V((t)+1,sl_next);} \
    CMASK(C0,C1,t); \
    { float a=MX3(C0[0],C0[1],C1[0]),b=MX3(C0[2],C0[3],C1[1]); a=MX3(a,C1[2],C1[3]); \
      _Pragma("unroll") for(int r=4;r<16;r+=4){a=MX3(a,C0[r],C0[r+1]);b=MX3(b,C0[r+2],C0[r+3]);a=MX3(a,C1[r],C1[r+1]);b=MX3(b,C1[r+2],C1[r+3]);} \
      float rm=__builtin_fmaxf(a,b); { auto rr=__builtin_amdgcn_permlane32_swap(__float_as_uint(rm),__float_as_uint(rm),false,false); rm=__builtin_fmaxf(__uint_as_float(rr[0]),__uint_as_float(rr[1])); } \
      resc=false; \
      if(__builtin_expect(__any(rm>(float)THRL),0)){ const float dl=__builtin_fmaxf(rm,0.f); mhat+=dl; \
        _Pragma("unroll") for(int r=0;r<16;++r){C0[r]-=dl;C1[r]-=dl;} \
        negmh=-mhat; \
        const float f=__builtin_amdgcn_exp2f(-dl); l_reg*=f; if(hi==0)wsf[r32]=f; resc=true; } } \
    SBAR(); \
    GAPB(o[0]=__builtin_amdgcn_mfma_f32_32x32x16_bf16(PAF(0),VFR(0),o[0],0,0,0), C0,0); \
    GAPB(o[1]=__builtin_amdgcn_mfma_f32_32x32x16_bf16(PAF(0),VFR(4),o[1],0,0,0), C0,4); \
    KRD(GL,0); GAPB(o[0]=__builtin_amdgcn_mfma_f32_32x32x16_bf16(PAF(1),VFR(1),o[0],0,0,0), C0,8); \
    KRD(GL,1); GAPB(o[1]=__builtin_amdgcn_mfma_f32_32x32x16_bf16(PAF(1),VFR(5),o[1],0,0,0), C0,12); \
    KRD(GL,2); GAPB(o[0]=__builtin_amdgcn_mfma_f32_32x32x16_bf16(PAF(2),VFR(2),o[0],0,0,0), C1,0); \
    KRD(GL,3); GAPB(o[1]=__builtin_amdgcn_mfma_f32_32x32x16_bf16(PAF(2),VFR(6),o[1],0,0,0), C1,4); \
    GAPB(o[0]=__builtin_amdgcn_mfma_f32_32x32x16_bf16(PAF(3),VFR(3),o[0],0,0,0), C1,8); \
    GAPB(o[1]=__builtin_amdgcn_mfma_f32_32x32x16_bf16(PAF(3),VFR(7),o[1],0,0,0), C1,12); \
    }while(0)
  int t=1;
  #undef CMASK
  #define CMASK(P0,P1,t) do{}while(0)
  for(;t+5<NT;t+=2){
    STEP(pB0,pB1,pA0,pA1,t,true,true,true);     WAIT_BAR(2); RESC(); ROT();
    STEP(pA0,pA1,pB0,pB1,t+1,true,true,true);   WAIT_BAR(2); RESC(); ROT();
  }
  #undef CMASK
  #define CMASK(P0,P1,t) do{int jb_=(t)-(NT-4); if(jb_>=0)cmask(P0,P1,jb_,qrel,hi);}while(0)
  #define ENDW(tt) do{ if((tt)+3<NT){WAIT_BAR(2);} else if((tt)+2<NT){WAIT_BAR(1);} else {WAIT_BAR(0);} }while(0)
  for(;t+1<NT;t+=2){
    STEP(pB0,pB1,pA0,pA1,t,(t+3<NT),(t+1<NT),(t+1<NT));       ENDW(t);   RESC(); ROT();
    STEP(pA0,pA1,pB0,pB1,t+1,(t+4<NT),(t+2<NT),(t+2<NT));     ENDW(t+1); RESC(); ROT();
  }
  STEP(pB0,pB1,pA0,pA1,NT-1,false,false,false); RESC();
  { float sacc=pB0[0]+pB0[1]; _Pragma("unroll") for(int r=2;r<16;++r)sacc+=pB0[r]; _Pragma("unroll") for(int r=0;r<16;++r)sacc+=pB1[r]; l_reg+=sacc;
    pw0=(u32x4){PKW(pB0,0),PKW(pB0,2),PKW(pB0,4),PKW(pB0,6)};pw1=(u32x4){PKW(pB0,8),PKW(pB0,10),PKW(pB0,12),PKW(pB0,14)};pw2=(u32x4){PKW(pB1,0),PKW(pB1,2),PKW(pB1,4),PKW(pB1,6)};pw3=(u32x4){PKW(pB1,8),PKW(pB1,10),PKW(pB1,12),PKW(pB1,14)};
    SBAR(); pv(o,vb0+sl_cur,PAF(0),PAF(1),PAF(2),PAF(3)); }
  #undef PKW
  #undef PAF
  #undef VFR
  #undef PIN
  #undef MX3
  #undef GAPA
  #undef GAPB
  #undef EX
  #undef VRD
  #undef KRD
  #undef STEP
  #undef ENDW
  {auto rr=__builtin_amdgcn_permlane32_swap(__float_as_uint(l_reg),__float_as_uint(l_reg),false,false);l_reg=__uint_as_float(rr[0])+__uint_as_float(rr[1]);}
  if(hi==0)wsf[32+r32]=l_reg;asm volatile("s_waitcnt lgkmcnt(0)":::"memory");
  float rli[16];
  #pragma unroll
  for(int r=0;r<16;++r)rli[r]=__builtin_amdgcn_rcpf(wsf[32+crow(r,hi)]);
  bf16*Ow=O+(rowbase+q0+wid*QBLK)*PO+h*D;
  { bf16*stg=(bf16*)(shm+LDS_OST)+wid*2048;
    #pragma unroll
    for(int r=0;r<16;++r){const int orow=crow(r,hi);
      #pragma unroll
      for(int d0=0;d0<2;++d0)stg[orow*64+d0*32+r32]=__float2bfloat16(o[d0][r]*rli[r]);}
    asm volatile("s_waitcnt lgkmcnt(0)":::"memory");
    #pragma unroll
    for(int i=0;i<4;++i){const int row=i*8+(lane>>3),ch=lane&7; const u32x4 v=*(const u32x4*)(stg+row*64+ch*8);
      float f[8]; _Pragma("unroll") for(int j=0;j<4;++j){ f[2*j]=__uint_as_float(v[j]<<16); f[2*j+1]=__uint_as_float(v[j]&0xffff0000u); }
      float ss=0.f; _Pragma("unroll") for(int j=0;j<8;++j)ss+=f[j]*f[j];
      ss+=__shfl_xor(ss,1); ss+=__shfl_xor(ss,2); ss+=__shfl_xor(ss,4);
      const float rs=__builtin_amdgcn_rsqf(ss*(1.0f/64.0f)+1e-5f);
      const f32x4_t g0=*(const f32x4_t*)(OG+h*D+ch*8), g1=*(const f32x4_t*)(OG+h*D+ch*8+4);
      u32x4 w; w[0]=cvtpk_s(f[0]*rs*g0[0],f[1]*rs*g0[1]); w[1]=cvtpk_s(f[2]*rs*g0[2],f[3]*rs*g0[3]); w[2]=cvtpk_s(f[4]*rs*g1[0],f[5]*rs*g1[1]); w[3]=cvtpk_s(f[6]*rs*g1[2],f[7]*rs*g1[3]);
      ATTN_STORE16(Ow+(long)row*PO+ch*8,w);} }
  asm volatile("s_waitcnt lgkmcnt(0)\n\ts_barrier":::"memory");
  #undef DMA_K
  #undef DMA_V
  #undef CMASK
  #undef START
  #undef RESC
  #undef ROT
  #undef BIAS
}
constexpr int ATTN_LDS_BYTES=LDS_BYTES;
struct AttnTensors { const bf16* Q; const bf16* K; const bf16* V; bf16* O; const float* CK; const float* OG; };
struct AttnUnit { int bh; int qb; };
struct StaticOrder {
  int vcu;
  __device__ __forceinline__ explicit StaticOrder(int grid,int block):vcu((block%8)*(grid/8)+block/8){}
  __device__ __forceinline__ bool next(int i,AttnUnit&u)const{ if(i>=4)return false; const int s=vcu&7; u.bh=vcu>>3; u.qb=(i==0)?s:(i==1)?15-s:(i==2)?16+s:31-s; return true; }
  __device__ __forceinline__ void a_ready(const AttnUnit&)const{}
  __device__ __forceinline__ void done(const AttnUnit&)const{}
};
template<class Sched,int THRL=8> __device__ __forceinline__ void attn_phase(char*lds,const AttnTensors&T,const Sched&S){
  AttnUnit u;
  for(int i=0;S.next(i,u);++i){ S.a_ready(u); attn_unit<THRL>(u.bh/NHEAD,u.bh%NHEAD,u.qb,0,T.Q,T.K,T.V,T.O,T.CK,T.OG,lds); S.done(u); }
}
#undef SBAR
#undef WAIT_BAR
}
namespace rw {
typedef short bf16x8 __attribute__((ext_vector_type(8)));
typedef float f32x4 __attribute__((ext_vector_type(4)));
typedef unsigned u32x2 __attribute__((ext_vector_type(2)));
typedef unsigned u32x4 __attribute__((ext_vector_type(4)));
#define RW_LAS __attribute__((address_space(3)))
constexpr int PT = 72, MB = 64 * PT * 2;
constexpr int O_AH = 0, O_RH = MB, O_BH = 2 * MB, O_KH = 3 * MB, O_AHT = 4 * MB, O_VT = 5 * MB, O_BTT = 6 * MB, O_KTT = 7 * MB, O_Z = 8 * MB;
constexpr int O_Z0 = O_Z, O_Z1 = O_Z + MB, O_Z2 = O_Z + 2 * MB, O_Z3 = O_Z + 3 * MB, O_Z4 = O_Z + 4 * MB;
constexpr int ZP = 68, ZB = 64 * ZP * 4;
constexpr int O_ZW = O_Z, O_ZA = O_Z + ZB, O_ZG = O_Z + 2 * ZB, O_WTOT = O_ZG + MB;
constexpr int XP = 264, O_X = 0;
constexpr int O_LW = O_Z4 + MB;
constexpr int PART_A_LDS = O_LW + 32768;
static_assert(64 * XP * 2 <= O_Z, "X overlays only the hat matrices");
static_assert(O_WTOT + 2048 <= O_Z4 + MB, "rwkv LDS map");
constexpr int UNIT_QT = 0, UNIT_YI = 8192, UNIT_ML = 16384, UNIT_NT = 24576, UNIT_P = 40960, UNIT_BYTES = 41216;

__device__ __forceinline__ unsigned pk(float lo, float hi) { typedef float f2 __attribute__((ext_vector_type(2))); typedef __bf16 b2 __attribute__((ext_vector_type(2))); f2 v = {lo, hi}; return __builtin_bit_cast(unsigned, __builtin_convertvector(v, b2)); }
__device__ __forceinline__ unsigned short f2b(float f) { return (unsigned short)(pk(f, 0.f) & 0xffffu); }
__device__ __forceinline__ float b2f(unsigned short b) { return __uint_as_float((unsigned)b << 16); }
__device__ __forceinline__ float sigm(float x) { return __builtin_amdgcn_rcpf(1.0f + __expf(-x)); }

__device__ __forceinline__ void mm_nt(f32x4 (&acc)[2], const RW_LAS unsigned char* lds, int xo, int yo, int ti, int ch, int c, int g) {
#pragma unroll
    for (int s = 0; s < 2; ++s) {
        const bf16x8 a = *(const RW_LAS bf16x8*)(lds + xo + ((16 * ti + c) * PT + 32 * s + 8 * g) * 2);
#pragma unroll
        for (int n = 0; n < 2; ++n) { const bf16x8 b = *(const RW_LAS bf16x8*)(lds + yo + ((32 * ch + 16 * n + c) * PT + 32 * s + 8 * g) * 2); acc[n] = __builtin_amdgcn_mfma_f32_16x16x32_bf16(a, b, acc[n], 0, 0, 0); }
    }
}
#define RW_ZERO(a) do { a[0] = (f32x4){0.f, 0.f, 0.f, 0.f}; a[1] = (f32x4){0.f, 0.f, 0.f, 0.f}; } while (0)
__device__ __forceinline__ void st_nat(RW_LAS unsigned char* lds, int off, const f32x4& v, int row0, int col) {
#pragma unroll
    for (int r = 0; r < 4; ++r) *(RW_LAS unsigned short*)(lds + off + ((row0 + r) * PT + col) * 2) = f2b(v[r]);
}
__device__ __forceinline__ void st_tr(RW_LAS unsigned char* lds, int off, const f32x4& v, int row0, int col) {
    u32x2 w; w.x = pk(v[0], v[1]); w.y = pk(v[2], v[3]); *(RW_LAS u32x2*)(lds + off + (col * PT + row0) * 2) = w;
}

struct PartA { const float* const __attribute__((address_space(4)))* in; unsigned char* ws; size_t o_u, o_lora, o_rec, o_bon, o_gg; };
#define PA_U ((const unsigned short*)(A.ws + A.o_u))
#define PA_WUPT ((const unsigned short*)(A.ws + A.o_lora))
#define PA_AUPT (PA_WUPT + 512 * 64)
#define PA_GUPT (PA_WUPT + 2 * 512 * 64)
#define PA_REC (A.ws + A.o_rec)
#define PA_BON ((unsigned short*)(A.ws + A.o_bon))
#define PA_GG ((unsigned short*)(A.ws + A.o_gg))

#define RW_BAR() asm volatile("s_waitcnt lgkmcnt(0)\n\ts_barrier" ::: "memory")
__device__ __forceinline__ void part_a_block(const PartA& A, RW_LAS unsigned char* lds, int bh, int chunk0, int nun, int tid_in, volatile RW_LAS unsigned* tsw) {
    constexpr int NU_ = 3328, T_ = 8192;
#if TS_PROBE >= 100
    unsigned long long ts_last = __builtin_amdgcn_s_memrealtime(), ts_acc = 0ull;
#define RW_TS(k) do { const unsigned long long n_ = __builtin_amdgcn_s_memrealtime(); if ((k) == TS_PROBE - 100) ts_acc += n_ - ts_last; ts_last = n_; } while (0)
#else
#define RW_TS(k) do { } while (0)
#endif
    u32x4 xc[4], xp[4]; unsigned short er[9], ek[9], ev[9];
#define RW_PREFETCH_X(CH) do { const int tid_ = tid_in, b_ = bh >> 3; const size_t m0_ = (size_t)b_ * T_ + (size_t)(CH) * 64; \
        { const int t_ = tid_ & 63, cb_ = (tid_ >> 6) * 32; const unsigned short* ur_ = PA_U + (m0_ + t_) * NU_ + 1536 + cb_; const bool first_ = ((CH) == 0 && t_ == 0); \
          const unsigned short* up_ = first_ ? ur_ : ur_ - NU_;         \
          _Pragma("unroll") for (int q = 0; q < 4; ++q) { xc[q] = *(const u32x4*)(ur_ + 8 * q); xp[q] = *(const u32x4*)(up_ + 8 * q); } \
          if (first_) { _Pragma("unroll") for (int q = 0; q < 4; ++q) xp[q] = (u32x4){0u, 0u, 0u, 0u}; } } } while (0)
#define RW_PREFETCH_E(CH) do { const int tid_ = tid_in, lane_ = tid_ & 63, w_ = tid_ >> 6, b_ = bh >> 3, h_ = bh & 7; const size_t m0_ = (size_t)b_ * T_ + (size_t)(CH) * 64; \
        { const unsigned short* u0_ = PA_U + (m0_ + 8 * w_) * NU_ + h_ * 64 + lane_; const bool first_ = ((CH) == 0 && w_ == 0); \
          const unsigned short* p0_ = first_ ? u0_ : u0_ - NU_; er[0] = p0_[0]; ek[0] = p0_[512]; ev[0] = p0_[1024]; \
          _Pragma("unroll") for (int i = 0; i < 8; ++i) { er[i + 1] = u0_[(size_t)i * NU_]; ek[i + 1] = u0_[(size_t)i * NU_ + 512]; ev[i + 1] = u0_[(size_t)i * NU_ + 1024]; } \
          if (first_) { er[0] = 0; ek[0] = 0; ev[0] = 0; } } } while (0)
    { const int lane_ = tid_in & 63, w_ = tid_in >> 6, ch_ = w_ & 1, c_ = lane_ & 15, g_ = lane_ >> 4;
#pragma unroll
      for (int q = 0; q < 4; ++q) { const int f = 4 * (w_ >> 1) + q; const int n = f & 1, col_ = (bh & 7) * 64 + 32 * ch_ + 16 * n + c_;
          const unsigned short* src = f < 4 ? PA_WUPT + col_ * 64 + 32 * (f >> 1) + 8 * g_ : f < 8 ? PA_AUPT + col_ * 64 + 32 * ((f - 4) >> 1) + 8 * g_ : PA_GUPT + col_ * 128 + 32 * ((f - 8) >> 1) + 8 * g_;
          *(RW_LAS bf16x8*)(lds + O_LW + ((ch_ * 16 + f) * 64 + lane_) * 16) = *(const bf16x8*)src; } }
#define RW_LOAD_LORA() do { const int ch_ = (tid_in >> 6) & 1, lane_ = tid_in & 63; _Pragma("unroll") for (int n = 0; n < 2; ++n) { \
        _Pragma("unroll") for (int s = 0; s < 2; ++s) { fw[s][n] = *(const RW_LAS bf16x8*)(lds + O_LW + ((ch_ * 16 + 2 * s + n) * 64 + lane_) * 16); fa[s][n] = *(const RW_LAS bf16x8*)(lds + O_LW + ((ch_ * 16 + 4 + 2 * s + n) * 64 + lane_) * 16); } \
        _Pragma("unroll") for (int s = 0; s < 4; ++s) fg[s][n] = *(const RW_LAS bf16x8*)(lds + O_LW + ((ch_ * 16 + 8 + 2 * s + n) * 64 + lane_) * 16); } } while (0)
    RW_PREFETCH_X(chunk0);
    const int pc_cc = (bh & 7) * 64 + (tid_in & 63);
    const float pc_mur = A.in[3][pc_cc], pc_muk = A.in[3][512 + pc_cc], pc_muv = A.in[3][1024 + pc_cc], pc_w0 = A.in[4][pc_cc], pc_a0 = A.in[6][pc_cc], pc_kk = A.in[9][pc_cc], pc_ka = A.in[10][pc_cc], pc_rk = A.in[11][pc_cc];
  for (int kk_ = 0; kk_ < nun; ++kk_) {
    const int chunk = chunk0 + kk_; int tid = tid_in;
    constexpr int RW_ = 512;
    asm volatile("" : "+v"(tid));
    const int lane = tid & 63, w = __builtin_amdgcn_readfirstlane(tid >> 6), ti = w >> 1, ch = w & 1, c = lane & 15, g = lane >> 4;
    const int b = bh >> 3, h = bh & 7; const size_t m0 = (size_t)b * T_ + (size_t)chunk * 64;
    unsigned char* rec = PA_REC + (size_t)(bh * 128 + chunk) * UNIT_BYTES;
    bf16x8 fw[2][2], fa[2][2], fg[4][2];
    { const int t = lane, cb = 32 * w;
      const f32x4* mup = (const f32x4*)(A.in[3] + 1536 + cb);
      f32x4 mu4[8];
#pragma unroll
      for (int q = 0; q < 8; ++q) mu4[q] = mup[q];
      float xs[32];
#pragma unroll
      for (int q = 0; q < 4; ++q)
#pragma unroll
          for (int e = 0; e < 4; ++e) { const float c0 = __uint_as_float(xc[q][e] << 16), c1 = __uint_as_float(xc[q][e] & 0xffff0000u), p0 = __uint_as_float(xp[q][e] << 16), p1 = __uint_as_float(xp[q][e] & 0xffff0000u);
              const int j = 8 * q + 2 * e; xs[j] = c0 + (p0 - c0) * mu4[j >> 2][j & 3]; xs[j + 1] = c1 + (p1 - c1) * mu4[(j + 1) >> 2][(j + 1) & 3]; }
      if (w < 2) {
#pragma unroll
          for (int j = 0; j < 32; ++j) xs[j] = 1.0f - 2.0f * __builtin_amdgcn_rcpf(1.0f + __expf(2.0f * xs[j]));
      } else if (w >= 4) {
#pragma unroll
          for (int j = 0; j < 32; ++j) xs[j] = __builtin_amdgcn_rcpf(1.0f + __expf(-xs[j]));
      }
#pragma unroll
      for (int q = 0; q < 4; ++q) { u32x4 o; o.x = pk(xs[8 * q], xs[8 * q + 1]); o.y = pk(xs[8 * q + 2], xs[8 * q + 3]); o.z = pk(xs[8 * q + 4], xs[8 * q + 5]); o.w = pk(xs[8 * q + 6], xs[8 * q + 7]);
          *(RW_LAS u32x4*)(lds + O_X + (t * XP + cb + 8 * q) * 2) = o; }
      if (kk_ + 1 < nun) { RW_PREFETCH_X(chunk + 1); } }
    RW_BAR(); RW_TS(0);
    RW_LOAD_LORA();
    RW_PREFETCH_E(chunk);
    { f32x4 zw[2], za[2], zg[2]; RW_ZERO(zw); RW_ZERO(za); RW_ZERO(zg);
#pragma unroll
      for (int s = 0; s < 2; ++s) {
          const bf16x8 aw = *(const RW_LAS bf16x8*)(lds + O_X + ((16 * ti + c) * XP + 32 * s + 8 * g) * 2), aa = *(const RW_LAS bf16x8*)(lds + O_X + ((16 * ti + c) * XP + 64 + 32 * s + 8 * g) * 2);
#pragma unroll
          for (int n = 0; n < 2; ++n) { zw[n] = __builtin_amdgcn_mfma_f32_16x16x32_bf16(aw, fw[s][n], zw[n], 0, 0, 0); za[n] = __builtin_amdgcn_mfma_f32_16x16x32_bf16(aa, fa[s][n], za[n], 0, 0, 0); } }
#pragma unroll
      for (int s = 0; s < 4; ++s) { const bf16x8 ag = *(const RW_LAS bf16x8*)(lds + O_X + ((16 * ti + c) * XP + 128 + 32 * s + 8 * g) * 2);
#pragma unroll
          for (int n = 0; n < 2; ++n) zg[n] = __builtin_amdgcn_mfma_f32_16x16x32_bf16(ag, fg[s][n], zg[n], 0, 0, 0); }
#pragma unroll
      for (int n = 0; n < 2; ++n)
#pragma unroll
          for (int r = 0; r < 4; ++r) { const int o = ((16 * ti + 4 * g + r) * ZP + 32 * ch + 16 * n + c) * 4;
              *(RW_LAS float*)(lds + O_ZW + o) = zw[n][r]; *(RW_LAS float*)(lds + O_ZA + o) = za[n][r]; *(RW_LAS unsigned short*)(lds + O_ZG + ((16 * ti + 4 * g + r) * PT + 32 * ch + 16 * n + c) * 2) = f2b(zg[n][r]); } }
    RW_BAR(); RW_TS(1);
    { const int cc = h * 64 + lane;
      float r[8], k[8], v[8], lw[8], av[8];
      { float pr = b2f(er[0]), pk_ = b2f(ek[0]), pv = b2f(ev[0]);
        const float mur = pc_mur, muk = pc_muk, muv = pc_muv;
#pragma unroll
        for (int i = 0; i < 8; ++i) { const float cr = b2f(er[i + 1]), ck = b2f(ek[i + 1]), cv = b2f(ev[i + 1]);
            r[i] = cr + (pr - cr) * mur; k[i] = ck + (pk_ - ck) * muk; v[i] = cv + (pv - cv) * muv; pr = cr; pk_ = ck; pv = cv; } }
      const float w0 = pc_w0, a0 = pc_a0, k_k = pc_kk, k_a = pc_ka, r_k = pc_rk;
      float run = 0.f, kkr[8], k2[8];
#pragma unroll
      for (int i = 0; i < 8; ++i) { const int t = 8 * w + i; const float zw = *(const RW_LAS float*)(lds + O_ZW + (t * ZP + lane) * 4) + w0, za = *(const RW_LAS float*)(lds + O_ZA + (t * ZP + lane) * 4) + a0;
          lw[i] = -0.6065306597126334f * sigm(zw); run += lw[i]; av[i] = sigm(za); kkr[i] = k[i] * k_k; k2[i] = k[i] * (1.0f + (av[i] - 1.0f) * k_a); }
      *(RW_LAS float*)(lds + O_WTOT + (w * 64 + lane) * 4) = run;
#pragma unroll
      for (int i = 0; i < 8; ++i) { *(RW_LAS float*)(lds + O_ZW + ((8 * w + i) * ZP + lane) * 4) = kkr[i] * kkr[i]; *(RW_LAS float*)(lds + O_ZA + ((8 * w + i) * ZP + lane) * 4) = r[i] * k2[i] * r_k; }
      float red[16];
      { const int q = lane >> 2, part = lane & 3; const RW_LAS float* rp = (const RW_LAS float*)(lds + ((q < 8) ? O_ZW : O_ZA) + ((8 * w + (q & 7)) * ZP + part * 16) * 4);
        const f32x4 s0 = *(const RW_LAS f32x4*)(rp), s1 = *(const RW_LAS f32x4*)(rp + 4), s2 = *(const RW_LAS f32x4*)(rp + 8), s3 = *(const RW_LAS f32x4*)(rp + 12);
        float s = ((s0.x + s0.y) + (s0.z + s0.w)) + ((s1.x + s1.y) + (s1.z + s1.w)) + ((s2.x + s2.y) + (s2.z + s2.w)) + ((s3.x + s3.y) + (s3.z + s3.w));
        s += __uint_as_float(__builtin_amdgcn_update_dpp(0, __float_as_uint(s), 0xB1, 0xF, 0xF, true));
        s += __uint_as_float(__builtin_amdgcn_update_dpp(0, __float_as_uint(s), 0x4E, 0xF, 0xF, true));
        asm volatile("s_waitcnt lgkmcnt(0)" ::: "memory");
        if (part == 0) *(RW_LAS float*)(lds + O_ZW + ((8 * w) * ZP + q) * 4) = s;
        const RW_LAS f32x4* rr = (const RW_LAS f32x4*)(lds + O_ZW + ((8 * w) * ZP) * 4);
#pragma unroll
        for (int j = 0; j < 4; ++j) { const f32x4 x = rr[j]; red[4 * j] = x.x; red[4 * j + 1] = x.y; red[4 * j + 2] = x.z; red[4 * j + 3] = x.w; } }
      RW_BAR(); RW_TS(2);
      float off = 0.f, tot = 0.f;
#pragma unroll
      for (int j = 0; j < 8; ++j) { const float x = *(const RW_LAS float*)(lds + O_WTOT + (j * 64 + lane) * 4); tot += x; if (j < w) off += x; }
      float cum = off; unsigned aht[4], vt[4], btt[4], ktt[4], bon[4], ggs[4]; float ahp = 0.f, vp = 0.f, btp = 0.f, ktp = 0.f, bop = 0.f, ggp = 0.f;
      const float etot = __expf(tot); float e1 = __expf(off);
#pragma unroll
      for (int i = 0; i < 8; ++i) { const int t = 8 * w + i; cum += lw[i];
          const float kk = kkr[i] * __builtin_amdgcn_rsqf(fmaxf(red[i], 1e-24f));
          const float bb = -kk * av[i];
          const float ex = e1; e1 = __expf(cum); const float e2 = __builtin_amdgcn_rcpf(e1), et = etot * e2;
          const float ah = kk * ex, rh = r[i] * e1, bh_ = bb * e2, kh = k2[i] * e2, bt = bb * et, kt = k2[i] * et;
          const int o = (t * PT + lane) * 2;
          *(RW_LAS unsigned short*)(lds + O_AH + o) = f2b(ah); *(RW_LAS unsigned short*)(lds + O_RH + o) = f2b(rh); *(RW_LAS unsigned short*)(lds + O_BH + o) = f2b(bh_); *(RW_LAS unsigned short*)(lds + O_KH + o) = f2b(kh);
          if (i & 1) { aht[i >> 1] = pk(ahp, ah); vt[i >> 1] = pk(vp, v[i]); btt[i >> 1] = pk(btp, bt); ktt[i >> 1] = pk(ktp, kt); } else { ahp = ah; vp = v[i]; btp = bt; ktp = kt; }
          const float bo = red[8 + i] * v[i], gg_ = b2f(*(const RW_LAS unsigned short*)(lds + O_ZG + (t * PT + lane) * 2));
          if (i & 1) { bon[i >> 1] = pk(bop, bo); ggs[i >> 1] = pk(ggp, gg_); } else { bop = bo; ggp = gg_; } }
      { const size_t uo = (size_t)(bh * 128 + chunk) * 4096;
        const int e0 = (((lane >> 4) * 4 + (w >> 1)) * 64 + (lane & 15) + 16 * (2 * (w & 1))) * 4;
        *(u32x2*)(PA_BON + uo + e0) = (u32x2){bon[0], bon[1]}; *(u32x2*)(PA_BON + uo + e0 + 64) = (u32x2){bon[2], bon[3]};
        *(u32x2*)(PA_GG + uo + e0) = (u32x2){ggs[0], ggs[1]}; *(u32x2*)(PA_GG + uo + e0 + 64) = (u32x2){ggs[2], ggs[3]}; }
      const int ot = (lane * PT + 8 * w) * 2;
      *(RW_LAS u32x4*)(lds + O_AHT + ot) = (u32x4){aht[0], aht[1], aht[2], aht[3]}; *(RW_LAS u32x4*)(lds + O_VT + ot) = (u32x4){vt[0], vt[1], vt[2], vt[3]};
      *(RW_LAS u32x4*)(lds + O_BTT + ot) = (u32x4){btt[0], btt[1], btt[2], btt[3]}; *(RW_LAS u32x4*)(lds + O_KTT + ot) = (u32x4){ktt[0], ktt[1], ktt[2], ktt[3]};
      if (w == 7) *(float*)(rec + UNIT_P + lane * 4) = etot; }
    RW_BAR(); RW_TS(3);

    const int row0 = 16 * ti + 4 * g;
    { f32x4 ab[2], ak[2], rb[2], rk[2]; RW_ZERO(ab); RW_ZERO(ak); RW_ZERO(rb); RW_ZERO(rk);
      mm_nt(ab, lds, O_AH, O_BH, ti, ch, c, g); mm_nt(ak, lds, O_AH, O_KH, ti, ch, c, g); mm_nt(rb, lds, O_RH, O_BH, ti, ch, c, g); mm_nt(rk, lds, O_RH, O_KH, ti, ch, c, g);
#pragma unroll
      for (int n = 0; n < 2; ++n) { const int col = 32 * ch + 16 * n + c, ct = 2 * ch + n;
          f32x4 ao, sk, irb, irk;
#pragma unroll
          for (int r = 0; r < 4; ++r) { const int t = row0 + r; ao[r] = (ti > ct) ? ab[n][r] : 0.f; sk[r] = (t > col) ? ak[n][r] : 0.f; irb[r] = (t >= col) ? rb[n][r] : 0.f; irk[r] = (t >= col) ? rk[n][r] : 0.f; }
          st_tr(lds, O_Z0, ao, row0, col); st_nat(lds, O_Z1, sk, row0, col); st_nat(lds, O_Z2, irb, row0, col); st_nat(lds, O_Z3, irk, row0, col);
          if (ti == ct) {
#pragma unroll
              for (int r = 0; r < 4; ++r) *(RW_LAS float*)(lds + O_Z4 + ((row0 + r) * 16 + c) * 4) = (4 * g + r > c) ? ab[n][r] : 0.f; } } }
    RW_BAR(); RW_TS(4);
    { f32x4 a[2]; RW_ZERO(a); mm_nt(a, lds, O_Z1, O_VT, ti, ch, c, g);
#pragma unroll
      for (int n = 0; n < 2; ++n) st_tr(lds, O_BH, a[n], row0, 32 * ch + 16 * n + c);
      for (int i = tid; i < MB / 16; i += 512) { *(RW_LAS u32x4*)(lds + O_KH + i * 16) = (u32x4){0u, 0u, 0u, 0u}; *(RW_LAS u32x4*)(lds + O_AH + i * 16) = (u32x4){0u, 0u, 0u, 0u}; } }
    RW_BAR(); RW_TS(5);
    if (w == 0) { float d[16];
#pragma unroll
      for (int t = 0; t < 16; ++t) { float s = (t == c) ? 1.f : 0.f;
          f32x4 av4[4];
#pragma unroll
          for (int q = 0; q < 4; ++q) if (4 * q < t) av4[q] = *(const RW_LAS f32x4*)(lds + O_Z4 + ((16 * g + t) * 16 + 4 * q) * 4);
#pragma unroll
          for (int q = 0; q < t; ++q) s += av4[q >> 2][q & 3] * d[q];
          d[t] = s; asm volatile("" ::: "memory"); }
#pragma unroll
      for (int t = 0; t < 16; ++t) *(RW_LAS unsigned short*)(lds + O_KH + ((16 * g + t) * PT + 16 * g + c) * 2) = f2b(d[t]);
      u32x4 lo, hi; lo.x = pk(d[0], d[1]); lo.y = pk(d[2], d[3]); lo.z = pk(d[4], d[5]); lo.w = pk(d[6], d[7]); hi.x = pk(d[8], d[9]); hi.y = pk(d[10], d[11]); hi.z = pk(d[12], d[13]); hi.w = pk(d[14], d[15]);
      *(RW_LAS u32x4*)(lds + O_AH + ((16 * g + c) * PT + 16 * g) * 2) = lo; *(RW_LAS u32x4*)(lds + O_AH + ((16 * g + c) * PT + 16 * g + 8) * 2) = hi; }
    RW_BAR(); RW_TS(6);
    f32x4 gac[2], g2[2], hh[2];
    RW_ZERO(gac); mm_nt(gac, lds, O_KH, O_Z0, ti, ch, c, g);
#pragma unroll
    for (int n = 0; n < 2; ++n) { st_nat(lds, O_Z1, gac[n], row0, 32 * ch + 16 * n + c); st_tr(lds, O_Z4, gac[n], row0, 32 * ch + 16 * n + c); }
    RW_BAR(); RW_TS(7);
    RW_ZERO(g2); mm_nt(g2, lds, O_Z1, O_Z4, ti, ch, c, g);
#pragma unroll
    for (int n = 0; n < 2; ++n) st_tr(lds, O_Z0, g2[n], row0, 32 * ch + 16 * n + c);
    RW_BAR(); RW_TS(7);
    RW_ZERO(hh); mm_nt(hh, lds, O_Z1, O_Z0, ti, ch, c, g);
#pragma unroll
    for (int n = 0; n < 2; ++n) { const int col = 32 * ch + 16 * n + c;
#pragma unroll
        for (int r = 0; r < 4; ++r) hh[n][r] += gac[n][r] + g2[n][r] + ((row0 + r == col) ? 1.f : 0.f);
        st_nat(lds, O_Z4, hh[n], row0, col); }
    RW_BAR(); RW_TS(7);
    { f32x4 tt[2]; RW_ZERO(tt); mm_nt(tt, lds, O_Z4, O_AH, ti, ch, c, g);
      RW_BAR(); RW_TS(7);
#pragma unroll
      for (int n = 0; n < 2; ++n) st_nat(lds, O_Z1, tt[n], row0, 32 * ch + 16 * n + c); }
    RW_BAR(); RW_TS(7);
    { f32x4 ww[2], uu[2]; RW_ZERO(ww); RW_ZERO(uu); mm_nt(ww, lds, O_Z1, O_AHT, ti, ch, c, g); mm_nt(uu, lds, O_Z1, O_BH, ti, ch, c, g);
#pragma unroll
      for (int n = 0; n < 2; ++n) { st_tr(lds, O_Z0, ww[n], row0, 32 * ch + 16 * n + c); st_tr(lds, O_KH, uu[n], row0, 32 * ch + 16 * n + c); } }
    RW_BAR(); RW_TS(8);
    { f32x4 qt[2], ml[2], yi[2], nt[2]; RW_ZERO(qt); RW_ZERO(ml); RW_ZERO(yi); RW_ZERO(nt);
      mm_nt(qt, lds, O_Z0, O_Z2, ti, ch, c, g); mm_nt(ml, lds, O_Z0, O_BTT, ti, ch, c, g);
      mm_nt(yi, lds, O_Z2, O_KH, ti, ch, c, g); mm_nt(yi, lds, O_Z3, O_VT, ti, ch, c, g);
      mm_nt(nt, lds, O_BTT, O_KH, ti, ch, c, g); mm_nt(nt, lds, O_KTT, O_VT, ti, ch, c, g);
#pragma unroll
      for (int n = 0; n < 2; ++n) { const int col = 32 * ch + 16 * n + c;
          const u32x2 rv = *(const RW_LAS u32x2*)(lds + O_RH + (col * PT + row0) * 2);
          f32x4 q = qt[n]; q[0] += __uint_as_float(rv.x << 16); q[1] += __uint_as_float(rv.x & 0xffff0000u); q[2] += __uint_as_float(rv.y << 16); q[3] += __uint_as_float(rv.y & 0xffff0000u);
          const int fo = ((((col >> 4) * 2 + (ti >> 1)) * 64) + (col & 15) + 16 * g) * 8 + (ti & 1) * 4;
          u32x2 o; o.x = pk(q[0], q[1]); o.y = pk(q[2], q[3]); *(u32x2*)(rec + UNIT_QT + fo * 2) = o;
          o.x = pk(ml[n][0], ml[n][1]); o.y = pk(ml[n][2], ml[n][3]); *(u32x2*)(rec + UNIT_ML + fo * 2) = o;
          const int ao = (((2 * ch + n) * 4 + ti) * 64 + lane) * 4;
          o.x = pk(yi[n][0], yi[n][1]); o.y = pk(yi[n][2], yi[n][3]); *(u32x2*)(rec + UNIT_YI + ao * 2) = o;
          *(f32x4*)(rec + UNIT_NT + ao * 4) = nt[n]; } }
    RW_BAR(); RW_TS(9);
  }
#if TS_PROBE >= 100
    if (blockIdx.x == 0 && tid_in == 0) { tsw[0] = (unsigned)ts_acc; tsw[1] = (unsigned)(ts_acc >> 32); }
#endif
#undef RW_TS
#undef RW_PREFETCH_X
#undef RW_PREFETCH_E
#undef RW_LOAD_LORA
}

constexpr int PB_STAGE = 25600, PB_D = 5;
__device__ __forceinline__ void part_b_block(const unsigned char* REC, unsigned short* SREC, RW_LAS unsigned char* lds, int bh, int tid) {
    const int lane = tid & 63, w = __builtin_amdgcn_readfirstlane(tid >> 6), g = lane >> 4;
    const unsigned char* rec0 = REC + (size_t)(bh * 128) * UNIT_BYTES + UNIT_ML;
#define PB_SBAR() asm volatile("s_barrier" ::: "memory")
    if (w >= 4) {
        const int lw = w - 4;
#define PB_ISSUE(CH, SLOT) do { const unsigned char* src_ = rec0 + (size_t)(CH) * UNIT_BYTES + lane * 16; RW_LAS unsigned char* dst_ = lds + (SLOT) * PB_STAGE; \
            _Pragma("unroll") for (int p_ = 0; p_ < 7; ++p_) { const int pc_ = lw + 4 * p_; if (pc_ < 25) __builtin_amdgcn_global_load_lds((const unsigned*)(src_ + pc_ * 1024), (RW_LAS unsigned*)(dst_ + pc_ * 1024), 16, 0, 0); } } while (0)
        for (int c0 = 0; c0 < PB_D; ++c0) PB_ISSUE(c0, c0);
        int slot = 0;
        for (int chunk = 0; chunk < 128; ++chunk) {
            if (chunk <= 128 - PB_D) { if (lw == 0) asm volatile("s_waitcnt vmcnt(28)" ::: "memory"); else asm volatile("s_waitcnt vmcnt(24)" ::: "memory"); }
            else asm volatile("s_waitcnt vmcnt(0)" ::: "memory");
            PB_SBAR();
            PB_SBAR();
            if (chunk + PB_D < 128) PB_ISSUE(chunk + PB_D, slot);
            slot = (slot + 1 == PB_D) ? 0 : slot + 1;
        }
#undef PB_ISSUE
    } else {
        const int vs = w;
        f32x4 st[4];
#pragma unroll
        for (int i = 0; i < 4; ++i) st[i] = (f32x4){0.f, 0.f, 0.f, 0.f};
        unsigned short* sr = SREC + (size_t)(bh * 128) * 4096 + (vs * 2 * 64 + lane) * 8;
        int slot = 0;
        for (int chunk = 0; chunk < 128; ++chunk) {
            PB_SBAR();
            const RW_LAS unsigned char* sb = lds + slot * PB_STAGE;
            bf16x8 mf[4][2]; f32x4 nt[4], pp[4];
#pragma unroll
            for (int i = 0; i < 4; ++i) { mf[i][0] = *(const RW_LAS bf16x8*)(sb + (((i * 2 + 0) * 64) + lane) * 16); mf[i][1] = *(const RW_LAS bf16x8*)(sb + (((i * 2 + 1) * 64) + lane) * 16);
                nt[i] = *(const RW_LAS f32x4*)(sb + 8192 + ((vs * 4 + i) * 64 + lane) * 16); pp[i] = *(const RW_LAS f32x4*)(sb + 24576 + (16 * i + 4 * g) * 4); }
            asm volatile("s_waitcnt lgkmcnt(0)" ::: "memory");
            PB_SBAR();
            bf16x8 bf[2];
#pragma unroll
            for (int s = 0; s < 2; ++s) { u32x4 t_; t_.x = pk(st[2 * s][0], st[2 * s][1]); t_.y = pk(st[2 * s][2], st[2 * s][3]); t_.z = pk(st[2 * s + 1][0], st[2 * s + 1][1]); t_.w = pk(st[2 * s + 1][2], st[2 * s + 1][3]); bf[s] = __builtin_bit_cast(bf16x8, t_);
                *(u32x4*)(sr + (size_t)chunk * 4096 + s * 512) = t_; }
#pragma unroll
            for (int i = 0; i < 4; ++i) { f32x4 a_ = st[i] * pp[i] + nt[i];
                a_ = __builtin_amdgcn_mfma_f32_16x16x32_bf16(mf[i][0], bf[0], a_, 0, 0, 0); a_ = __builtin_amdgcn_mfma_f32_16x16x32_bf16(mf[i][1], bf[1], a_, 0, 0, 0); st[i] = a_; }
            slot = (slot + 1 == PB_D) ? 0 : slot + 1;
        }
    }
#undef PB_SBAR
}

struct PartC { const unsigned char* REC; const unsigned short* SREC; const unsigned short* BON; const unsigned short* GG; const float* ln_w; const float* ln_b; unsigned short* MIX; };
__device__ __forceinline__ void part_c_wave(const PartC& C, RW_LAS unsigned char* stage  , int unit, int i, int lane) {
    constexpr int T_ = 8192;
    const int c = lane & 15, g = lane >> 4, bh = unit >> 7, chunk = unit & 127, b = bh >> 3, h = bh & 7;
    const unsigned char* rec = C.REC + (size_t)unit * UNIT_BYTES; const unsigned short* sr = C.SREC + (size_t)unit * 4096;
    const bf16x8 q0 = *(const bf16x8*)(rec + UNIT_QT + (((i * 2 + 0) * 64) + lane) * 16), q1 = *(const bf16x8*)(rec + UNIT_QT + (((i * 2 + 1) * 64) + lane) * 16);
    f32x4 y[4]; u32x2 bo[4], gg[4];
#pragma unroll
    for (int n = 0; n < 4; ++n) { const bf16x8 s0 = *(const bf16x8*)(sr + ((n * 2 + 0) * 64 + lane) * 8), s1 = *(const bf16x8*)(sr + ((n * 2 + 1) * 64 + lane) * 8);
        const u32x2 yi = *(const u32x2*)(rec + UNIT_YI + ((n * 4 + i) * 64 + lane) * 8);
        bo[n] = *(const u32x2*)(C.BON + (size_t)unit * 4096 + ((n * 4 + i) * 64 + lane) * 4); gg[n] = *(const u32x2*)(C.GG + (size_t)unit * 4096 + ((n * 4 + i) * 64 + lane) * 4);
        f32x4 a; a[0] = __uint_as_float(yi.x << 16); a[1] = __uint_as_float(yi.x & 0xffff0000u); a[2] = __uint_as_float(yi.y << 16); a[3] = __uint_as_float(yi.y & 0xffff0000u);
        a = __builtin_amdgcn_mfma_f32_16x16x32_bf16(q0, s0, a, 0, 0, 0); a = __builtin_amdgcn_mfma_f32_16x16x32_bf16(q1, s1, a, 0, 0, 0); y[n] = a; }
    float lw[4], lb[4];
#pragma unroll
    for (int n = 0; n < 4; ++n) { lw[n] = C.ln_w[h * 64 + 16 * n + c]; lb[n] = C.ln_b[h * 64 + 16 * n + c]; }
#pragma unroll
    for (int r = 0; r < 4; ++r) {
        float s = (y[0][r] + y[1][r]) + (y[2][r] + y[3][r]);
        s += __shfl_xor(s, 1); s += __shfl_xor(s, 2); s += __shfl_xor(s, 4); s += __shfl_xor(s, 8);
        const float mean = s * (1.0f / 64.0f); float d[4], q = 0.f;
#pragma unroll
        for (int n = 0; n < 4; ++n) { d[n] = y[n][r] - mean; q += d[n] * d[n]; }
        q += __shfl_xor(q, 1); q += __shfl_xor(q, 2); q += __shfl_xor(q, 4); q += __shfl_xor(q, 8);
        const float rs = 1.0f / sqrtf(q * (1.0f / 64.0f) + 64e-5f);
#pragma unroll
        for (int n = 0; n < 4; ++n) { const unsigned bw = (r & 2) ? bo[n].y : bo[n].x, gw_ = (r & 2) ? gg[n].y : gg[n].x;
            const float bv = (r & 1) ? __uint_as_float(bw & 0xffff0000u) : __uint_as_float(bw << 16), gv = (r & 1) ? __uint_as_float(gw_ & 0xffff0000u) : __uint_as_float(gw_ << 16);
            *(RW_LAS unsigned short*)(stage + ((4 * g + r) * 64 + 16 * n + c) * 2) = f2b((d[n] * rs * lw[n] + lb[n] + bv) * gv); }
    }
    asm volatile("s_waitcnt lgkmcnt(0)" ::: "memory");
    unsigned short* mix = C.MIX + ((size_t)b * T_ + (size_t)chunk * 64 + 16 * i) * 1024 + h * 64;
#pragma unroll
    for (int rr = 0; rr < 2; ++rr) { const int row = (lane >> 3) + 8 * rr; const u32x4 v = *(const RW_LAS u32x4*)(stage + (row * 64 + (lane & 7) * 8) * 2); *(u32x4*)(mix + (size_t)row * 1024 + (lane & 7) * 8) = v; }
    asm volatile("s_waitcnt lgkmcnt(0)" ::: "memory");
}
#undef RW_ZERO
}

constexpr int NWAVES = 8;
#ifndef MK_N_LAUNCHES
#define MK_N_LAUNCHES 1
#endif
constexpr int PER_PHASE = 10;
constexpr int N_LAUNCHES = MK_N_LAUNCHES;

constexpr int BATCH = 4, T = 8192, D = 1024, M = BATCH * T;
constexpr int IN_W = 3336, NU = 3328;
constexpr int RW = 512, NH = 8, HD = 64;
constexpr int C_R = 0, C_K = 512, C_V = 1024, C_WL = 1536, C_AL = 1600, C_GL = 1664, C_FQ = 1792, C_FK = 2304, C_FV = 2816;
constexpr int NE = 32, TOPK = 4, DFF = 1024, NH1 = 2 * DFF;
constexpr int NSLOTS = M * TOPK + NE * 256;
constexpr float RMS_EPS = 1e-5f, GN_EPS = 64e-5f;
constexpr float LOG2E = 1.4426950408889634f;

constexpr size_t MiB = 1u << 20;
constexpr size_t WS_CTL = 0, CTL_ZERO_BYTES = 64 * 1024;
constexpr size_t WS_WIN = 2 * MiB, WS_WOUT = 9 * MiB, WS_W1 = 12 * MiB, WS_W2 = 140 * MiB;
constexpr size_t WS_XN = 204 * MiB;
constexpr size_t WS_U = 268 * MiB;
constexpr size_t WS_MIX = 476 * MiB;
constexpr size_t WS_X1 = 408 * MiB;
constexpr size_t WS_ACT = 268 * MiB;
constexpr size_t WS_Y2 = 540 * MiB;
constexpr size_t WS_LF = 812 * MiB, WS_CK = 813 * MiB;
constexpr size_t WS_ELIST = 814 * MiB;
constexpr size_t WS_TOKSLOT = 818 * MiB, WS_GATE = 819 * MiB;
constexpr size_t WS_RWT = 11 * MiB + 512 * 1024;
constexpr size_t WS_LORA = 11 * MiB;
constexpr size_t WS_REC = 540 * MiB;
constexpr size_t WS_BON = 820 * MiB, WS_GG = 852 * MiB, WS_SREC = 884 * MiB;
constexpr size_t WS_END = 916 * MiB;
static_assert(WS_REC + (size_t)4096 * rw::UNIT_BYTES <= 812 * MiB, "RWKV records fit the Y2 overlay");
constexpr int CW_TMO = 0, CW_CODE = 1;
constexpr int CW_BAR = 4096;
constexpr int CW_CNT = 8192;
constexpr int CW_AQ = 12288, CW_XQ = 12352, CW_XN = 12416;
constexpr int XW_LIMIT = 40;
constexpr int CW_QK = 12544;

constexpr int RING_OFF = 0, RING_BYTES = 131072;
constexpr int LDSCTL_OFF = 153600, MISC_OFF = LDSCTL_OFF + 320;
constexpr int LCNT_OFF = LDSCTL_OFF + 1024, LBASE_OFF = LCNT_OFF + 128, TPRE_OFF = LBASE_OFF + 128, ECNT_OFF = TPRE_OFF + 256;
constexpr int LDS_BYTES = 157696;
static_assert(rw::PART_A_LDS <= LDSCTL_OFF && RING_BYTES <= LDSCTL_OFF, "phase scratch below the control words");
static_assert(ECNT_OFF + 128 <= LDS_BYTES, "LDS map");

#define GAS __attribute__((address_space(1)))
#define LAS __attribute__((address_space(3)))
typedef unsigned short bf16;
typedef unsigned v4u __attribute__((ext_vector_type(4)));
typedef float f32x4 __attribute__((ext_vector_type(4)));
typedef short bf16x8 __attribute__((ext_vector_type(8)));
typedef GAS unsigned gu32;
typedef GAS unsigned long long gu64;
#define RLX_AGENT __ATOMIC_RELAXED, __HIP_MEMORY_SCOPE_AGENT
#define LDS_WAIT() asm volatile("s_waitcnt lgkmcnt(0)" ::: "memory")
#define VM_WAIT() asm volatile("s_waitcnt vmcnt(0)" ::: "memory")
__device__ __forceinline__ unsigned long long rt() { return __builtin_amdgcn_s_memrealtime(); }
__device__ __forceinline__ unsigned f2bf(float f) { unsigned u = __builtin_bit_cast(unsigned, f); return (u + 0x7fffu + ((u >> 16) & 1u)) >> 16; }
__device__ __forceinline__ unsigned pk2(float lo, float hi) { return f2bf(lo) | (f2bf(hi) << 16); }

#define XB_TMO      128
#define XB_XCNT(j)  (256  + 64 * (j))
#define XB_XSUB(j)  (1280 + 64 * (j))
#define XB_XGEN(j)  (2304 + 64 * (j))
#define XB_TOP      3328
#define XB_TOPGEN   3392
#define XCD_BAR_WORDS 3456
#define XB_SPIN_CAP (1u << 18)

__device__ __forceinline__ unsigned xb_ld(unsigned* p)              { return __hip_atomic_load(p, __ATOMIC_RELAXED, __HIP_MEMORY_SCOPE_AGENT); }
__device__ __forceinline__ unsigned xb_add(unsigned* p, unsigned v) { return __hip_atomic_fetch_add(p, v, __ATOMIC_RELAXED, __HIP_MEMORY_SCOPE_AGENT); }
__device__ __forceinline__ unsigned xb_xcc_id() { return (unsigned)__builtin_amdgcn_s_getreg((3 << 11) | 20) & 0xFu; }
#define XB_SPIN(cond, bar) do { unsigned _sp = 0; while (cond) { __builtin_amdgcn_s_sleep(1); \
    if ((++_sp & 255u) == 0u) { if (xb_ld(&(bar)[XB_TMO])) break; if (_sp > XB_SPIN_CAP) { atomicAdd(&(bar)[XB_TMO], 1u); break; } } } } while (0)

struct XcdBarrier {
    unsigned* bar; unsigned x;
    volatile LAS unsigned* st;
};

__device__ __forceinline__ XcdBarrier xcd_barrier_post(unsigned* bar, volatile LAS unsigned* st) {
    XcdBarrier b; b.bar = bar; b.x = xb_xcc_id(); b.st = st;
    if (threadIdx.x == 0) (void)xb_add(&bar[XB_XCNT(b.x)], 1u);
    return b;
}
__device__ __forceinline__ void xcd_barrier_complete(unsigned* bar, unsigned x, unsigned& nloc, unsigned& nx) {
    const unsigned G = gridDim.x * gridDim.y * gridDim.z;
    unsigned sum, cnt, mine, sp = 0u;
    for (;;) {
        sum = 0u; cnt = 0u; mine = 0u;
#pragma unroll
        for (unsigned j = 0; j < 16; ++j) { const unsigned c = xb_ld(&bar[XB_XCNT(j)]); sum += c; cnt += (c > 0u) ? 1u : 0u; mine = (j == x) ? c : mine; }
        if (sum == G) break;
        __builtin_amdgcn_s_sleep(1);
        if ((++sp & 255u) == 0u) { if (xb_ld(&bar[XB_TMO])) break; if (sp > XB_SPIN_CAP) { atomicAdd(&bar[XB_TMO], 1u); break; } }
    }
    nloc = mine > 0u ? mine : 1u; nx = cnt > 0u ? cnt : 1u;
}

__device__ __forceinline__ void xcd_barrier(const XcdBarrier& b) {
    asm volatile("s_waitcnt vmcnt(0)" ::: "memory");
    __syncthreads();
    if (threadIdx.x == 0) {
        unsigned* bar = b.bar;
        __builtin_amdgcn_s_waitcnt(0);
        unsigned nloc = b.st[0], nx = b.st[1];
        if (nloc == 0u) { xcd_barrier_complete(bar, b.x, nloc, nx); b.st[0] = nloc; b.st[1] = nx; }
        const unsigned old = xb_add(&bar[XB_XSUB(b.x)], 1u);
        const unsigned gen = old / nloc;
        if (old + 1u == (gen + 1u) * nloc) {
            __builtin_amdgcn_fence(__ATOMIC_RELEASE, "agent");
            asm volatile("s_waitcnt vmcnt(0)" ::: "memory");
            const unsigned og = xb_add(&bar[XB_TOP], 1u);
            const unsigned tg = og / nx;
            if (og + 1u == (tg + 1u) * nx) xb_add(&bar[XB_TOPGEN], 1u);
            else XB_SPIN(xb_ld(&bar[XB_TOPGEN]) == tg, bar);
            __builtin_amdgcn_fence(__ATOMIC_ACQUIRE, "agent");
            xb_add(&bar[XB_XGEN(b.x)], 1u);
            asm volatile("s_waitcnt vmcnt(0)" ::: "memory");
        } else {
            XB_SPIN(xb_ld(&bar[XB_XGEN(b.x)]) == gen, bar);
            __builtin_amdgcn_fence(__ATOMIC_ACQUIRE, "agent");
            asm volatile("s_waitcnt vmcnt(0)" ::: "memory");
        }
    }
    __syncthreads();
}
struct Frame {
    LAS unsigned char* lds;
    volatile LAS unsigned* MISC;
    gu32* ctl;
    int tid, lane, wave;
    int vcu, G;
    const float* const __attribute__((address_space(4)))* in;
    float* out; unsigned char* ws;
};
enum { I_X = 0, I_ANG, I_WIN, I_MU, I_W0, I_WUP, I_A0, I_AUP, I_GUP, I_KK, I_KA, I_RK, I_LNW, I_LNB, I_FB, I_OG, I_WOUT, I_FNG, I_RW, I_RB, I_W1, I_B1, I_W2, I_B2, I_FIN };

__device__ __forceinline__ float wave_sum(float v) {
#define WS_DPP(ctrl, rmask) v += __uint_as_float((unsigned)__builtin_amdgcn_update_dpp(0, (int)__float_as_uint(v), ctrl, rmask, 0xF, false))
    WS_DPP(0xB1, 0xF); WS_DPP(0x4E, 0xF); WS_DPP(0x141, 0xF); WS_DPP(0x140, 0xF);
    WS_DPP(0x142, 0xA); WS_DPP(0x143, 0xC);
#undef WS_DPP
    return __uint_as_float((unsigned)__builtin_amdgcn_readlane((int)__float_as_uint(v), 63));
}
__device__ __forceinline__ float bf2f(bf16 b) { return __uint_as_float((unsigned)b << 16); }
__device__ __forceinline__ float sigmoidf_(float x) { return 1.0f / (1.0f + __expf(-x)); }

struct XwRegs { f32x4 v[8]; };
__device__ __forceinline__ void p0_transpose_load(XwRegs& R, const float* W, int ldw, int ncols, int item, int lane) {
    const int nblk = ncols / 32, kb = item / nblk, nb = item % nblk, k0 = 64 * kb, n0 = 32 * nb;
#pragma unroll
    for (int i = 0; i < 8; ++i) { const int kk = 8 * i + (lane >> 3); R.v[i] = __builtin_nontemporal_load((const f32x4*)(W + (size_t)(k0 + kk) * ldw + n0 + 4 * (lane & 7))); }
}
template <bool FP8> __device__ __forceinline__ void p0_transpose_finish(const XwRegs& R, int K, int ncols, bf16* WT, LAS float* scr, int item, int lane) {
    const int nblk = ncols / 32, kb = item / nblk, nb = item % nblk, k0 = 64 * kb, n0 = 32 * nb;
#pragma unroll
    for (int i = 0; i < 8; ++i) { const int kk = 8 * i + (lane >> 3); LAS float* d = scr + kk * 33 + 4 * (lane & 7); d[0] = R.v[i].x; d[1] = R.v[i].y; d[2] = R.v[i].z; d[3] = R.v[i].w; }
    LDS_WAIT(); asm volatile("" ::: "memory");
    const int c = lane & 7;
#pragma unroll
    for (int j = 0; j < 4; ++j) { const int n = (lane >> 3) + 8 * j; const LAS float* s = scr + (8 * c) * 33 + n;
        if constexpr (FP8) { int w0 = __builtin_amdgcn_cvt_pk_fp8_f32(s[0 * 33] * 64.f, s[1 * 33] * 64.f, 0, false); w0 = __builtin_amdgcn_cvt_pk_fp8_f32(s[2 * 33] * 64.f, s[3 * 33] * 64.f, w0, true);
            int w1 = __builtin_amdgcn_cvt_pk_fp8_f32(s[4 * 33] * 64.f, s[5 * 33] * 64.f, 0, false); w1 = __builtin_amdgcn_cvt_pk_fp8_f32(s[6 * 33] * 64.f, s[7 * 33] * 64.f, w1, true);
            typedef int i32x2_ __attribute__((ext_vector_type(2))); *(i32x2_*)((unsigned char*)WT + (size_t)(n0 + n) * K + k0 + 8 * c) = (i32x2_){w0, w1}; }
        else { v4u o; o.x = pk2(s[0 * 33], s[1 * 33]); o.y = pk2(s[2 * 33], s[3 * 33]); o.z = pk2(s[4 * 33], s[5 * 33]); o.w = pk2(s[6 * 33], s[7 * 33]);
        *(GAS v4u*)(WT + (size_t)(n0 + n) * K + k0 + 8 * c) = o; } }
    LDS_WAIT(); asm volatile("" ::: "memory");
}
template <bool FP8> __device__ __forceinline__ void p0_transpose_item(const float* W, int K, int ldw, int ncols, bf16* WT, LAS float* scr, int item, int lane) {
    XwRegs R; p0_transpose_load(R, W, ldw, ncols, item, lane); p0_transpose_finish<FP8>(R, K, ncols, WT, scr, item, lane);
}

__device__ __forceinline__ void p0_prologue(Frame& F) {
    LAS float* scr = (LAS float*)(F.lds + RING_OFF + F.wave * 16384);
    const int gw = F.vcu * NWAVES + F.wave, NGW = F.G * NWAVES;
    constexpr int I_IN = (D / 64) * (NU / 32), I_O = (D / 64) * (D / 32), I_1 = (D / 64) * (NH1 / 32), I_2 = (DFF / 64) * (D / 32);
    constexpr int NITEMS = I_IN + I_O;
    bf16* WIN_T = (bf16*)(F.ws + WS_WIN); bf16* WOUT_T = (bf16*)(F.ws + WS_WOUT); bf16* W1_T = (bf16*)(F.ws + WS_W1); bf16* W2_T = (bf16*)(F.ws + WS_W2);
    for (int it = gw; it < NITEMS; it += NGW) {
        int r = it;
        if (r < I_IN) { p0_transpose_item<false>(F.in[I_WIN], D, IN_W, NU, WIN_T, scr, r, F.lane); continue; } r -= I_IN;
        p0_transpose_item<false>(F.in[I_WOUT], D, D, D, WOUT_T, scr, r, F.lane);
    }
    { bf16* WUPT = (bf16*)(F.ws + WS_LORA); bf16* AUPT = WUPT + RW * 64; bf16* GUPT = AUPT + RW * 64;
      for (int i = (F.vcu * NWAVES + F.wave) * 64 + F.lane; i < RW * 64; i += F.G * NWAVES * 64) { const int c = i >> 6, j = i & 63; WUPT[i] = (bf16)f2bf(F.in[I_WUP][j * RW + c]); AUPT[i] = (bf16)f2bf(F.in[I_AUP][j * RW + c]); }
      for (int i = (F.vcu * NWAVES + F.wave) * 64 + F.lane; i < RW * 128; i += F.G * NWAVES * 64) { const int c = i >> 7, j = i & 127; GUPT[i] = (bf16)f2bf(F.in[I_GUP][j * RW + c]); }
      bf16* RWH = (bf16*)(F.ws + WS_RWT); bf16* RWL = RWH + NE * D;
      for (int i = (F.vcu * NWAVES + F.wave) * 64 + F.lane; i < NE * D; i += F.G * NWAVES * 64) { const int e = i >> 10, k = i & 1023; const float w = F.in[I_RW][k * NE + e]; const unsigned h_ = f2bf(w); RWH[i] = (bf16)h_; RWL[i] = (bf16)f2bf(w - __uint_as_float(h_ << 16)); } }
    __syncthreads();
    LAS float* wfl = (LAS float*)(F.lds + RING_OFF);
    for (int k = F.tid; k < D; k += NWAVES * 64) {
#pragma unroll
        for (int j = 0; j < 8; ++j) wfl[j * D + k] = F.in[I_WIN][(size_t)k * IN_W + NU + j];
    }
    __syncthreads();
    bf16* XN = (bf16*)(F.ws + WS_XN); float* LF = (float*)(F.ws + WS_LF);
    const float* g = F.in[I_ANG];
    f32x4 gnv[4];
#pragma unroll
    for (int j = 0; j < 4; ++j) gnv[j] = *(const f32x4*)(g + 4 * F.lane + 256 * j);
    for (int m = gw; m < M; m += NGW) {
        const GAS f32x4* xr = (const GAS f32x4*)(F.in[I_X] + (size_t)m * D) + F.lane;
        f32x4 v[4]; float s2 = 0.f;
#pragma unroll
        for (int j = 0; j < 4; ++j) { v[j] = xr[64 * j]; s2 += (v[j].x * v[j].x + v[j].y * v[j].y) + (v[j].z * v[j].z + v[j].w * v[j].w); }
        const float rstd = 1.f / sqrtf(wave_sum(s2) * (1.f / D) + RMS_EPS);
        GAS unsigned long long* o8 = (GAS unsigned long long*)(XN + (size_t)m * D) + F.lane;
        float fl[8];
#pragma unroll
        for (int j = 0; j < 8; ++j) fl[j] = 0.f;
#pragma unroll
        for (int j = 0; j < 4; ++j) { const f32x4 gv = gnv[j]; v[j] = v[j] * rstd * gv;
            o8[64 * j] = (unsigned long long)pk2(v[j].x, v[j].y) | ((unsigned long long)pk2(v[j].z, v[j].w) << 32);
#pragma unroll
            for (int q = 0; q < 8; ++q) { const f32x4 w = *(const LAS f32x4*)(wfl + q * D + 4 * F.lane + 256 * j); fl[q] += (v[j].x * w.x + v[j].y * w.y) + (v[j].z * w.z + v[j].w * w.w); } }
        float mine = 0.f;
#pragma unroll
        for (int q = 0; q < 8; ++q) { const float s = wave_sum(fl[q]); if (F.lane == q) mine = s; }
        if (F.lane < 8) { const float z = mine + F.in[I_FB][F.lane]; const float ls = fminf(z, 0.f) - log1pf(__expf(-fabsf(z)));
            const int b = m / T, t = m % T; LF[(size_t)(b * NH + F.lane) * T + t] = ls * LOG2E; }
    }
}

constexpr int XW_I1 = (D / 64) * (NH1 / 32), XW_I2 = (DFF / 64) * (D / 32), XW_ITEMS = NE * (XW_I1 + XW_I2) / 32;
__device__ __forceinline__ void xw_item(Frame& F, int bi) {
    LAS float* scr = (LAS float*)(F.lds + RING_OFF + F.wave * 16384);
    unsigned char* W1_8 = F.ws + WS_W1; unsigned char* W2_8 = F.ws + WS_W2;
    const int r0 = bi * 32 + F.wave * 4;
    XwRegs R[4];
    if (r0 < NE * XW_I1) {
#pragma unroll
        for (int q = 0; q < 4; ++q) { const int r = r0 + q, e = r / XW_I1; p0_transpose_load(R[q], F.in[I_W1] + (size_t)e * D * NH1, NH1, NH1, r % XW_I1, F.lane); }
#pragma unroll
        for (int q = 0; q < 4; ++q) { const int r = r0 + q, e = r / XW_I1; p0_transpose_finish<true>(R[q], D, NH1, (bf16*)(W1_8 + (size_t)e * NH1 * D), scr, r % XW_I1, F.lane); }
    } else {
#pragma unroll
        for (int q = 0; q < 4; ++q) { const int r = r0 + q - NE * XW_I1, e = r / XW_I2; p0_transpose_load(R[q], F.in[I_W2] + (size_t)e * DFF * D, D, D, r % XW_I2, F.lane); }
#pragma unroll
        for (int q = 0; q < 4; ++q) { const int r = r0 + q - NE * XW_I1, e = r / XW_I2; p0_transpose_finish<true>(R[q], DFF, D, (bf16*)(W2_8 + (size_t)e * D * DFF), scr, r % XW_I2, F.lane); }
    }
}

__device__ __forceinline__ void p2_cumsum(Frame& F, int bh) {
    const float* lf = (const float*)(F.ws + WS_LF) + (size_t)bh * T; float* ck = (float*)(F.ws + WS_CK) + (size_t)bh * T;
    LAS double* wt = (LAS double*)(F.lds + RING_OFF);
    f32x4 v[4];
#pragma unroll
    for (int j = 0; j < 4; ++j) v[j] = *(const f32x4*)(lf + F.tid * 16 + 4 * j);
    double run = 0.0;
#pragma unroll
    for (int j = 0; j < 4; ++j) run += ((double)v[j].x + (double)v[j].y) + ((double)v[j].z + (double)v[j].w);
    double incl = run;
#pragma unroll
    for (int o = 1; o < 64; o <<= 1) { const double n = __shfl_up(incl, o); if (F.lane >= o) incl += n; }
    if (F.lane == 63) wt[F.wave] = incl;
    __syncthreads();
    double acc = incl - run;
    for (int j = 0; j < F.wave; ++j) acc += wt[j];
#pragma unroll
    for (int j = 0; j < 4; ++j) { f32x4 o; acc += (double)v[j].x; o.x = (float)acc; acc += (double)v[j].y; o.y = (float)acc; acc += (double)v[j].z; o.z = (float)acc; acc += (double)v[j].w; o.w = (float)acc; *(f32x4*)(ck + F.tid * 16 + 4 * j) = o; }
    __syncthreads();
}

__device__ __forceinline__ float row_max16(float v) {
#define RM_DPP(ctrl) v = fmaxf(v, __uint_as_float((unsigned)__builtin_amdgcn_update_dpp(0, (int)__float_as_uint(v), ctrl, 0xF, 0xF, true)))
    RM_DPP(0xB1); RM_DPP(0x4E); RM_DPP(0x141); RM_DPP(0x140);
#undef RM_DPP
    return v;
}
__device__ __forceinline__ int row_min16(int v) {
#define RM_DPP(ctrl) { const int o_ = __builtin_amdgcn_update_dpp(0, v, ctrl, 0xF, 0xF, true); v = o_ < v ? o_ : v; }
    RM_DPP(0xB1); RM_DPP(0x4E); RM_DPP(0x141); RM_DPP(0x140);
#undef RM_DPP
    return v;
}
__device__ __forceinline__ void p6_route(Frame& F) {
    typedef short bf16x8_ __attribute__((ext_vector_type(8)));
    LAS unsigned* lcnt = (LAS unsigned*)(F.lds + LCNT_OFF); LAS unsigned* lbase = (LAS unsigned*)(F.lds + LBASE_OFF);
    const bf16* X1 = (const bf16*)(F.ws + WS_X1); unsigned char* XN8 = F.ws + WS_XN; const float* g2 = F.in[I_FNG];
    const bf16* RWH = (const bf16*)(F.ws + WS_RWT); const bf16* RWL = RWH + NE * D;
    int* ELIST = (int*)(F.ws + WS_ELIST); int* TOKSLOT = (int*)(F.ws + WS_TOKSLOT); float* GATE = (float*)(F.ws + WS_GATE);
    const int lane = F.lane, c = lane & 15, g = lane >> 4;
    if (F.tid < NE) lcnt[F.tid] = 0u;
    __syncthreads();
    for (int blk = F.vcu; blk < M / 128; blk += F.G) {
        const int m0 = blk * 128 + F.wave * 16;
        const bf16* xr = X1 + (size_t)(m0 + c) * D + 8 * g;
        const float* gr = g2 + 8 * g;
        const bf16* bh0 = RWH + (size_t)c * D + 8 * g; const bf16* bh1 = bh0 + 16 * D; const bf16* bl0 = RWL + (size_t)c * D + 8 * g; const bf16* bl1 = bl0 + 16 * D;
        f32x4 a0 = {0.f, 0.f, 0.f, 0.f}, a1 = {0.f, 0.f, 0.f, 0.f}; float ss = 0.f;
#pragma unroll 4
        for (int s = 0; s < 32; ++s) {
            f32x4 x0, x1; { const v4u xw_ = *(const v4u*)(xr + 32 * s); x0 = (f32x4){__uint_as_float(xw_.x << 16), __uint_as_float(xw_.x & 0xffff0000u), __uint_as_float(xw_.y << 16), __uint_as_float(xw_.y & 0xffff0000u)}; x1 = (f32x4){__uint_as_float(xw_.z << 16), __uint_as_float(xw_.z & 0xffff0000u), __uint_as_float(xw_.w << 16), __uint_as_float(xw_.w & 0xffff0000u)}; } const f32x4 g0 = *(const f32x4*)(gr + 32 * s), g1 = *(const f32x4*)(gr + 32 * s + 4);
            const bf16x8_ wh0 = *(const bf16x8_*)(bh0 + 32 * s), wh1 = *(const bf16x8_*)(bh1 + 32 * s), wl0 = *(const bf16x8_*)(bl0 + 32 * s), wl1 = *(const bf16x8_*)(bl1 + 32 * s);
            ss += (x0.x * x0.x + x0.y * x0.y) + (x0.z * x0.z + x0.w * x0.w) + (x1.x * x1.x + x1.y * x1.y) + (x1.z * x1.z + x1.w * x1.w);
            const f32x4 y0 = x0 * g0, y1 = x1 * g1;
            v4u hi; hi.x = rw::pk(y0.x, y0.y); hi.y = rw::pk(y0.z, y0.w); hi.z = rw::pk(y1.x, y1.y); hi.w = rw::pk(y1.z, y1.w);
            v4u lo; lo.x = rw::pk(y0.x - __uint_as_float(hi.x << 16), y0.y - __uint_as_float(hi.x & 0xffff0000u)); lo.y = rw::pk(y0.z - __uint_as_float(hi.y << 16), y0.w - __uint_as_float(hi.y & 0xffff0000u));
            lo.z = rw::pk(y1.x - __uint_as_float(hi.z << 16), y1.y - __uint_as_float(hi.z & 0xffff0000u)); lo.w = rw::pk(y1.z - __uint_as_float(hi.w << 16), y1.w - __uint_as_float(hi.w & 0xffff0000u));
            const bf16x8_ ah = __builtin_bit_cast(bf16x8_, hi), al = __builtin_bit_cast(bf16x8_, lo);
            a0 = __builtin_amdgcn_mfma_f32_16x16x32_bf16(ah, wh0, a0, 0, 0, 0); a1 = __builtin_amdgcn_mfma_f32_16x16x32_bf16(ah, wh1, a1, 0, 0, 0);
            a0 = __builtin_amdgcn_mfma_f32_16x16x32_bf16(ah, wl0, a0, 0, 0, 0); a1 = __builtin_amdgcn_mfma_f32_16x16x32_bf16(ah, wl1, a1, 0, 0, 0);
            a0 = __builtin_amdgcn_mfma_f32_16x16x32_bf16(al, wh0, a0, 0, 0, 0); a1 = __builtin_amdgcn_mfma_f32_16x16x32_bf16(al, wh1, a1, 0, 0, 0);
        }
        ss += __shfl_xor(ss, 16); ss += __shfl_xor(ss, 32);
        const float rstd = 1.f / sqrtf(ss * (1.f / D) + RMS_EPS);
        { unsigned char* xo = XN8 + (size_t)(m0 + c) * D + 8 * g;
          for (int s0 = 0; s0 < 32; s0 += 4) { v4u xw4[4]; f32x4 ga[4], gb[4];
#pragma unroll
              for (int q = 0; q < 4; ++q) { xw4[q] = *(const v4u*)(xr + 32 * (s0 + q)); ga[q] = *(const f32x4*)(gr + 32 * (s0 + q)); gb[q] = *(const f32x4*)(gr + 32 * (s0 + q) + 4); }
#pragma unroll
              for (int q = 0; q < 4; ++q) { const v4u xw_ = xw4[q];
                  const f32x4 x0 = {__uint_as_float(xw_.x << 16), __uint_as_float(xw_.x & 0xffff0000u), __uint_as_float(xw_.y << 16), __uint_as_float(xw_.y & 0xffff0000u)}, x1 = {__uint_as_float(xw_.z << 16), __uint_as_float(xw_.z & 0xffff0000u), __uint_as_float(xw_.w << 16), __uint_as_float(xw_.w & 0xffff0000u)};
                  const f32x4 y0 = x0 * ga[q] * rstd, y1 = x1 * gb[q] * rstd;
                  int w0 = __builtin_amdgcn_cvt_pk_fp8_f32(y0.x, y0.y, 0, false); w0 = __builtin_amdgcn_cvt_pk_fp8_f32(y0.z, y0.w, w0, true);
                  int w1 = __builtin_amdgcn_cvt_pk_fp8_f32(y1.x, y1.y, 0, false); w1 = __builtin_amdgcn_cvt_pk_fp8_f32(y1.z, y1.w, w1, true);
                  typedef int i32x2_ __attribute__((ext_vector_type(2))); *(i32x2_*)(xo + 32 * (s0 + q)) = (i32x2_){w0, w1}; } } }
        const float rb0 = F.in[I_RB][c], rb1 = F.in[I_RB][16 + c];
        int pe = 0; float pg = 0.f;
#pragma unroll
        for (int r = 0; r < 4; ++r) { const float rs = __shfl(rstd, 4 * g + r); float v0 = a0[r] * rs + rb0, v1 = a1[r] * rs + rb1;
            float tv[4]; int ti[4];
#pragma unroll
            for (int k = 0; k < 4; ++k) { const bool first = v0 >= v1; const float bv = first ? v0 : v1; const int be = first ? c : 16 + c;
                const float mx = row_max16(bv); const int wi = row_min16(bv == mx ? be : 99);
                tv[k] = mx; ti[k] = wi; if (wi == c) v0 = -INFINITY; if (wi == 16 + c) v1 = -INFINITY; }
            const float e1 = __expf(tv[1] - tv[0]), e2 = __expf(tv[2] - tv[0]), e3 = __expf(tv[3] - tv[0]); const float inv = 1.f / (1.f + e1 + e2 + e3);
            if ((c >> 2) == r) { const int k = c & 3; pe = k == 0 ? ti[0] : k == 1 ? ti[1] : k == 2 ? ti[2] : ti[3]; pg = (k == 0 ? 1.f : k == 1 ? e1 : k == 2 ? e2 : e3) * inv; } }
        const int ptok = m0 + 4 * g + (c >> 2);
        const unsigned lpos = atomicAdd((unsigned*)(lcnt + pe), 1u);
        __syncthreads();
        if (F.tid < NE) { const unsigned n = lcnt[F.tid]; lbase[F.tid] = n ? __hip_atomic_fetch_add((unsigned*)(F.ctl + CW_CNT + 64 * F.tid), n, RLX_AGENT) : 0u; }
        __syncthreads();
        const unsigned p = lbase[pe] + lpos;
        ELIST[(size_t)pe * M + p] = ptok; TOKSLOT[ptok * 4 + (c & 3)] = (pe << 16) | (int)p; GATE[ptok * 4 + (c & 3)] = pg;
        __syncthreads();
        if (F.tid < NE) lcnt[F.tid] = 0u;
        __syncthreads();
    }
}

__device__ __forceinline__ void moe_prefix(Frame& F) {
    LAS int* tpre = (LAS int*)(F.lds + TPRE_OFF); LAS int* ecnt = (LAS int*)(F.lds + ECNT_OFF);
    if (F.tid < NE) ecnt[F.tid] = (int)__hip_atomic_load((unsigned*)(F.ctl + CW_CNT + 64 * F.tid), RLX_AGENT);
    __syncthreads();
    if (F.tid == 0) { int run = 0; for (int e = 0; e < NE; ++e) { tpre[e] = run; run += (ecnt[e] + 255) >> 8; } tpre[NE] = run; }
    __syncthreads();
}
struct MoeOrder {
    const LAS int* tpre; const LAS int* ecnt; int nN, G, c;
    __device__ __forceinline__ bool next(int i, pg8::Unit& u) const {
        const int ux = i * (G >> 3) + (c >> 3), pm = 8 * (ux / nN) + (c & 7); const int ntl = __builtin_amdgcn_readfirstlane(tpre[NE]); if (pm >= ntl) return false;
        const int L = ux; int e = 0;
        for (int j = 1; j < NE; ++j) { if (__builtin_amdgcn_readfirstlane(tpre[j]) <= pm) e = j; }
        u.pm = pm; u.pn = L % nN; u.e = e; u.l0 = (pm - __builtin_amdgcn_readfirstlane(tpre[e])) * 256; u.cnt = __builtin_amdgcn_readfirstlane(ecnt[e]); return true;
    }
    __device__ __forceinline__ void a_ready(const pg8::Unit&) const {}
    __device__ __forceinline__ void done(const pg8::Unit&) const {}
};

__device__ __forceinline__ void p9_final(Frame& F) {
    const int gw = F.vcu * NWAVES + F.wave, NGW = F.G * NWAVES, lane = F.lane;
    const LAS int* tpre = (const LAS int*)(F.lds + TPRE_OFF);
    const bf16* Y2 = (const bf16*)(F.ws + WS_Y2); const int* TOKSLOT = (const int*)(F.ws + WS_TOKSLOT); const float* GATE = (const float*)(F.ws + WS_GATE);
    const float* gf = F.in[I_FIN];
    int ts[4]; float gt[4];
    f32x4 gfv[4];
#pragma unroll
    for (int j = 0; j < 4; ++j) gfv[j] = *(const f32x4*)(gf + 4 * lane + 256 * j);
#pragma unroll
    for (int k = 0; k < 4; ++k) { ts[k] = TOKSLOT[gw * 4 + k]; gt[k] = GATE[gw * 4 + k]; }
    for (int m = gw; m < M; m += NGW) {
        GAS f32x4* xr = (GAS f32x4*)(F.out + (size_t)m * D) + lane;
        const GAS unsigned long long* x1r = (const GAS unsigned long long*)((const bf16*)(F.ws + WS_X1) + (size_t)m * D) + lane;
        f32x4 v[4];
#pragma unroll
        for (int j = 0; j < 4; ++j) { const unsigned long long w_ = x1r[64 * j]; const unsigned lo_ = (unsigned)w_, hi_ = (unsigned)(w_ >> 32);
            v[j] = (f32x4){__uint_as_float(lo_ << 16), __uint_as_float(lo_ & 0xffff0000u), __uint_as_float(hi_ << 16), __uint_as_float(hi_ & 0xffff0000u)}; }
        int yw[4][4]; float gc[4];
#pragma unroll
        for (int k = 0; k < 4; ++k) { const int e = ts[k] >> 16, p = ts[k] & 0xffff; gc[k] = gt[k] * 0.25f;
            const size_t row = (size_t)tpre[e] * 256 + p; const GAS int* yr = (const GAS int*)((const unsigned char*)Y2 + row * D) + lane;
#pragma unroll
            for (int j = 0; j < 4; ++j) yw[k][j] = yr[64 * j]; }
        { const int mn = (m + NGW < M) ? m + NGW : m;
#pragma unroll
          for (int k = 0; k < 4; ++k) { ts[k] = TOKSLOT[mn * 4 + k]; gt[k] = GATE[mn * 4 + k]; } }
#pragma unroll
        for (int k = 0; k < 4; ++k)
#pragma unroll
            for (int j = 0; j < 4; ++j) { const int w = yw[k][j]; const float g_ = gc[k];
                v[j].x += g_ * __builtin_amdgcn_cvt_f32_fp8(w, 0); v[j].y += g_ * __builtin_amdgcn_cvt_f32_fp8(w, 1); v[j].z += g_ * __builtin_amdgcn_cvt_f32_fp8(w, 2); v[j].w += g_ * __builtin_amdgcn_cvt_f32_fp8(w, 3); }
        float s2 = 0.f;
#pragma unroll
        for (int j = 0; j < 4; ++j) s2 += (v[j].x * v[j].x + v[j].y * v[j].y) + (v[j].z * v[j].z + v[j].w * v[j].w);
        const float rstd = 1.f / sqrtf(wave_sum(s2) * (1.f / D) + RMS_EPS);
#pragma unroll
        for (int j = 0; j < 4; ++j) xr[64 * j] = v[j] * rstd * gfv[j];
    }
}

struct Args { const float* in[25]; float* out; unsigned char* ws; int ph_lo, ph_hi, li, pad; };
__global__ void __launch_bounds__(NWAVES * 64, 2) mk_fwd(Args args) {
    extern __shared__ __attribute__((aligned(16))) unsigned char lds[];
    Frame F;
    F.lds = (LAS unsigned char*)lds;
    F.MISC = (volatile LAS unsigned*)(F.lds + MISC_OFF);
    F.tid = threadIdx.x; F.lane = F.tid & 63; F.wave = __builtin_amdgcn_readfirstlane(F.tid >> 6);
    F.G = gridDim.x; { const int bx = blockIdx.x; F.vcu = (F.G % 8 == 0) ? (bx % 8) * (F.G / 8) + bx / 8 : bx; }
    F.in = (const float* const __attribute__((address_space(4)))*)__builtin_amdgcn_kernarg_segment_ptr();
    F.out = args.out; F.ws = args.ws; F.ctl = (gu32*)(args.ws + WS_CTL);
    for (int u = F.tid; u < (LDS_BYTES - LDSCTL_OFF) / 4; u += NWAVES * 64) ((LAS unsigned*)(F.lds + LDSCTL_OFF))[u] = 0u;
    __syncthreads();
    XcdBarrier bar; bar.bar = (unsigned*)(F.ctl + CW_BAR); bar.x = 0; bar.st = nullptr;
    if (N_LAUNCHES != PER_PHASE) bar = xcd_barrier_post((unsigned*)(F.ctl + CW_BAR), F.MISC + 8);
#define GRID_BAR(seam) do { if (N_LAUNCHES == PER_PHASE) { if (F.tid == 0) __hip_atomic_store(F.ctl + CW_TMO, 0xBADBA0u | (unsigned)(seam), RLX_AGENT); } else { xcd_barrier(bar); } } while (0)
    const int lo = args.ph_lo, hi = args.ph_hi;
#define STAMP(k) do { if (TS_PROBE >= 0 && TS_PROBE < 100 && blockIdx.x == 0 && F.tid == 0) { const unsigned long long ts_ = __builtin_amdgcn_s_memrealtime(); F.MISC[32 + 2 * (k)] = (unsigned)ts_; F.MISC[33 + 2 * (k)] = (unsigned)(ts_ >> 32); } } while (0)
    STAMP(0);
#define IN(k) (lo <= (k) && (k) < hi)
#define BOTH(k) (IN(k) && IN((k) + 1))
    bf16* WIN_T = (bf16*)(F.ws + WS_WIN); bf16* WOUT_T = (bf16*)(F.ws + WS_WOUT); bf16* W1_T = (bf16*)(F.ws + WS_W1); bf16* W2_T = (bf16*)(F.ws + WS_W2);
    bf16* XN = (bf16*)(F.ws + WS_XN); bf16* U = (bf16*)(F.ws + WS_U); bf16* MIX = (bf16*)(F.ws + WS_MIX); bf16* ACT = (bf16*)(F.ws + WS_ACT); bf16* Y2 = (bf16*)(F.ws + WS_Y2);

    if (IN(0)) { _Pragma("unroll") for (int rep_ = 0; rep_ < DUPN(0); ++rep_) p0_prologue(F); if (BOTH(0)) GRID_BAR(0); STAMP(1); }

    if (IN(1)) {
        pg8::Gemm g{XN, WIN_T, D, 0, nullptr, 0}; pg8::StaticOrder S; S.init(M, NU, F.G, (int)blockIdx.x);
        pg8::EpiU E{U, NU, C_FQ / 256, C_FK / 256, attn_body::C2};
        _Pragma("unroll") for (int rep_ = 0; rep_ < DUPN(1); ++rep_) pg8::gemm_phase<pg8::EpiU, pg8::StaticOrder, false, PG8_ALIGN, PG8_SP2>(F.lds + RING_OFF, g, S, E);
        if (BOTH(1)) GRID_BAR(1); STAMP(2);
    }

    if (IN(2)) {
      _Pragma("unroll") for (int rep_ = 0; rep_ < DUPN(2); ++rep_) {
        _Pragma("unroll") for (int r2_ = 0; r2_ < DUPN(11); ++r2_) if (F.vcu < BATCH * NH) p2_cumsum(F, F.vcu);
        _Pragma("unroll") for (int r2_ = 0; r2_ < DUPN(10); ++r2_) { const int gw = F.vcu * NWAVES + F.wave, bh = gw & 31, b = bh / NH, h = bh % NH; float qm = 0.f, km = 0.f;
          {
            const bf16* ub = U + ((size_t)b * T + (size_t)(gw >> 5) * 128 + (F.lane >> 3)) * NU + h * HD + (F.lane & 7) * 8;
            v4u qv[16], kv[16];
#pragma unroll
            for (int i = 0; i < 16; ++i) { qv[i] = *(const v4u*)(ub + (size_t)i * 8 * NU + C_FQ); kv[i] = *(const v4u*)(ub + (size_t)i * 8 * NU + C_FK); }
#pragma unroll
            for (int i = 0; i < 16; ++i) { float sq = 0.f, sk = 0.f;
#pragma unroll
                for (int e = 0; e < 4; ++e) { const float q0 = __uint_as_float(qv[i][e] << 16), q1 = __uint_as_float(qv[i][e] & 0xffff0000u), k0 = __uint_as_float(kv[i][e] << 16), k1 = __uint_as_float(kv[i][e] & 0xffff0000u);
                    sq += q0 * q0 + q1 * q1; sk += k0 * k0 + k1 * k1; }
                qm = fmaxf(qm, sq + 0.f); km = fmaxf(km, sk); qv[i].x = __float_as_uint(sq); kv[i].x = __float_as_uint(sk); }
            qm = 0.f; km = 0.f;
#pragma unroll
            for (int i = 0; i < 16; ++i) { float sq = __uint_as_float(qv[i].x), sk = __uint_as_float(kv[i].x);
#define NR_DPP(v, ctrl) v += __uint_as_float((unsigned)__builtin_amdgcn_update_dpp(0, (int)__float_as_uint(v), ctrl, 0xF, 0xF, true))
                NR_DPP(sq, 0xB1); NR_DPP(sq, 0x4E); NR_DPP(sq, 0x141); NR_DPP(sk, 0xB1); NR_DPP(sk, 0x4E); NR_DPP(sk, 0x141);
#undef NR_DPP
                qm = fmaxf(qm, sq); km = fmaxf(km, sk); }
#pragma unroll
            for (int o = 8; o < 64; o <<= 1) { qm = fmaxf(qm, __shfl_xor(qm, o)); km = fmaxf(km, __shfl_xor(km, o)); } }
          if (F.lane == 0) { __hip_atomic_fetch_max((unsigned*)(F.ctl + CW_QK + 64 * bh), __float_as_uint(sqrtf(qm)), RLX_AGENT); __hip_atomic_fetch_max((unsigned*)(F.ctl + CW_QK + 64 * bh + 1), __float_as_uint(sqrtf(km)), RLX_AGENT); } }
        {
          const rw::PartA PA{F.in, F.ws, WS_U, WS_LORA, WS_REC, WS_BON, WS_GG};
          _Pragma("unroll") for (int r2_ = 0; r2_ < DUPN(9); ++r2_) for (int u = F.vcu * 16; u < 4096; u += F.G * 16)
              rw::part_a_block(PA, F.lds + RING_OFF, u >> 7, u & 127, 16, F.tid, F.MISC + 60); }
      }
        if (BOTH(2)) GRID_BAR(2); STAMP(3);
    }

    if (IN(3)) {
        const attn_body::AttnTensors AT{(const attn_body::bf16*)(U + C_FQ), (const attn_body::bf16*)(U + C_FK), (const attn_body::bf16*)(U + C_FV), (attn_body::bf16*)(MIX + RW),
                                        (const float*)(F.ws + WS_CK), F.in[I_OG]};
      {
        _Pragma("unroll") for (int r2_ = 0; r2_ < DUPN(16); ++r2_) if (F.vcu < BATCH * NH) rw::part_b_block(F.ws + WS_REC, (bf16*)(F.ws + WS_SREC), F.lds + RING_OFF, F.vcu, F.tid);
        __syncthreads();
        for (;;) {
            if (F.wave == 0) {
                int ln_ = (int)threadIdx.x; asm volatile("" : "+v"(ln_));
                unsigned jj = 0; if (ln_ == 0) { jj = __hip_atomic_fetch_add((unsigned*)(F.ctl + CW_AQ), 1u, RLX_AGENT); F.MISC[18] = 0u; }
                int j = (int)__builtin_amdgcn_readfirstlane(jj); int kt0 = 0;
                const int NQ_ = 1024 + XW_ITEMS; j = (j < NQ_) ? (((j % 5) < 2) ? (j / 5) * 2 + (j % 5) : 1024 + (j / 5) * 3 + (j % 5) - 2) : NQ_;
                if (j < BATCH * NH * (T / 256)) { const int bh = j & 31, qb = 31 - (j >> 5), q0 = qb * 256, ntf = (q0 + 256) / 64;
                    const float th = 2.0f * __uint_as_float(__hip_atomic_load((unsigned*)(F.ctl + CW_QK + 64 * bh), RLX_AGENT)) * __uint_as_float(__hip_atomic_load((unsigned*)(F.ctl + CW_QK + 64 * bh + 1), RLX_AGENT)) + 37.0f;
                    const float* ck = AT.CK + (size_t)bh * T; const int cand = 2 * ln_;
                    bool ok = false; if (cand >= 2 && cand <= ntf - 4) ok = (ck[64 * cand - 1] - ck[q0]) >= th;
                    kt0 = 2 * (int)__popcll(__ballot(ok)); }
                if (ln_ == 0) { F.MISC[16] = (unsigned)j; F.MISC[17] = (unsigned)kt0; } }
            __syncthreads();
            const int j = (int)F.MISC[16], kt0 = (int)F.MISC[17]; const unsigned lim = F.MISC[18];
            __syncthreads();
            if (j >= 1024 + XW_ITEMS) break;
            if (j >= 1024) { xw_item(F, j - 1024); if (lim && F.tid == 0) __hip_atomic_fetch_add((unsigned*)(F.ctl + CW_XN), 0xffffffffu, RLX_AGENT); continue; }
            const int bh = j & 31, qb = 31 - (j >> 5);
            attn_body::attn_unit<8>(bh / NH, bh % NH, qb, kt0, AT.Q, AT.K, AT.V, AT.O, AT.CK, AT.OG, (char*)lds + RING_OFF);
        }
      }
        if (BOTH(3)) GRID_BAR(3); STAMP(4);
    }

    if (IN(4)) {
        const rw::PartC PC{F.ws + WS_REC, (const bf16*)(F.ws + WS_SREC), (const bf16*)(F.ws + WS_BON), (const bf16*)(F.ws + WS_GG), F.in[I_LNW], F.in[I_LNB], MIX};
        _Pragma("unroll") for (int rep_ = 0; rep_ < DUPN(4); ++rep_) for (int u = F.vcu * 2 + (F.wave >> 2); u < 4096; u += F.G * 2) rw::part_c_wave(PC, F.lds + RING_OFF + F.wave * 2048, u, F.wave & 3, F.lane);
        if (BOTH(4)) GRID_BAR(4); STAMP(5);
    }

    if (IN(5)) {
        pg8::Gemm g{MIX, WOUT_T, D, 0, nullptr, 0}; pg8::StaticOrder S; S.init(M, D, F.G, (int)blockIdx.x);
        pg8::EpiRes E{F.in[I_X], (bf16*)(F.ws + WS_X1), D};
        _Pragma("unroll") for (int rep_ = 0; rep_ < DUPN(5); ++rep_) pg8::gemm_phase<pg8::EpiRes, pg8::StaticOrder, false, PG8_ALIGN, PG8_SP2>(F.lds + RING_OFF, g, S, E);
        if (BOTH(5)) GRID_BAR(5); STAMP(6);
    }

    if (IN(6)) { p6_route(F); if (BOTH(6)) GRID_BAR(6); STAMP(7); }

    if (IN(7)) {
        moe_prefix(F);
        pg8::Gemm g{XN, W1_T, D / 2, (size_t)NH1 * D / 2, (const int*)(F.ws + WS_ELIST), M};
        MoeOrder S{(const LAS int*)(F.lds + TPRE_OFF), (const LAS int*)(F.lds + ECNT_OFF), NH1 / 256, F.G, (int)blockIdx.x};
        pg8::EpiSwiglu E{(unsigned char*)ACT, DFF, F.in[I_B1], NH1};
        _Pragma("unroll") for (int rep_ = 0; rep_ < DUPN(7); ++rep_) pg8::gemm_phase<pg8::EpiSwiglu, MoeOrder, true, PG8_ALIGN, PG8_SP2, 121>(F.lds + RING_OFF, g, S, E);
        if (BOTH(7)) GRID_BAR(7); STAMP(8);
    }

    if (IN(8)) {
        if (!IN(7)) moe_prefix(F);
        pg8::Gemm g{ACT, W2_T, DFF / 2, (size_t)D * DFF / 2, nullptr, 0};
        MoeOrder S{(const LAS int*)(F.lds + TPRE_OFF), (const LAS int*)(F.lds + ECNT_OFF), D / 256, F.G, (int)blockIdx.x};
        pg8::EpiBias E{(unsigned char*)Y2, D, F.in[I_B2], D};
        _Pragma("unroll") for (int rep_ = 0; rep_ < DUPN(8); ++rep_) pg8::gemm_phase<pg8::EpiBias, MoeOrder, false, PG8_ALIGN, PG8_SP2, 121>(F.lds + RING_OFF, g, S, E);
        if (BOTH(8)) GRID_BAR(8); STAMP(9);
    }

    if (IN(9)) { if (!IN(8)) moe_prefix(F); p9_final(F); }
    STAMP(10);
    if (TS_PROBE >= 100 && blockIdx.x == 0 && F.tid == 0) {
        const unsigned long long span_ = (((unsigned long long)F.MISC[61] << 32) | F.MISC[60]) * TS_MULT, t0_ = __builtin_amdgcn_s_memrealtime();
        while (__builtin_amdgcn_s_memrealtime() - t0_ < span_) __builtin_amdgcn_s_sleep(8);
    }
    if (TS_PROBE >= 0 && TS_PROBE < 100 && blockIdx.x == 0 && F.tid == 0) {
        const unsigned long long a_ = ((unsigned long long)F.MISC[33 + 2 * TS_PROBE] << 32) | F.MISC[32 + 2 * TS_PROBE], b_ = ((unsigned long long)F.MISC[35 + 2 * TS_PROBE] << 32) | F.MISC[34 + 2 * TS_PROBE];
        const unsigned long long t0_ = __builtin_amdgcn_s_memrealtime(), span_ = (b_ - a_) * TS_MULT;
        while (__builtin_amdgcn_s_memrealtime() - t0_ < span_) __builtin_amdgcn_s_sleep(8);
    }
#undef IN
#undef BOTH
}

extern "C" void kernel_launch(void* const* d_in, const int* in_sizes, int n_in, void* d_out, int out_size, void* d_ws, size_t ws_size, hipStream_t stream) {
    static int grid = 0;
    if (grid == 0) {
        if (n_in != 25 || in_sizes[0] != M * D || out_size != M * D || ws_size < WS_END) { fprintf(stderr, "kernel_launch: unexpected shapes (n_in %d, in0 %d, out %d, ws %zu); nothing launched\n", n_in, n_in > 0 ? in_sizes[0] : -1, out_size, ws_size); grid = -1; return; }
        int dev = 0, cus = 0, per_cu = 0;
        if (hipGetDevice(&dev) != hipSuccess || hipDeviceGetAttribute(&cus, hipDeviceAttributeMultiprocessorCount, dev) != hipSuccess) { grid = -1; return; }
        if (hipFuncSetAttribute((const void*)mk_fwd, hipFuncAttributeMaxDynamicSharedMemorySize, LDS_BYTES) != hipSuccess) { fprintf(stderr, "kernel_launch: hipFuncSetAttribute failed\n"); grid = -1; return; }
        if (hipOccupancyMaxActiveBlocksPerMultiprocessor(&per_cu, (const void*)mk_fwd, NWAVES * 64, LDS_BYTES) != hipSuccess || per_cu < 1) fprintf(stderr, "kernel_launch: occupancy query reports %d\n", per_cu);
        (void)hipGetLastError();
        grid = cus;
        if (grid != 256) { fprintf(stderr, "kernel_launch: built for 256 CUs, found %d\n", grid); }
    }
    if (grid < 0) return;
    if (hipMemsetAsync((char*)d_ws + WS_CTL, 0, CTL_ZERO_BYTES, stream) != hipSuccess) return;
    Args a{};
    for (int i = 0; i < 25; ++i) a.in[i] = (const float*)d_in[i];
    a.out = (float*)d_out; a.ws = (unsigned char*)d_ws;
    for (int li = 0; li < N_LAUNCHES; ++li) {
        a.ph_lo = (N_LAUNCHES == PER_PHASE) ? li : 0; a.ph_hi = (N_LAUNCHES == PER_PHASE) ? li + 1 : PER_PHASE; a.li = li;
        hipLaunchKernelGGL(mk_fwd, dim3(grid), dim3(NWAVES * 64), LDS_BYTES, stream, a);
    }
}
```

```cpp
#ifndef DUP_MASK
#define DUP_MASK 0
#endif
#define DUPN(k) (((DUP_MASK) >> (k)) & 1 ? 2 : 1)
#ifndef TS_PROBE
#define TS_PROBE (-1)
#endif
#define TS_MULT 4
#include <hip/hip_runtime.h>
#include <cstdio>
#include <cstdint>
namespace pg8 {
#define PG8_LAS __attribute__((address_space(3)))
typedef unsigned short bf16_t;
typedef short bf16x8 __attribute__((ext_vector_type(8)));
typedef float f32x4 __attribute__((ext_vector_type(4)));
typedef unsigned u32x4 __attribute__((ext_vector_type(4)));
typedef int i32x4 __attribute__((ext_vector_type(4)));
typedef int i32x8 __attribute__((ext_vector_type(8)));
constexpr int BM = 256, BK = 64, HALF = 128, HTB = HALF * BK * 2  , STAGE_BYTES = 8 * HTB, NXCD = 8, WGM = 8;

__host__ __device__ __forceinline__ int lds_byte(int r, int c) { const int st = (r >> 4) * 2 + (c >> 5), rr = r & 15, cc = c & 31, ob = rr * 64 + cc * 2; return st * 1024 + (ob ^ (((ob >> 9) & 1) << 5)); }
__host__ __device__ __forceinline__ void stage_rc(int b, int& R, int& C) { const int st = b / 1024, sb = b % 1024, swz = sb ^ (((sb >> 9) & 1) << 5); R = (st >> 1) * 16 + swz / 64; C = (st & 1) * 32 + (swz % 64) / 2; }
__host__ __device__ __forceinline__ int perm32(int rho) { const int n = rho >> 4, i = rho & 15; return 8 * (i >> 2) + 4 * n + (i & 3); }

struct Unit { int pm, pn, e, l0, cnt; };
struct Gemm { const bf16_t* A; const bf16_t* Bt; int K; size_t bstride; const int* rows; int rows_stride; };

struct StaticOrder {
    int nM, nN, nwg, G, c;
    __host__ __device__ void init(int M, int N, int G_, int c_) { nM = M / BM; nN = N / BM; nwg = nM * nN; G = G_; c = c_; }
    __host__ __device__ bool next(int i, Unit& u) const {
        const long L = (long)i * G + c; if (L >= nwg) return false;
        int wgid = (int)L; { const int q = nwg / NXCD, r = nwg % NXCD, xcd = wgid % NXCD, off = wgid / NXCD; wgid = (xcd < r ? xcd * (q + 1) : r * (q + 1) + (xcd - r) * q) + off; }
        const int nig = WGM * nN, gid = wgid / nig, fm = gid * WGM, gsz = (nM - fm) < WGM ? (nM - fm) : WGM;
        u.pm = fm + ((wgid % nig) % gsz); u.pn = (wgid % nig) / gsz; u.e = 0; u.l0 = 0; u.cnt = 256; return true;
    }
    __device__ __forceinline__ void a_ready(const Unit&) const {}
    __device__ __forceinline__ void done(const Unit&) const {}
};

__device__ __forceinline__ unsigned cvt_pk_bf16(float lo, float hi) { unsigned r; asm volatile("v_cvt_pk_bf16_f32 %0, %1, %2" : "=v"(r) : "v"(lo), "v"(hi)); return r; }
typedef float f32x2 __attribute__((ext_vector_type(2)));
typedef unsigned u32x2 __attribute__((ext_vector_type(2)));
struct EpiU {
    static constexpr bool PERM = true, AFTER_DRAIN = false;
    bf16_t* O; int ldc; int q_lo, q_hi; float qscale;
    __device__ __forceinline__ void operator()(const f32x4 (&acc)[2][2][4][2], const Unit& u, int wr, int wc, int fr, int fq) const {
        const int row0 = u.pm * BM + wr * 64 + fr; const int col0 = u.pn * BM + wc * 32 + 8 * fq;
        const float sc = (u.pn >= q_lo && u.pn < q_hi) ? qscale : 1.f;
#pragma unroll
        for (int ai = 0; ai < 2; ++ai)
#pragma unroll
            for (int m = 0; m < 4; ++m) { bf16_t* rowp = O + (size_t)(row0 + ai * HALF + m * 16) * ldc + col0;
#pragma unroll
                for (int bj = 0; bj < 2; ++bj) { const f32x4 v0 = acc[ai][bj][m][0] * sc, v1 = acc[ai][bj][m][1] * sc;
                    u32x4 w; w.x = cvt_pk_bf16(v0[0], v0[1]); w.y = cvt_pk_bf16(v0[2], v0[3]); w.z = cvt_pk_bf16(v1[0], v1[1]); w.w = cvt_pk_bf16(v1[2], v1[3]);
                    *(u32x4*)(rowp + bj * HALF) = w; } }
    }
};
struct EpiRes {
    static constexpr bool PERM = false, AFTER_DRAIN = false;
    const float* base; bf16_t* out; int ldc;
    __device__ __forceinline__ void operator()(const f32x4 (&acc)[2][2][4][2], const Unit& u, int wr, int wc, int fr, int fq) const {
        const int col0 = u.pn * BM + wc * 32 + 4 * fq;
#pragma unroll
        for (int ai = 0; ai < 2; ++ai) {
            f32x4 pre[4][2][2];
#pragma unroll
            for (int m = 0; m < 4; ++m) { const size_t off = (size_t)(u.pm * BM + ai * HALF + wr * 64 + m * 16 + fr) * ldc + col0;
#pragma unroll
                for (int bj = 0; bj < 2; ++bj)
#pragma unroll
                    for (int n = 0; n < 2; ++n) pre[m][bj][n] = *(const f32x4*)(base + off + bj * HALF + n * 16); }
#pragma unroll
            for (int m = 0; m < 4; ++m) { const size_t off = (size_t)(u.pm * BM + ai * HALF + wr * 64 + m * 16 + fr) * ldc + col0;
#pragma unroll
                for (int bj = 0; bj < 2; ++bj)
#pragma unroll
                    for (int n = 0; n < 2; ++n) { const f32x4 v = pre[m][bj][n] + acc[ai][bj][m][n];
                        u32x2 w; w.x = cvt_pk_bf16(v[0], v[1]); w.y = cvt_pk_bf16(v[2], v[3]); *(u32x2*)(out + off + bj * HALF + n * 16) = w; } }
        }
    }
};
struct EpiSwiglu {
    static constexpr bool PERM = true, AFTER_DRAIN = false;
    unsigned char* O; int ldc; const float* bias; int nb;
    __device__ __forceinline__ static f32x2 act2(f32x4 h) {
        f32x2 g = {fminf(h[0], 7.0f), fminf(h[2], 7.0f)}, l = {fminf(fmaxf(h[1], -7.0f), 7.0f), fminf(fmaxf(h[3], -7.0f), 7.0f)};
        const f32x2 z = g * (-1.702f * 1.4426950408889634f);
        f32x2 e = {__builtin_amdgcn_exp2f(z.x), __builtin_amdgcn_exp2f(z.y)}; e = e + 1.0f;
        const f32x2 s = {__builtin_amdgcn_rcpf(e.x), __builtin_amdgcn_rcpf(e.y)};
        return (g * s) * (l + 1.0f);
    }
    __device__ __forceinline__ void operator()(const f32x4 (&acc)[2][2][4][2], const Unit& u, int wr, int wc, int fr, int fq) const {
        const int row0 = u.pm * BM + wr * 64 + fr; const int col0 = u.pn * BM + wc * 32 + 8 * fq;
        const float* bp = bias + (size_t)u.e * nb + col0;
        f32x4 bv[2][2];
#pragma unroll
        for (int bj = 0; bj < 2; ++bj)
#pragma unroll
            for (int n = 0; n < 2; ++n) bv[bj][n] = *(const f32x4*)(bp + bj * HALF + 4 * n);
#pragma unroll
        for (int ai = 0; ai < 2; ++ai)
#pragma unroll
            for (int m = 0; m < 4; ++m) { unsigned char* rowp = O + (size_t)(row0 + ai * HALF + m * 16) * ldc + (col0 >> 1);
#pragma unroll
                for (int bj = 0; bj < 2; ++bj) { const f32x4 v0 = acc[ai][bj][m][0] + bv[bj][0], v1 = acc[ai][bj][m][1] + bv[bj][1];
                    const f32x2 a0 = act2(v0), a1 = act2(v1);
                    int w = __builtin_amdgcn_cvt_pk_fp8_f32(a0.x, a0.y, 0, false); w = __builtin_amdgcn_cvt_pk_fp8_f32(a1.x, a1.y, w, true);
                    *(int*)(rowp + bj * (HALF / 2)) = w; } }
    }
};
struct EpiBias {
    static constexpr bool PERM = true, AFTER_DRAIN = false;
    unsigned char* O; int ldc; const float* bias; int nb;
    __device__ __forceinline__ void operator()(const f32x4 (&acc)[2][2][4][2], const Unit& u, int wr, int wc, int fr, int fq) const {
        const int row0 = u.pm * BM + wr * 64 + fr; const int col0 = u.pn * BM + wc * 32 + 8 * fq;
        const float* bp = bias + (size_t)u.e * nb + col0;
        f32x4 bv[2][2];
#pragma unroll
        for (int bj = 0; bj < 2; ++bj)
#pragma unroll
            for (int n = 0; n < 2; ++n) bv[bj][n] = *(const f32x4*)(bp + bj * HALF + 4 * n);
#pragma unroll
        for (int ai = 0; ai < 2; ++ai)
#pragma unroll
            for (int m = 0; m < 4; ++m) { unsigned char* rowp = O + (size_t)(row0 + ai * HALF + m * 16) * ldc + col0;
#pragma unroll
                for (int bj = 0; bj < 2; ++bj) { const f32x4 v0 = (acc[ai][bj][m][0] + bv[bj][0]) * 4.0f, v1 = (acc[ai][bj][m][1] + bv[bj][1]) * 4.0f;
                    int w0 = __builtin_amdgcn_cvt_pk_fp8_f32(v0[0], v0[1], 0, false); w0 = __builtin_amdgcn_cvt_pk_fp8_f32(v0[2], v0[3], w0, true);
                    int w1 = __builtin_amdgcn_cvt_pk_fp8_f32(v1[0], v1[1], 0, false); w1 = __builtin_amdgcn_cvt_pk_fp8_f32(v1[2], v1[3], w1, true);
                    u32x2 w; w.x = (unsigned)w0; w.y = (unsigned)w1; *(u32x2*)(rowp + bj * HALF) = w; } }
    }
};

template <class Epi, class Sched, bool GATHER, bool ALIGN_EPI = false, bool SP2 = false, int FP8SCALE = 0>
__device__ __forceinline__ void gemm_phase(PG8_LAS unsigned char* lds, const Gemm g, const Sched& S, const Epi& E) {
    const int tid = threadIdx.x, wid = __builtin_amdgcn_readfirstlane(tid >> 6), lane = tid & 63, wr = wid >> 2, wc = wid & 3, fr = lane & 15, fq = lane >> 4;
    const int K = g.K, nt = K / BK;
    unsigned voffA[2], voffB[2]; int sR[2], sC[2];
#pragma unroll
    for (int i = 0; i < 2; ++i) { int R, C; stage_rc(tid * 16 + i * 8192, R, C); const int Rb = Epi::PERM ? ((R & ~31) + perm32(R & 31)) : R; sR[i] = R; sC[i] = C;
        voffA[i] = (unsigned)(R * K + C) * 2u; voffB[i] = (unsigned)(Rb * K + C) * 2u; }
    unsigned vC[2][2], vN[2][2], vS[2][2];
#define PG8_GOFF(U, V) do { _Pragma("unroll") for (int _h = 0; _h < 2; ++_h) _Pragma("unroll") for (int _i = 0; _i < 2; ++_i) { int _ix = (U).l0 + _h * HALF + sR[_i]; _ix = _ix < (U).cnt ? _ix : (U).cnt - 1; \
        const int _tok = g.rows[(size_t)(U).e * g.rows_stride + _ix]; V[_h][_i] = (unsigned)(_tok * K + sC[_i]) * 2u; } } while (0)
#define PG8_STAGE_A(bufoff, gbase, h, VG) do { if constexpr (GATHER) { PG8_STAGE(bufoff, gbase, VG[h]); } else { PG8_STAGE(bufoff, (gbase) + (h) * hstep, voffA); } } while (0)
    const size_t kstep = (size_t)(BK * 2);
    const size_t hstep = (size_t)HALF * K * 2;
    const size_t tstep = 2 * hstep;
    const unsigned ldsw = (unsigned)wid * 1024u;
    const int aoff = lds_byte(wr * 64 + fr, fq * 8), boff = lds_byte(wc * 32 + fr, fq * 8);
#define PG8_SA(b, h) (((b) * 2 + (h)) * HTB)
#define PG8_SB(b, h) ((4 + (b) * 2 + (h)) * HTB)
#define PG8_STAGE(bufoff, gbase, voff) do { _Pragma("unroll") for (int _i = 0; _i < 2; ++_i) \
        __builtin_amdgcn_global_load_lds((const unsigned*)((const char*)(gbase) + (voff)[_i]), (PG8_LAS unsigned*)(lds + (bufoff) + ldsw + _i * 8192), 16, 0, 0); } while (0)
#define PG8_CAT(lo, hi) __builtin_shufflevector(lo, hi, 0, 1, 2, 3, 4, 5, 6, 7)
#define PG8_LDA(dst, b, h) do { _Pragma("unroll") for (int m = 0; m < 4; ++m) dst[m] = PG8_CAT(*(const PG8_LAS i32x4*)(lds + PG8_SA(b, h) + aoff + m * 2048), *(const PG8_LAS i32x4*)(lds + PG8_SA(b, h) + aoff + m * 2048 + 1024)); } while (0)
#define PG8_LDB(dst, b, h) do { _Pragma("unroll") for (int n = 0; n < 2; ++n) dst[n] = PG8_CAT(*(const PG8_LAS i32x4*)(lds + PG8_SB(b, h) + boff + n * 2048), *(const PG8_LAS i32x4*)(lds + PG8_SB(b, h) + boff + n * 2048 + 1024)); } while (0)
#define PG8_HALF(v, k) __builtin_bit_cast(bf16x8, __builtin_shufflevector(v, v, 4 * (k), 4 * (k) + 1, 4 * (k) + 2, 4 * (k) + 3))
#define PG8_MMA(ai, bj, At, Bt) do { __builtin_amdgcn_s_setprio(1); _Pragma("unroll") for (int m = 0; m < 4; ++m) _Pragma("unroll") for (int n = 0; n < 2; ++n) { \
        if constexpr (FP8SCALE != 0) { asm volatile("v_mfma_scale_f32_16x16x128_f8f6f4 %0, %1, %2, %0, %3, %4 op_sel_hi:[0,0,0]" : "+v"(acc[ai][bj][m][n]) : "v"(Bt[n]), "v"(At[m]), "v"(sclw), "v"(sclx)); } \
        else { acc[ai][bj][m][n] = __builtin_amdgcn_mfma_f32_16x16x32_bf16(PG8_HALF(Bt[n], 0), PG8_HALF(At[m], 0), acc[ai][bj][m][n], 0, 0, 0); acc[ai][bj][m][n] = __builtin_amdgcn_mfma_f32_16x16x32_bf16(PG8_HALF(Bt[n], 1), PG8_HALF(At[m], 1), acc[ai][bj][m][n], 0, 0, 0); } } __builtin_amdgcn_s_setprio(0); } while (0)
#define PG8_WAIT_V(n) asm volatile("s_waitcnt vmcnt(" #n ")" ::: "memory")
#define PG8_WAIT_L(n) asm volatile("s_waitcnt lgkmcnt(" #n ")" ::: "memory")
#define PG8_BAR __builtin_amdgcn_s_barrier()
#define PG8_SCHED __builtin_amdgcn_sched_barrier(0)
    Unit cur, nxt; int ui = 0;
    if (!S.next(0, cur)) return;
    f32x4 acc[2][2][4][2];
#pragma unroll
    for (int a = 0; a < 2; ++a)
#pragma unroll
        for (int b = 0; b < 2; ++b)
#pragma unroll
            for (int m = 0; m < 4; ++m)
#pragma unroll
                for (int n = 0; n < 2; ++n) acc[a][b][m][n] = (f32x4){0.f, 0.f, 0.f, 0.f};
    i32x8 At[4], B0[2], B1[2];
    const int sclw = FP8SCALE * 0x01010101, sclx = 0x7f7f7f7f;
    const char* cA = (const char*)g.A + (GATHER ? (size_t)0 : (size_t)cur.pm * tstep); const char* cB = (const char*)g.Bt + ((size_t)cur.e * g.bstride) * 2 + (size_t)cur.pn * tstep;
    if constexpr (GATHER) { PG8_GOFF(cur, vC); }
    S.a_ready(cur);
    if constexpr (SP2) {
        PG8_STAGE(PG8_SB(0, 0), cB, voffB); PG8_STAGE(PG8_SB(0, 1), cB + hstep, voffB); PG8_STAGE_A(PG8_SA(0, 0), cA, 0, vC); PG8_STAGE_A(PG8_SA(0, 1), cA, 1, vC);
        if (wr == 1) PG8_BAR;
        PG8_WAIT_V(2); PG8_BAR;
        PG8_STAGE(PG8_SB(1, 0), cB + kstep, voffB); PG8_STAGE_A(PG8_SA(1, 0), cA + kstep, 0, vC); PG8_STAGE(PG8_SB(1, 1), cB + hstep + kstep, voffB);
        PG8_WAIT_V(6); PG8_BAR;
    } else {
        PG8_STAGE(PG8_SB(0, 0), cB, voffB); PG8_STAGE_A(PG8_SA(0, 0), cA, 0, vC); PG8_STAGE(PG8_SB(0, 1), cB + hstep, voffB); PG8_STAGE_A(PG8_SA(0, 1), cA, 1, vC);
        if (wr == 1) PG8_BAR;
        PG8_WAIT_V(4); PG8_BAR;
        PG8_STAGE(PG8_SB(1, 0), cB + kstep, voffB); PG8_STAGE_A(PG8_SA(1, 0), cA + kstep, 0, vC); PG8_STAGE(PG8_SB(1, 1), cB + hstep + kstep, voffB);
        PG8_WAIT_V(6); PG8_BAR;
    }
    for (;;) {
        const bool has_next = S.next(ui + 1, nxt);
        const char* nA = (has_next && !GATHER) ? (const char*)g.A + (size_t)nxt.pm * tstep : cA; const char* nB = has_next ? (const char*)g.Bt + ((size_t)nxt.e * g.bstride) * 2 + (size_t)nxt.pn * tstep : cB;
        if constexpr (GATHER) { if (has_next) { PG8_GOFF(nxt, vN); } else { _Pragma("unroll") for (int h_ = 0; h_ < 2; ++h_) _Pragma("unroll") for (int i_ = 0; i_ < 2; ++i_) vN[h_][i_] = vC[h_][i_]; } }
        for (int t = 0; t < nt; t += 2) {
            const bool last = (t == nt - 2);
            const char* a1 = cA + (size_t)(t + 1) * kstep;
            const char* a2 = last ? nA : cA + (size_t)(t + 2) * kstep;
            if constexpr (GATHER) { _Pragma("unroll") for (int h_ = 0; h_ < 2; ++h_) _Pragma("unroll") for (int i_ = 0; i_ < 2; ++i_) vS[h_][i_] = last ? vN[h_][i_] : vC[h_][i_]; } const char* b2 = last ? nB : cB + (size_t)(t + 2) * kstep;
            const char* a3 = a2 + kstep; const char* b3 = b2 + kstep;
            if (last && has_next) S.a_ready(nxt);
            if constexpr (SP2) {
            PG8_LDB(B0, 0, 0); PG8_LDB(B1, 0, 1); PG8_SCHED; PG8_LDA(At, 0, 0); PG8_STAGE_A(PG8_SA(1, 1), a1, 1, vC);
            PG8_WAIT_V(8); PG8_WAIT_L(0); PG8_BAR; PG8_MMA(0, 0, At, B0); PG8_MMA(0, 1, At, B1); PG8_BAR; PG8_SCHED;
            PG8_LDA(At, 0, 1); PG8_STAGE(PG8_SB(0, 0), b2, voffB); PG8_STAGE(PG8_SB(0, 1), b2 + hstep, voffB); PG8_STAGE_A(PG8_SA(0, 0), a2, 0, vS);
            PG8_WAIT_V(8); PG8_WAIT_L(0); PG8_BAR; PG8_MMA(1, 0, At, B0); PG8_MMA(1, 1, At, B1); PG8_BAR; PG8_SCHED;
            PG8_LDB(B0, 1, 0); PG8_LDB(B1, 1, 1); PG8_SCHED; PG8_LDA(At, 1, 0); PG8_STAGE_A(PG8_SA(0, 1), a2, 1, vS);
            PG8_WAIT_V(8); PG8_WAIT_L(0); PG8_BAR; PG8_MMA(0, 0, At, B0); PG8_MMA(0, 1, At, B1); PG8_BAR; PG8_SCHED;
            PG8_LDA(At, 1, 1); PG8_STAGE(PG8_SB(1, 0), b3, voffB); PG8_STAGE(PG8_SB(1, 1), b3 + hstep, voffB); PG8_STAGE_A(PG8_SA(1, 0), a3, 0, vS);
            PG8_WAIT_V(8); PG8_WAIT_L(0); PG8_BAR; PG8_MMA(1, 0, At, B0); PG8_MMA(1, 1, At, B1); PG8_BAR; PG8_SCHED;
            } else {
            PG8_LDB(B0, 0, 0); PG8_SCHED; PG8_LDA(At, 0, 0); PG8_STAGE_A(PG8_SA(1, 1), a1, 1, vC);
            PG8_WAIT_L(8); PG8_BAR; PG8_WAIT_L(0); PG8_MMA(0, 0, At, B0); PG8_BAR; PG8_SCHED;
            PG8_LDB(B1, 0, 1); PG8_STAGE(PG8_SB(0, 0), b2, voffB);
            PG8_BAR; PG8_WAIT_L(0); PG8_MMA(0, 1, At, B1); PG8_BAR;
            PG8_LDA(At, 0, 1); PG8_STAGE_A(PG8_SA(0, 0), a2, 0, vS);
            PG8_BAR; PG8_WAIT_L(0); PG8_MMA(1, 0, At, B0); PG8_BAR; PG8_SCHED;
            PG8_STAGE(PG8_SB(0, 1), b2 + hstep, voffB);
            PG8_WAIT_V(6); PG8_BAR; PG8_MMA(1, 1, At, B1); PG8_BAR;
            PG8_LDB(B0, 1, 0); PG8_SCHED; PG8_LDA(At, 1, 0); PG8_STAGE_A(PG8_SA(0, 1), a2, 1, vS);
            PG8_WAIT_L(8); PG8_BAR; PG8_WAIT_L(0); PG8_MMA(0, 0, At, B0); PG8_BAR; PG8_SCHED;
            PG8_LDB(B1, 1, 1); PG8_STAGE(PG8_SB(1, 0), b3, voffB);
            PG8_BAR; PG8_WAIT_L(0); PG8_MMA(0, 1, At, B1); PG8_BAR;
            PG8_LDA(At, 1, 1); PG8_STAGE_A(PG8_SA(1, 0), a3, 0, vS);
            PG8_BAR; PG8_WAIT_L(0); PG8_MMA(1, 0, At, B0); PG8_BAR; PG8_SCHED;
            PG8_STAGE(PG8_SB(1, 1), b3 + hstep, voffB);
            PG8_WAIT_V(6); PG8_BAR; PG8_MMA(1, 1, At, B1); PG8_BAR;
            }
        }
        if constexpr (FP8SCALE != 0) { asm volatile("s_nop 15\n\ts_nop 15" ::: "memory"); }
        if constexpr (ALIGN_EPI) { if (wr == 0) PG8_BAR; }
        if constexpr (!Epi::AFTER_DRAIN) { E(acc, cur, wr, wc, fr, fq); S.done(cur); }
        if (!has_next) break;
#pragma unroll
        for (int a = 0; a < 2; ++a)
#pragma unroll
            for (int b = 0; b < 2; ++b)
#pragma unroll
                for (int m = 0; m < 4; ++m)
#pragma unroll
                    for (int n = 0; n < 2; ++n) acc[a][b][m][n] = (f32x4){0.f, 0.f, 0.f, 0.f};
        cur = nxt; cA = nA; cB = nB; ++ui;
        if constexpr (GATHER) { _Pragma("unroll") for (int h_ = 0; h_ < 2; ++h_) _Pragma("unroll") for (int i_ = 0; i_ < 2; ++i_) vC[h_][i_] = vN[h_][i_]; }
        if constexpr (ALIGN_EPI) { if (wr == 1) PG8_BAR; }
    }
    PG8_WAIT_V(0);
    if constexpr (!ALIGN_EPI) { if (wr == 0) PG8_BAR; }
    PG8_BAR;
    if constexpr (Epi::AFTER_DRAIN) { E.fused(acc, cur, wr, wc, fr, fq, lds, wid, lane); S.done(cur); }
#undef PG8_SA
#undef PG8_GOFF
#undef PG8_STAGE_A
#undef PG8_SB
#undef PG8_STAGE
#undef PG8_LDA
#undef PG8_LDB
#undef PG8_MMA
#undef PG8_CAT
#undef PG8_HALF
#undef PG8_WAIT_V
#undef PG8_WAIT_L
#undef PG8_BAR
#undef PG8_SCHED
}
}
#ifndef PG8_SP2
#define PG8_SP2 true
#endif
#ifndef PG8_ALIGN
#define PG8_ALIGN true
#endif
#include <hip/hip_bf16.h>
#include <cmath>
namespace attn_body {
using bf16=__hip_bfloat16;
using bf16x8=__attribute__((ext_vector_type(8)))short;
using s16x4=__attribute__((ext_vector_type(4)))short;
using f32x16=__attribute__((ext_vector_type(16)))float;
using u32x4=__attribute__((ext_vector_type(4)))unsigned;
constexpr int BATCH=4,NHEAD=8,SEQ=8192,D=64,PQ=3328,PO=1024;
constexpr int NW=8,QBLK=32,QB=QBLK*NW,KVBLK=64,NQB=SEQ/QB;
constexpr int ATTN_UNIT_ROWS=QB;
__device__ __forceinline__ int crow(int r,int hi){return (r&3)+8*(r>>2)+4*hi;}
#define SBAR() __builtin_amdgcn_sched_barrier(0)
__device__ __forceinline__ void cmask(f32x16&p0,f32x16&p1,int jb,int qrel,int hi){
  const float NEG=-INFINITY; int kb=64*jb+4*hi;
  #pragma unroll
  for(int r=0;r<16;++r){int kv=kb+(r&3)+8*(r>>2); if(kv>qrel)p0[r]=NEG; if(kv+32>qrel)p1[r]=NEG;}
}

constexpr int NSLOT=3, SLOTB=8192;
constexpr int LDS_K=0, LDS_V=NSLOT*SLOTB, LDS_WS=2*NSLOT*SLOTB, LDS_OST=LDS_WS+NW*64*4, LDS_CK=LDS_OST+NW*4096, LDS_BYTES=LDS_CK+SEQ*4;
constexpr float C2=0.125f*1.4426950408889634f;
__device__ __forceinline__ void glds16(const void*gsrc,unsigned lds_dst){unsigned keep;
  asm volatile("s_mov_b32 %0, m0\n\ts_mov_b32 m0, %2\n\ts_nop 0\n\tglobal_load_lds_dwordx4 %1, off\n\ts_mov_b32 m0, %0":"=&s"(keep):"v"(gsrc),"s"(lds_dst):"memory");}
__device__ __forceinline__ float max3f(float a,float b,float c){float r;asm("v_max3_f32 %0, %1, %2, %3":"=v"(r):"v"(a),"v"(b),"v"(c));return r;}
__device__ __forceinline__ float max2f(float a,float b){float r;asm("v_max_f32_e32 %0, %1, %2":"=v"(r):"v"(a),"v"(b));return r;}
__device__ __forceinline__ float fadd_s(float a,float b){float r;asm("v_add_f32_e32 %0, %1, %2":"=v"(r):"v"(a),"v"(b));return r;}
__device__ __forceinline__ float fsub_s(float a,float b){float r;asm("v_sub_f32_e32 %0, %1, %2":"=v"(r):"v"(a),"v"(b));return r;}
typedef float f32x2_t __attribute__((ext_vector_type(2))); typedef __bf16 bf16x2_t __attribute__((ext_vector_type(2)));
__device__ __forceinline__ unsigned cvtpk_s(float lo,float hi){f32x2_t v={lo,hi};bf16x2_t b=__builtin_convertvector(v,bf16x2_t);return __builtin_bit_cast(unsigned,b);}
#define WAIT_BAR(N) asm volatile("s_waitcnt vmcnt(" #N ") lgkmcnt(0)\n\ts_barrier":::"memory")

__device__ __forceinline__ void qkt(f32x16&p0,f32x16&p1,const char*Kslot,const bf16x8*qr,int r32,int hi){
  const char*kb=Kslot+hi*1024+r32*16;
  #pragma unroll
  for(int d0=0;d0<4;++d0){
    const bf16x8 b0=*reinterpret_cast<const bf16x8*>(kb+d0*2048);
    const bf16x8 b1=*reinterpret_cast<const bf16x8*>(kb+d0*2048+512);
    p0=__builtin_amdgcn_mfma_f32_32x32x16_bf16(b0,qr[d0],p0,0,0,0);p1=__builtin_amdgcn_mfma_f32_32x32x16_bf16(b1,qr[d0],p1,0,0,0);}
}
typedef __attribute__((address_space(3))) const char* lds_cptr;
typedef __attribute__((address_space(3))) float* lds_f32p; typedef __attribute__((address_space(3))) const float* lds_cf32p; typedef float f32x4_t __attribute__((ext_vector_type(4)));
typedef short v4i16_t __attribute__((ext_vector_type(4)));
__device__ __forceinline__ void kload8(bf16x8*kf,lds_cptr kp){
  kf[0]=*(const __attribute__((address_space(3))) bf16x8*)(kp);      kf[1]=*(const __attribute__((address_space(3))) bf16x8*)(kp+512);
  kf[2]=*(const __attribute__((address_space(3))) bf16x8*)(kp+2048); kf[3]=*(const __attribute__((address_space(3))) bf16x8*)(kp+2560);
  kf[4]=*(const __attribute__((address_space(3))) bf16x8*)(kp+4096); kf[5]=*(const __attribute__((address_space(3))) bf16x8*)(kp+4608);
  kf[6]=*(const __attribute__((address_space(3))) bf16x8*)(kp+6144); kf[7]=*(const __attribute__((address_space(3))) bf16x8*)(kp+6656);
}
__device__ __forceinline__ void kload2(bf16x8*kf,lds_cptr kp,int j){ kf[2*j]=*(const __attribute__((address_space(3))) bf16x8*)(kp+j*2048); kf[2*j+1]=*(const __attribute__((address_space(3))) bf16x8*)(kp+j*2048+512); }
__device__ __forceinline__ s16x4 vtr(lds_cptr p){ return __builtin_bit_cast(s16x4,__builtin_amdgcn_ds_read_tr16_b64_v4i16((__attribute__((address_space(3))) v4i16_t*)p)); }
__device__ __forceinline__ float rowmax(const f32x16&p0,const f32x16&p1){
  float a=max3f(p0[0],p0[1],p1[0]),b=max3f(p0[2],p0[3],p1[1]);a=max3f(a,p1[2],p1[3]);
  #pragma unroll
  for(int r=4;r<16;r+=4){a=max3f(a,p0[r],p0[r+1]);b=max3f(b,p0[r+2],p0[r+3]);a=max3f(a,p1[r],p1[r+1]);b=max3f(b,p1[r+2],p1[r+3]);}
  const float m=max2f(a,b);
  auto rr=__builtin_amdgcn_permlane32_swap(__float_as_uint(m),__float_as_uint(m),false,false);
  return max2f(__uint_as_float(rr[0]),__uint_as_float(rr[1]));
}
__device__ __forceinline__ void pv(f32x16*o,int vb,bf16x8 pa0,bf16x8 pa1,bf16x8 pa2,bf16x8 pa3){
  #pragma unroll
  for(int d0=0;d0<2;++d0){s16x4 lo[4],hi[4];
    #pragma unroll
    for(int ks=0;ks<4;++ks){
      asm volatile("ds_read_b64_tr_b16 %0,%1 offset:%c2":"=&v"(lo[ks]):"v"(vb),"i"(d0*4096+ks*1024):"memory");
      asm volatile("ds_read_b64_tr_b16 %0,%1 offset:%c2":"=&v"(hi[ks]):"v"(vb),"i"(d0*4096+ks*1024+512):"memory");}
    asm volatile("s_waitcnt lgkmcnt(0)":::"memory");SBAR();
    #define PK(k) (bf16x8){lo[k][0],lo[k][1],lo[k][2],lo[k][3],hi[k][0],hi[k][1],hi[k][2],hi[k][3]}
    o[d0]=__builtin_amdgcn_mfma_f32_32x32x16_bf16(pa0,PK(0),o[d0],0,0,0);
    o[d0]=__builtin_amdgcn_mfma_f32_32x32x16_bf16(pa1,PK(1),o[d0],0,0,0);
    o[d0]=__builtin_amdgcn_mfma_f32_32x32x16_bf16(pa2,PK(2),o[d0],0,0,0);
    o[d0]=__builtin_amdgcn_mfma_f32_32x32x16_bf16(pa3,PK(3),o[d0],0,0,0);
    #undef PK
  }
}

#ifndef ATTN_STORE16
#define ATTN_STORE16(p,v) (*(u32x4*)(p)=(v))
#endif
template<int THRL> __device__ __forceinline__ void attn_unit(int b,int h,int qb,int kt0,const bf16*Q,const bf16*__restrict__ K,const bf16*__restrict__ V,bf16*O,const float*__restrict__ CKG,const float*__restrict__ OG,char*shm){
  const int tid=threadIdx.x,lane=tid&63,r32=lane&31,hi=lane>>5; const int wid=__builtin_amdgcn_readfirstlane(tid>>6);
  const long rowbase=(long)b*SEQ; const int q0=qb*QB; const lds_cptr shm3_=(lds_cptr)shm;
  const bf16*Qw=Q+(rowbase+q0+wid*QBLK)*PQ+h*D;
  const bf16*Kh=K+(rowbase+(long)kt0*KVBLK)*PQ+h*D,*Vh=V+(rowbase+(long)kt0*KVBLK)*PQ+h*D;
  const unsigned lds0=(unsigned)(uintptr_t)shm;
  float*wsf=(float*)(shm+LDS_WS)+wid*64;
  const bf16*ksrc=Kh+(long)lane*PQ+wid*8;
  const bf16*vsrc=Vh+(long)(16*(wid&3)+(lane>>2))*PQ+(wid>>2)*32+(lane&3)*8;
  const unsigned kdst=lds0+LDS_K+wid*1024, vdst=lds0+LDS_V+wid*1024;
  #define DMA_K(t,slot) glds16(ksrc+(long)(t)*KVBLK*PQ,(unsigned)__builtin_amdgcn_readfirstlane(kdst+(slot)))
  #define DMA_V(t,slot) glds16(vsrc+(long)(t)*KVBLK*PQ,(unsigned)__builtin_amdgcn_readfirstlane(vdst+(slot)))
  const int vb0=(int)(lds0+LDS_V)+((lane>>4)&1)*32+(lane&3)*8+(4*hi+((lane&15)>>2))*64;
  const char*Kbase=shm+LDS_K; bf16x8 kf[8];
  const lds_cptr shm3=(lds_cptr)shm; const lds_cptr kp0=shm3+LDS_K+hi*1024+r32*16; const lds_cptr vp0=shm3+LDS_V+((lane>>4)&1)*32+(lane&3)*8+(4*hi+((lane&15)>>2))*64;
  const int NT=(q0+QB)/KVBLK-kt0;
  { const float*ckg=CKG+((long)(b*NHEAD+h))*SEQ+kt0*KVBLK; lds_f32p ckl=(lds_f32p)(shm3_+LDS_CK);
    f32x4_t cv_[4];
    _Pragma("unroll") for(int it=0;it<4;++it)cv_[it]=*(const f32x4_t*)(ckg+tid*4+it*NW*64*4);
    _Pragma("unroll") for(int it=0;it<4;++it)*(__attribute__((address_space(3))) f32x4_t*)(ckl+tid*4+it*NW*64*4)=cv_[it]; }
  const lds_cf32p ckb=(lds_cf32p)(shm3_+LDS_CK)+4*hi;
  DMA_K(0,0);DMA_V(0,0);DMA_K(1,SLOTB);
  bf16x8 qr[4];
  #pragma unroll
  for(int d0=0;d0<4;++d0)qr[d0]=*reinterpret_cast<const bf16x8*>(&Qw[(long)r32*PQ+d0*16+hi*8]);
  float mhat=0.f,l_reg=0.f;f32x16 o[2];o[0]=f32x16{};o[1]=f32x16{};float negmh=0.f;
  #define BIAS(C0,C1,t) do{ const lds_cf32p cp_=ckb+(t)*KVBLK; \
    _Pragma("unroll") for(int g_=0;g_<4;++g_){ const f32x4_t a_=*(const __attribute__((address_space(3))) f32x4_t*)(cp_+8*g_); const f32x4_t b_=*(const __attribute__((address_space(3))) f32x4_t*)(cp_+8*g_+32); \
      _Pragma("unroll") for(int j_=0;j_<4;++j_){ C0[4*g_+j_]=negmh-a_[j_]; C1[4*g_+j_]=negmh-b_[j_]; } if(g_&1){SBAR();} } }while(0)
  const int qrel=wid*QBLK+r32;
  #define CMASK(P0,P1,t) do{int jb_=(t)-(NT-4); if(jb_>=0)cmask(P0,P1,jb_,qrel,hi);}while(0)
  bool resc=false;
  #define START(P0,P1) do{ const float rm=rowmax(P0,P1); resc=false; \
    { const float dl=rm; mhat=fadd_s(mhat,dl); \
      _Pragma("unroll") for(int r=0;r<16;++r){P0[r]=fsub_s(P0[r],dl);P1[r]=fsub_s(P1[r],dl);} \
      negmh=-mhat; } \
    _Pragma("unroll") for(int r=0;r<16;++r)P0[r]=__builtin_amdgcn_exp2f(P0[r]); }while(0)
  #define RESC() do{ if(resc){ asm volatile("s_waitcnt lgkmcnt(0)":::"memory"); \
      _Pragma("unroll") for(int d_=0;d_<2;++d_) _Pragma("unroll") for(int r=0;r<16;++r)o[d_][r]*=wsf[crow(r,hi)]; } }while(0)
  f32x16 pA0,pA1,pB0,pB1;
  int sl_prev=0,sl_cur=0,sl_next=SLOTB;
  #define ROT() do{sl_prev=sl_cur;sl_cur=sl_next;sl_next=(sl_next==(NSLOT-1)*SLOTB)?0:sl_next+SLOTB;}while(0)
  DMA_K(2,2*SLOTB);
  WAIT_BAR(3);
  BIAS(pA0,pA1,0); qkt(pA0,pA1,Kbase,qr,r32,hi);asm volatile("s_nop 15\n\ts_nop 7":"+v"(pA0),"+v"(pA1));CMASK(pA0,pA1,0);
  START(pA0,pA1);
  _Pragma("unroll") for(int r=0;r<16;++r)pA1[r]=__builtin_amdgcn_exp2f(pA1[r]);
  WAIT_BAR(0);
  DMA_K(3,0);DMA_V(1,SLOTB);
  ROT();
  kload8(kf,kp0+sl_cur);
  WAIT_BAR(2);
  s16x4 vlo[8],vhi[8]; u32x4 pw0,pw1,pw2,pw3;
  #define PKW(P,B) cvtpk_s(P[B],P[B+1])
  #define PAF(k) __builtin_bit_cast(bf16x8,pw##k)
  #define VFR(i) (bf16x8){vlo[i][0],vlo[i][1],vlo[i][2],vlo[i][3],vhi[i][0],vhi[i][1],vhi[i][2],vhi[i][3]}
  #define PIN(x) asm volatile("":"+v"(x))
  #define MX3(a,b,c) __builtin_fmaxf(__builtin_fmaxf((a),(b)),(c))
  #define GAPA(MF,A0,A1,A2,A3,W0,W1,PW) do{ MF; sacc+=A0; sacc+=A1; sacc+=A2; sacc+=A3; PIN(sacc); W0; W1; PIN(PW); SBAR(); }while(0)
  #define EX(v) __builtin_amdgcn_exp2f(v)
  #define GAPB(MF,X,B) do{ MF; X[B]=EX(X[B]); X[B+1]=EX(X[B+1]); X[B+2]=EX(X[B+2]); X[B+3]=EX(X[B+3]); PIN(X); SBAR(); }while(0)
  #define VRD(i) do{ vlo[i]=vtr(vp_+(((i)>>2)*4096+((i)&3)*1024)); vhi[i]=vtr(vp_+(((i)>>2)*4096+((i)&3)*1024+512)); }while(0)
  #define KRD(G,j) do{ if(G){ kload2(kf,kp0+sl_next,j); SBAR(); } }while(0)
  #define STEP(C0,C1,P0,P1,t,GK,GV,GL) do{ SBAR(); BIAS(C0,C1,t); SBAR(); \
    const lds_cptr vp_=vp0+sl_prev; \
    VRD(0); SBAR(); float sacc=(P0[0]+P0[1]); \
    GAPA(C0=__builtin_amdgcn_mfma_f32_32x32x16_bf16(kf[0],qr[0],C0,0,0,0), P0[2],P0[3],P0[4],P0[5],     pw0[0]=PKW(P0,0), pw0[1]=PKW(P0,2), pw0); \
    VRD(4); SBAR(); GAPA(C1=__builtin_amdgcn_mfma_f32_32x32x16_bf16(kf[1],qr[0],C1,0,0,0), P0[6],P0[7],P0[8],P0[9],     pw0[2]=PKW(P0,4), pw0[3]=PKW(P0,6), pw0); \
    VRD(1); SBAR(); GAPA(C0=__builtin_amdgcn_mfma_f32_32x32x16_bf16(kf[2],qr[1],C0,0,0,0),   P0[10],P0[11],P0[12],P0[13], pw1[0]=PKW(P0,8), pw1[1]=PKW(P0,10), pw1); \
    VRD(5); SBAR(); GAPA(C1=__builtin_amdgcn_mfma_f32_32x32x16_bf16(kf[3],qr[1],C1,0,0,0),   P0[14],P0[15],P1[0],P1[1],   pw1[2]=PKW(P0,12),pw1[3]=PKW(P0,14), pw1); \
    VRD(2); SBAR(); GAPA(C0=__builtin_amdgcn_mfma_f32_32x32x16_bf16(kf[4],qr[2],C0,0,0,0),   P1[2],P1[3],P1[4],P1[5],     pw2[0]=PKW(P1,0), pw2[1]=PKW(P1,2), pw2); \
    VRD(6); SBAR(); GAPA(C1=__builtin_amdgcn_mfma_f32_32x32x16_bf16(kf[5],qr[2],C1,0,0,0),   P1[6],P1[7],P1[8],P1[9],     pw2[2]=PKW(P1,4), pw2[3]=PKW(P1,6), pw2); \
    VRD(3); SBAR(); GAPA(C0=__builtin_amdgcn_mfma_f32_32x32x16_bf16(kf[6],qr[3],C0,0,0,0),   P1[10],P1[11],P1[12],P1[13], pw3[0]=PKW(P1,8), pw3[1]=PKW(P1,10), pw3); \
    VRD(7); SBAR(); GAPA(C1=__builtin_amdgcn_mfma_f32_32x32x16_bf16(kf[7],qr[3],C1,0,0,0),   P1[14],P1[15],0.f,0.f,       pw3[2]=PKW(P1,12),pw3[3]=PKW(P1,14), pw3); \
    l_reg+=sacc; \
    if(GK){DMA_K((t)+3,sl_cur);} if(GV){DMA_V((t)+1,sl_next);} \
    CMASK(C0,C1,t); \
    { float a=MX3(C0[0],C0[1],C1[0]),b=MX3(C0[2],C0[3],C1[1]); a=MX3(a,C1[2],C1[3]); \
      _Pragma("unroll") for(int r=4;r<16;r+=4){a=MX3(a,C0[r],C0[r+1]);b=MX3(b,C0[r+2],C0[r+3]);a=MX3(a,C1[r],C1[r+1]);b=MX3(b,C1[r+2],C1[r+3]);} \
      float rm=__builtin_fmaxf(a,b); { auto rr=__builtin_amdgcn_permlane32_swap(__float_as_uint(rm),__float_as_uint(rm),false,false); rm=__builtin_fmaxf(__uint_as_float(rr[0]),__uint_as_float(rr[1])); } \
      resc=false; \
      if(__builtin_expect(__any(rm>(float)THRL),0)){ const float dl=__builtin_fmaxf(rm,0.f); mhat+=dl; \
        _Pragma("unroll") for(int r=0;r<16;++r){C0[r]-=dl;C1[r]-=dl;} \
        negmh=-mhat; \
        const float f=__builtin_amdgcn_exp2f(-dl); l_reg*=f; if(hi==0)wsf[r32]=f; resc=true; } } \
    SBAR(); \
    GAPB(o[0]=__builtin_amdgcn_mfma_f32_32x32x16_bf16(PAF(0),VFR(0),o[0],0,0,0), C0,0); \
    GAPB(o[1]=__builtin_amdgcn_mfma_f32_32x32x16_bf16(PAF(0),VFR(4),o[1],0,0,0), C0,4); \
    KRD(GL,0); GAPB(o[0]=__builtin_amdgcn_mfma_f32_32x32x16_bf16(PAF(1),VFR(1),o[0],0,0,0), C0,8); \
    KRD(GL,1); GAPB(o[1]=__builtin_amdgcn_mfma_f32_32x32x16_bf16(PAF(1),VFR(5),o[1],0,0,0), C0,12); \
    KRD(GL,2); GAPB(o[0]=__builtin_amdgcn_mfma_f32_32x32x16_bf16(PAF(2),VFR(2),o[0],0,0,0), C1,0); \
    KRD(GL,3); GAPB(o[1]=__builtin_amdgcn_mfma_f32_32x32x16_bf16(PAF(2),VFR(6),o[1],0,0,0), C1,4); \
    GAPB(o[0]=__builtin_amdgcn_mfma_f32_32x32x16_bf16(PAF(3),VFR(3),o[0],0,0,0), C1,8); \
    GAPB(o[1]=__builtin_amdgcn_mfma_f32_32x32x16_bf16(PAF(3),VFR(7),o[1],0,0,0), C1,12); \
    }while(0)
  int t=1;
  #undef CMASK
  #define CMASK(P0,P1,t) do{}while(0)
  for(;t+5<NT;t+=2){
    STEP(pB0,pB1,pA0,pA1,t,true,true,true);     WAIT_BAR(2); RESC(); ROT();
    STEP(pA0,pA1,pB0,pB1,t+1,true,true,true);   WAIT_BAR(2); RESC(); ROT();
  }
  #undef CMASK
  #define CMASK(P0,P1,t) do{int jb_=(t)-(NT-4); if(jb_>=0)cmask(P0,P1,jb_,qrel,hi);}while(0)
  #define ENDW(tt) do{ if((tt)+3<NT){WAIT_BAR(2);} else if((tt)+2<NT){WAIT_BAR(1);} else {WAIT_BAR(0);} }while(0)
  for(;t+1<NT;t+=2){
    STEP(pB0,pB1,pA0,pA1,t,(t+3<NT),(t+1<NT),(t+1<NT));       ENDW(t);   RESC(); ROT();
    STEP(pA0,pA1,pB0,pB1,t+1,(t+4<NT),(t+2<NT),(t+2<NT));     ENDW(t+1); RESC(); ROT();
  }
  STEP(pB0,pB1,pA0,pA1,NT-1,false,false,false); RESC();
  { float sacc=pB0[0]+pB0[1]; _Pragma("unroll") for(int r=2;r<16;++r)sacc+=pB0[r]; _Pragma("unroll") for(int r=0;r<16;++r)sacc+=pB1[r]; l_reg+=sacc;
    pw0=(u32x4){PKW(pB0,0),PKW(pB0,2),PKW(pB0,4),PKW(pB0,6)};pw1=(u32x4){PKW(pB0,8),PKW(pB0,10),PKW(pB0,12),PKW(pB0,14)};pw2=(u32x4){PKW(pB1,0),PKW(pB1,2),PKW(pB1,4),PKW(pB1,6)};pw3=(u32x4){PKW(pB1,8),PKW(pB1,10),PKW(pB1,12),PKW(pB1,14)};
    SBAR(); pv(o,vb0+sl_cur,PAF(0),PAF(1),PAF(2),PAF(3)); }
  #undef PKW
  #undef PAF
  #undef VFR
  #undef PIN
  #undef MX3
  #undef GAPA
  #undef GAPB
  #undef EX
  #undef VRD
  #undef KRD
  #undef STEP
  #undef ENDW
  {auto rr=__builtin_amdgcn_permlane32_swap(__float_as_uint(l_reg),__float_as_uint(l_reg),false,false);l_reg=__uint_as_float(rr[0])+__uint_as_float(rr[1]);}
  if(hi==0)wsf[32+r32]=l_reg;asm volatile("s_waitcnt lgkmcnt(0)":::"memory");
  float rli[16];
  #pragma unroll
  for(int r=0;r<16;++r)rli[r]=__builtin_amdgcn_rcpf(wsf[32+crow(r,hi)]);
  bf16*Ow=O+(rowbase+q0+wid*QBLK)*PO+h*D;
  { bf16*stg=(bf16*)(shm+LDS_OST)+wid*2048;
    #pragma unroll
    for(int r=0;r<16;++r){const int orow=crow(r,hi);
      #pragma unroll
      for(int d0=0;d0<2;++d0)stg[orow*64+d0*32+r32]=__float2bfloat16(o[d0][r]*rli[r]);}
    asm volatile("s_waitcnt lgkmcnt(0)":::"memory");
    #pragma unroll
    for(int i=0;i<4;++i){const int row=i*8+(lane>>3),ch=lane&7; const u32x4 v=*(const u32x4*)(stg+row*64+ch*8);
      float f[8]; _Pragma("unroll") for(int j=0;j<4;++j){ f[2*j]=__uint_as_float(v[j]<<16); f[2*j+1]=__uint_as_float(v[j]&0xffff0000u); }
      float ss=0.f; _Pragma("unroll") for(int j=0;j<8;++j)ss+=f[j]*f[j];
      ss+=__shfl_xor(ss,1); ss+=__shfl_xor(ss,2); ss+=__shfl_xor(ss,4);
      const float rs=__builtin_amdgcn_rsqf(ss*(1.0f/64.0f)+1e-5f);
      const f32x4_t g0=*(const f32x4_t*)(OG+h*D+ch*8), g1=*(const f32x4_t*)(OG+h*D+ch*8+4);
      u32x4 w; w[0]=cvtpk_s(f[0]*rs*g0[0],f[1]*rs*g0[1]); w[1]=cvtpk_s(f[2]*rs*g0[2],f[3]*rs*g0[3]); w[2]=cvtpk_s(f[4]*rs*g1[0],f[5]*rs*g1[1]); w[3]=cvtpk_s(f[6]*rs*g1[2],f[7]*rs*g1[3]);
      ATTN_STORE16(Ow+(long)row*PO+ch*8,w);} }
  asm volatile("s_waitcnt lgkmcnt(0)\n\ts_barrier":::"memory");
  #undef DMA_K
  #undef DMA_V
  #undef CMASK
  #undef START
  #undef RESC
  #undef ROT
  #undef BIAS
}
constexpr int ATTN_LDS_BYTES=LDS_BYTES;
struct AttnTensors { const bf16* Q; const bf16* K; const bf16* V; bf16* O; const float* CK; const float* OG; };
struct AttnUnit { int bh; int qb; };
struct StaticOrder {
  int vcu;
  __device__ __forceinline__ explicit StaticOrder(int grid,int block):vcu((block%8)*(grid/8)+block/8){}
  __device__ __forceinline__ bool next(int i,AttnUnit&u)const{ if(i>=4)return false; const int s=vcu&7; u.bh=vcu>>3; u.qb=(i==0)?s:(i==1)?15-s:(i==2)?16+s:31-s; return true; }
  __device__ __forceinline__ void a_ready(const AttnUnit&)const{}
  __device__ __forceinline__ void done(const AttnUnit&)const{}
};
template<class Sched,int THRL=8> __device__ __forceinline__ void attn_phase(char*lds,const AttnTensors&T,const Sched&S){
  AttnUnit u;
  for(int i=0;S.next(i,u);++i){ S.a_ready(u); attn_unit<THRL>(u.bh/NHEAD,u.bh%NHEAD,u.qb,0,T.Q,T.K,T.V,T.O,T.CK,T.OG,lds); S.done(u); }
}
#undef SBAR
#undef WAIT_BAR
}
namespace rw {
typedef short bf16x8 __attribute__((ext_vector_type(8)));
typedef float f32x4 __attribute__((ext_vector_type(4)));
typedef unsigned u32x2 __attribute__((ext_vector_type(2)));
typedef unsigned u32x4 __attribute__((ext_vector_type(4)));
#define RW_LAS __attribute__((address_space(3)))
constexpr int PT = 72, MB = 64 * PT * 2;
constexpr int O_AH = 0, O_RH = MB, O_BH = 2 * MB, O_KH = 3 * MB, O_AHT = 4 * MB, O_VT = 5 * MB, O_BTT = 6 * MB, O_KTT = 7 * MB, O_Z = 8 * MB;
constexpr int O_Z0 = O_Z, O_Z1 = O_Z + MB, O_Z2 = O_Z + 2 * MB, O_Z3 = O_Z + 3 * MB, O_Z4 = O_Z + 4 * MB;
constexpr int ZP = 68, ZB = 64 * ZP * 4;
constexpr int O_ZW = O_Z, O_ZA = O_Z + ZB, O_ZG = O_Z + 2 * ZB, O_WTOT = O_ZG + MB;
constexpr int XP = 264, O_X = 0;
constexpr int O_LW = O_Z4 + MB;
constexpr int PART_A_LDS = O_LW + 32768;
static_assert(64 * XP * 2 <= O_Z, "X overlays only the hat matrices");
static_assert(O_WTOT + 2048 <= O_Z4 + MB, "rwkv LDS map");
constexpr int UNIT_QT = 0, UNIT_YI = 8192, UNIT_ML = 16384, UNIT_NT = 24576, UNIT_P = 40960, UNIT_BYTES = 41216;

__device__ __forceinline__ unsigned pk(float lo, float hi) { typedef float f2 __attribute__((ext_vector_type(2))); typedef __bf16 b2 __attribute__((ext_vector_type(2))); f2 v = {lo, hi}; return __builtin_bit_cast(unsigned, __builtin_convertvector(v, b2)); }
__device__ __forceinline__ unsigned short f2b(float f) { return (unsigned short)(pk(f, 0.f) & 0xffffu); }
__device__ __forceinline__ float b2f(unsigned short b) { return __uint_as_float((unsigned)b << 16); }
__device__ __forceinline__ float sigm(float x) { return __builtin_amdgcn_rcpf(1.0f + __expf(-x)); }

__device__ __forceinline__ void mm_nt(f32x4 (&acc)[2], const RW_LAS unsigned char* lds, int xo, int yo, int ti, int ch, int c, int g) {
#pragma unroll
    for (int s = 0; s < 2; ++s) {
        const bf16x8 a = *(const RW_LAS bf16x8*)(lds + xo + ((16 * ti + c) * PT + 32 * s + 8 * g) * 2);
#pragma unroll
        for (int n = 0; n < 2; ++n) { const bf16x8 b = *(const RW_LAS bf16x8*)(lds + yo + ((32 * ch + 16 * n + c) * PT + 32 * s + 8 * g) * 2); acc[n] = __builtin_amdgcn_mfma_f32_16x16x32_bf16(a, b, acc[n], 0, 0, 0); }
    }
}
#define RW_ZERO(a) do { a[0] = (f32x4){0.f, 0.f, 0.f, 0.f}; a[1] = (f32x4){0.f, 0.f, 0.f, 0.f}; } while (0)
__device__ __forceinline__ void st_nat(RW_LAS unsigned char* lds, int off, const f32x4& v, int row0, int col) {
#pragma unroll
    for (int r = 0; r < 4; ++r) *(RW_LAS unsigned short*)(lds + off + ((row0 + r) * PT + col) * 2) = f2b(v[r]);
}
__device__ __forceinline__ void st_tr(RW_LAS unsigned char* lds, int off, const f32x4& v, int row0, int col) {
    u32x2 w; w.x = pk(v[0], v[1]); w.y = pk(v[2], v[3]); *(RW_LAS u32x2*)(lds + off + (col * PT + row0) * 2) = w;
}

struct PartA { const float* const __attribute__((address_space(4)))* in; unsigned char* ws; size_t o_u, o_lora, o_rec, o_bon, o_gg; };
#define PA_U ((const unsigned short*)(A.ws + A.o_u))
#define PA_WUPT ((const unsigned short*)(A.ws + A.o_lora))
#define PA_AUPT (PA_WUPT + 512 * 64)
#define PA_GUPT (PA_WUPT + 2 * 512 * 64)
#define PA_REC (A.ws + A.o_rec)
#define PA_BON ((unsigned short*)(A.ws + A.o_bon))
#define PA_GG ((unsigned short*)(A.ws + A.o_gg))

#define RW_BAR() asm volatile("s_waitcnt lgkmcnt(0)\n\ts_barrier" ::: "memory")
__device__ __forceinline__ void part_a_block(const PartA& A, RW_LAS unsigned char* lds, int bh, int chunk0, int nun, int tid_in, volatile RW_LAS unsigned* tsw) {
    constexpr int NU_ = 3328, T_ = 8192;
#if TS_PROBE >= 100
    unsigned long long ts_last = __builtin_amdgcn_s_memrealtime(), ts_acc = 0ull;
#define RW_TS(k) do { const unsigned long long n_ = __builtin_amdgcn_s_memrealtime(); if ((k) == TS_PROBE - 100) ts_acc += n_ - ts_last; ts_last = n_; } while (0)
#else
#define RW_TS(k) do { } while (0)
#endif
    u32x4 xc[4], xp[4]; unsigned short er[9], ek[9], ev[9];
#define RW_PREFETCH_X(CH) do { const int tid_ = tid_in, b_ = bh >> 3; const size_t m0_ = (size_t)b_ * T_ + (size_t)(CH) * 64; \
        { const int t_ = tid_ & 63, cb_ = (tid_ >> 6) * 32; const unsigned short* ur_ = PA_U + (m0_ + t_) * NU_ + 1536 + cb_; const bool first_ = ((CH) == 0 && t_ == 0); \
          const unsigned short* up_ = first_ ? ur_ : ur_ - NU_;         \
          _Pragma("unroll") for (int q = 0; q < 4; ++q) { xc[q] = *(const u32x4*)(ur_ + 8 * q); xp[q] = *(const u32x4*)(up_ + 8 * q); } \
          if (first_) { _Pragma("unroll") for (int q = 0; q < 4; ++q) xp[q] = (u32x4){0u, 0u, 0u, 0u}; } } } while (0)
#define RW_PREFETCH_E(CH) do { const int tid_ = tid_in, lane_ = tid_ & 63, w_ = tid_ >> 6, b_ = bh >> 3, h_ = bh & 7; const size_t m0_ = (size_t)b_ * T_ + (size_t)(CH) * 64; \
        { const unsigned short* u0_ = PA_U + (m0_ + 8 * w_) * NU_ + h_ * 64 + lane_; const bool first_ = ((CH) == 0 && w_ == 0); \
          const unsigned short* p0_ = first_ ? u0_ : u0_ - NU_; er[0] = p0_[0]; ek[0] = p0_[512]; ev[0] = p0_[1024]; \
          _Pragma("unroll") for (int i = 0; i < 8; ++i) { er[i + 1] = u0_[(size_t)i * NU_]; ek[i + 1] = u0_[(size_t)i * NU_ + 512]; ev[i + 1] = u0_[(size_t)i * NU_ + 1024]; } \
          if (first_) { er[0] = 0; ek[0] = 0; ev[0] = 0; } } } while (0)
    { const int lane_ = tid_in & 63, w_ = tid_in >> 6, ch_ = w_ & 1, c_ = lane_ & 15, g_ = lane_ >> 4;
#pragma unroll
      for (int q = 0; q < 4; ++q) { const int f = 4 * (w_ >> 1) + q; const int n = f & 1, col_ = (bh & 7) * 64 + 32 * ch_ + 16 * n + c_;
          const unsigned short* src = f < 4 ? PA_WUPT + col_ * 64 + 32 * (f >> 1) + 8 * g_ : f < 8 ? PA_AUPT + col_ * 64 + 32 * ((f - 4) >> 1) + 8 * g_ : PA_GUPT + col_ * 128 + 32 * ((f - 8) >> 1) + 8 * g_;
          *(RW_LAS bf16x8*)(lds + O_LW + ((ch_ * 16 + f) * 64 + lane_) * 16) = *(const bf16x8*)src; } }
#define RW_LOAD_LORA() do { const int ch_ = (tid_in >> 6) & 1, lane_ = tid_in & 63; _Pragma("unroll") for (int n = 0; n < 2; ++n) { \
        _Pragma("unroll") for (int s = 0; s < 2; ++s) { fw[s][n] = *(const RW_LAS bf16x8*)(lds + O_LW + ((ch_ * 16 + 2 * s + n) * 64 + lane_) * 16); fa[s][n] = *(const RW_LAS bf16x8*)(lds + O_LW + ((ch_ * 16 + 4 + 2 * s + n) * 64 + lane_) * 16); } \
        _Pragma("unroll") for (int s = 0; s < 4; ++s) fg[s][n] = *(const RW_LAS bf16x8*)(lds + O_LW + ((ch_ * 16 + 8 + 2 * s + n) * 64 + lane_) * 16); } } while (0)
    RW_PREFETCH_X(chunk0);
    const int pc_cc = (bh & 7) * 64 + (tid_in & 63);
    const float pc_mur = A.in[3][pc_cc], pc_muk = A.in[3][512 + pc_cc], pc_muv = A.in[3][1024 + pc_cc], pc_w0 = A.in[4][pc_cc], pc_a0 = A.in[6][pc_cc], pc_kk = A.in[9][pc_cc], pc_ka = A.in[10][pc_cc], pc_rk = A.in[11][pc_cc];
  for (int kk_ = 0; kk_ < nun; ++kk_) {
    const int chunk = chunk0 + kk_; int tid = tid_in;
    constexpr int RW_ = 512;
    asm volatile("" : "+v"(tid));
    const int lane = tid & 63, w = __builtin_amdgcn_readfirstlane(tid >> 6), ti = w >> 1, ch = w & 1, c = lane & 15, g = lane >> 4;
    const int b = bh >> 3, h = bh & 7; const size_t m0 = (size_t)b * T_ + (size_t)chunk * 64;
    unsigned char* rec = PA_REC + (size_t)(bh * 128 + chunk) * UNIT_BYTES;
    bf16x8 fw[2][2], fa[2][2], fg[4][2];
    { const int t = lane, cb = 32 * w;
      const f32x4* mup = (const f32x4*)(A.in[3] + 1536 + cb);
      f32x4 mu4[8];
#pragma unroll
      for (int q = 0; q < 8; ++q) mu4[q] = mup[q];
      float xs[32];
#pragma unroll
      for (int q = 0; q < 4; ++q)
#pragma unroll
          for (int e = 0; e < 4; ++e) { const float c0 = __uint_as_float(xc[q][e] << 16), c1 = __uint_as_float(xc[q][e] & 0xffff0000u), p0 = __uint_as_float(xp[q][e] << 16), p1 = __uint_as_float(xp[q][e] & 0xffff0000u);
              const int j = 8 * q + 2 * e; xs[j] = c0 + (p0 - c0) * mu4[j >> 2][j & 3]; xs[j + 1] = c1 + (p1 - c1) * mu4[(j + 1) >> 2][(j + 1) & 3]; }
      if (w < 2) {
#pragma unroll
          for (int j = 0; j < 32; ++j) xs[j] = 1.0f - 2.0f * __builtin_amdgcn_rcpf(1.0f + __expf(2.0f * xs[j]));
      } else if (w >= 4) {
#pragma unroll
          for (int j = 0; j < 32; ++j) xs[j] = __builtin_amdgcn_rcpf(1.0f + __expf(-xs[j]));
      }
#pragma unroll
      for (int q = 0; q < 4; ++q) { u32x4 o; o.x = pk(xs[8 * q], xs[8 * q + 1]); o.y = pk(xs[8 * q + 2], xs[8 * q + 3]); o.z = pk(xs[8 * q + 4], xs[8 * q + 5]); o.w = pk(xs[8 * q + 6], xs[8 * q + 7]);
          *(RW_LAS u32x4*)(lds + O_X + (t * XP + cb + 8 * q) * 2) = o; }
      if (kk_ + 1 < nun) { RW_PREFETCH_X(chunk + 1); } }
    RW_BAR(); RW_TS(0);
    RW_LOAD_LORA();
    RW_PREFETCH_E(chunk);
    { f32x4 zw[2], za[2], zg[2]; RW_ZERO(zw); RW_ZERO(za); RW_ZERO(zg);
#pragma unroll
      for (int s = 0; s < 2; ++s) {
          const bf16x8 aw = *(const RW_LAS bf16x8*)(lds + O_X + ((16 * ti + c) * XP + 32 * s + 8 * g) * 2), aa = *(const RW_LAS bf16x8*)(lds + O_X + ((16 * ti + c) * XP + 64 + 32 * s + 8 * g) * 2);
#pragma unroll
          for (int n = 0; n < 2; ++n) { zw[n] = __builtin_amdgcn_mfma_f32_16x16x32_bf16(aw, fw[s][n], zw[n], 0, 0, 0); za[n] = __builtin_amdgcn_mfma_f32_16x16x32_bf16(aa, fa[s][n], za[n], 0, 0, 0); } }
#pragma unroll
      for (int s = 0; s < 4; ++s) { const bf16x8 ag = *(const RW_LAS bf16x8*)(lds + O_X + ((16 * ti + c) * XP + 128 + 32 * s + 8 * g) * 2);
#pragma unroll
          for (int n = 0; n < 2; ++n) zg[n] = __builtin_amdgcn_mfma_f32_16x16x32_bf16(ag, fg[s][n], zg[n], 0, 0, 0); }
#pragma unroll
      for (int n = 0; n < 2; ++n)
#pragma unroll
          for (int r = 0; r < 4; ++r) { const int o = ((16 * ti + 4 * g + r) * ZP + 32 * ch + 16 * n + c) * 4;
              *(RW_LAS float*)(lds + O_ZW + o) = zw[n][r]; *(RW_LAS float*)(lds + O_ZA + o) = za[n][r]; *(RW_LAS unsigned short*)(lds + O_ZG + ((16 * ti + 4 * g + r) * PT + 32 * ch + 16 * n + c) * 2) = f2b(zg[n][r]); } }
    RW_BAR(); RW_TS(1);
    { const int cc = h * 64 + lane;
      float r[8], k[8], v[8], lw[8], av[8];
      { float pr = b2f(er[0]), pk_ = b2f(ek[0]), pv = b2f(ev[0]);
        const float mur = pc_mur, muk = pc_muk, muv = pc_muv;
#pragma unroll
        for (int i = 0; i < 8; ++i) { const float cr = b2f(er[i + 1]), ck = b2f(ek[i + 1]), cv = b2f(ev[i + 1]);
            r[i] = cr + (pr - cr) * mur; k[i] = ck + (pk_ - ck) * muk; v[i] = cv + (pv - cv) * muv; pr = cr; pk_ = ck; pv = cv; } }
      const float w0 = pc_w0, a0 = pc_a0, k_k = pc_kk, k_a = pc_ka, r_k = pc_rk;
      float run = 0.f, kkr[8], k2[8];
#pragma unroll
      for (int i = 0; i < 8; ++i) { const int t = 8 * w + i; const float zw = *(const RW_LAS float*)(lds + O_ZW + (t * ZP + lane) * 4) + w0, za = *(const RW_LAS float*)(lds + O_ZA + (t * ZP + lane) * 4) + a0;
          lw[i] = -0.6065306597126334f * sigm(zw); run += lw[i]; av[i] = sigm(za); kkr[i] = k[i] * k_k; k2[i] = k[i] * (1.0f + (av[i] - 1.0f) * k_a); }
      *(RW_LAS float*)(lds + O_WTOT + (w * 64 + lane) * 4) = run;
#pragma unroll
      for (int i = 0; i < 8; ++i) { *(RW_LAS float*)(lds + O_ZW + ((8 * w + i) * ZP + lane) * 4) = kkr[i] * kkr[i]; *(RW_LAS float*)(lds + O_ZA + ((8 * w + i) * ZP + lane) * 4) = r[i] * k2[i] * r_k; }
      float red[16];
      { const int q = lane >> 2, part = lane & 3; const RW_LAS float* rp = (const RW_LAS float*)(lds + ((q < 8) ? O_ZW : O_ZA) + ((8 * w + (q & 7)) * ZP + part * 16) * 4);
        const f32x4 s0 = *(const RW_LAS f32x4*)(rp), s1 = *(const RW_LAS f32x4*)(rp + 4), s2 = *(const RW_LAS f32x4*)(rp + 8), s3 = *(const RW_LAS f32x4*)(rp + 12);
        float s = ((s0.x + s0.y) + (s0.z + s0.w)) + ((s1.x + s1.y) + (s1.z + s1.w)) + ((s2.x + s2.y) + (s2.z + s2.w)) + ((s3.x + s3.y) + (s3.z + s3.w));
        s += __uint_as_float(__builtin_amdgcn_update_dpp(0, __float_as_uint(s), 0xB1, 0xF, 0xF, true));
        s += __uint_as_float(__builtin_amdgcn_update_dpp(0, __float_as_uint(s), 0x4E, 0xF, 0xF, true));
        asm volatile("s_waitcnt lgkmcnt(0)" ::: "memory");
        if (part == 0) *(RW_LAS float*)(lds + O_ZW + ((8 * w) * ZP + q) * 4) = s;
        const RW_LAS f32x4* rr = (const RW_LAS f32x4*)(lds + O_ZW + ((8 * w) * ZP) * 4);
#pragma unroll
        for (int j = 0; j < 4; ++j) { const f32x4 x = rr[j]; red[4 * j] = x.x; red[4 * j + 1] = x.y; red[4 * j + 2] = x.z; red[4 * j + 3] = x.w; } }
      RW_BAR(); RW_TS(2);
      float off = 0.f, tot = 0.f;
#pragma unroll
      for (int j = 0; j < 8; ++j) { const float x = *(const RW_LAS float*)(lds + O_WTOT + (j * 64 + lane) * 4); tot += x; if (j < w) off += x; }
      float cum = off; unsigned aht[4], vt[4], btt[4], ktt[4], bon[4], ggs[4]; float ahp = 0.f, vp = 0.f, btp = 0.f, ktp = 0.f, bop = 0.f, ggp = 0.f;
      const float etot = __expf(tot); float e1 = __expf(off);
#pragma unroll
      for (int i = 0; i < 8; ++i) { const int t = 8 * w + i; cum += lw[i];
          const float kk = kkr[i] * __builtin_amdgcn_rsqf(fmaxf(red[i], 1e-24f));
          const float bb = -kk * av[i];
          const float ex = e1; e1 = __expf(cum); const float e2 = __builtin_amdgcn_rcpf(e1), et = etot * e2;
          const float ah = kk * ex, rh = r[i] * e1, bh_ = bb * e2, kh = k2[i] * e2, bt = bb * et, kt = k2[i] * et;
          const int o = (t * PT + lane) * 2;
          *(RW_LAS unsigned short*)(lds + O_AH + o) = f2b(ah); *(RW_LAS unsigned short*)(lds + O_RH + o) = f2b(rh); *(RW_LAS unsigned short*)(lds + O_BH + o) = f2b(bh_); *(RW_LAS unsigned short*)(lds + O_KH + o) = f2b(kh);
          if (i & 1) { aht[i >> 1] = pk(ahp, ah); vt[i >> 1] = pk(vp, v[i]); btt[i >> 1] = pk(btp, bt); ktt[i >> 1] = pk(ktp, kt); } else { ahp = ah; vp = v[i]; btp = bt; ktp = kt; }
          const float bo = red[8 + i] * v[i], gg_ = b2f(*(const RW_LAS unsigned short*)(lds + O_ZG + (t * PT + lane) * 2));
          if (i & 1) { bon[i >> 1] = pk(bop, bo); ggs[i >> 1] = pk(ggp, gg_); } else { bop = bo; ggp = gg_; } }
      { const size_t uo = (size_t)(bh * 128 + chunk) * 4096;
        const int e0 = (((lane >> 4) * 4 + (w >> 1)) * 64 + (lane & 15) + 16 * (2 * (w & 1))) * 4;
        *(u32x2*)(PA_BON + uo + e0) = (u32x2){bon[0], bon[1]}; *(u32x2*)(PA_BON + uo + e0 + 64) = (u32x2){bon[2], bon[3]};
        *(u32x2*)(PA_GG + uo + e0) = (u32x2){ggs[0], ggs[1]}; *(u32x2*)(PA_GG + uo + e0 + 64) = (u32x2){ggs[2], ggs[3]}; }
      const int ot = (lane * PT + 8 * w) * 2;
      *(RW_LAS u32x4*)(lds + O_AHT + ot) = (u32x4){aht[0], aht[1], aht[2], aht[3]}; *(RW_LAS u32x4*)(lds + O_VT + ot) = (u32x4){vt[0], vt[1], vt[2], vt[3]};
      *(RW_LAS u32x4*)(lds + O_BTT + ot) = (u32x4){btt[0], btt[1], btt[2], btt[3]}; *(RW_LAS u32x4*)(lds + O_KTT + ot) = (u32x4){ktt[0], ktt[1], ktt[2], ktt[3]};
      if (w == 7) *(float*)(rec + UNIT_P + lane * 4) = etot; }
    RW_BAR(); RW_TS(3);

    const int row0 = 16 * ti + 4 * g;
    { f32x4 ab[2], ak[2], rb[2], rk[2]; RW_ZERO(ab); RW_ZERO(ak); RW_ZERO(rb); RW_ZERO(rk);
      mm_nt(ab, lds, O_AH, O_BH, ti, ch, c, g); mm_nt(ak, lds, O_AH, O_KH, ti, ch, c, g); mm_nt(rb, lds, O_RH, O_BH, ti, ch, c, g); mm_nt(rk, lds, O_RH, O_KH, ti, ch, c, g);
#pragma unroll
      for (int n = 0; n < 2; ++n) { const int col = 32 * ch + 16 * n + c, ct = 2 * ch + n;
          f32x4 ao, sk, irb, irk;
#pragma unroll
          for (int r = 0; r < 4; ++r) { const int t = row0 + r; ao[r] = (ti > ct) ? ab[n][r] : 0.f; sk[r] = (t > col) ? ak[n][r] : 0.f; irb[r] = (t >= col) ? rb[n][r] : 0.f; irk[r] = (t >= col) ? rk[n][r] : 0.f; }
          st_tr(lds, O_Z0, ao, row0, col); st_nat(lds, O_Z1, sk, row0, col); st_nat(lds, O_Z2, irb, row0, col); st_nat(lds, O_Z3, irk, row0, col);
          if (ti == ct) {
#pragma unroll
              for (int r = 0; r < 4; ++r) *(RW_LAS float*)(lds + O_Z4 + ((row0 + r) * 16 + c) * 4) = (4 * g + r > c) ? ab[n][r] : 0.f; } } }
    RW_BAR(); RW_TS(4);
    { f32x4 a[2]; RW_ZERO(a); mm_nt(a, lds, O_Z1, O_VT, ti, ch, c, g);
#pragma unroll
      for (int n = 0; n < 2; ++n) st_tr(lds, O_BH, a[n], row0, 32 * ch + 16 * n + c);
      for (int i = tid; i < MB / 16; i += 512) { *(RW_LAS u32x4*)(lds + O_KH + i * 16) = (u32x4){0u, 0u, 0u, 0u}; *(RW_LAS u32x4*)(lds + O_AH + i * 16) = (u32x4){0u, 0u, 0u, 0u}; } }
    RW_BAR(); RW_TS(5);
    if (w == 0) { float d[16];
#pragma unroll
      for (int t = 0; t < 16; ++t) { float s = (t == c) ? 1.f : 0.f;
          f32x4 av4[4];
#pragma unroll
          for (int q = 0; q < 4; ++q) if (4 * q < t) av4[q] = *(const RW_LAS f32x4*)(lds + O_Z4 + ((16 * g + t) * 16 + 4 * q) * 4);
#pragma unroll
          for (int q = 0; q < t; ++q) s += av4[q >> 2][q & 3] * d[q];
          d[t] = s; asm volatile("" ::: "memory"); }
#pragma unroll
      for (int t = 0; t < 16; ++t) *(RW_LAS unsigned short*)(lds + O_KH + ((16 * g + t) * PT + 16 * g + c) * 2) = f2b(d[t]);
      u32x4 lo, hi; lo.x = pk(d[0], d[1]); lo.y = pk(d[2], d[3]); lo.z = pk(d[4], d[5]); lo.w = pk(d[6], d[7]); hi.x = pk(d[8], d[9]); hi.y = pk(d[10], d[11]); hi.z = pk(d[12], d[13]); hi.w = pk(d[14], d[15]);
      *(RW_LAS u32x4*)(lds + O_AH + ((16 * g + c) * PT + 16 * g) * 2) = lo; *(RW_LAS u32x4*)(lds + O_AH + ((16 * g + c) * PT + 16 * g + 8) * 2) = hi; }
    RW_BAR(); RW_TS(6);
    f32x4 gac[2], g2[2], hh[2];
    RW_ZERO(gac); mm_nt(gac, lds, O_KH, O_Z0, ti, ch, c, g);
#pragma unroll
    for (int n = 0; n < 2; ++n) { st_nat(lds, O_Z1, gac[n], row0, 32 * ch + 16 * n + c); st_tr(lds, O_Z4, gac[n], row0, 32 * ch + 16 * n + c); }
    RW_BAR(); RW_TS(7);
    RW_ZERO(g2); mm_nt(g2, lds, O_Z1, O_Z4, ti, ch, c, g);
#pragma unroll
    for (int n = 0; n < 2; ++n) st_tr(lds, O_Z0, g2[n], row0, 32 * ch + 16 * n + c);
    RW_BAR(); RW_TS(7);
    RW_ZERO(hh); mm_nt(hh, lds, O_Z1, O_Z0, ti, ch, c, g);
#pragma unroll
    for (int n = 0; n < 2; ++n) { const int col = 32 * ch + 16 * n + c;
#pragma unroll
        for (int r = 0; r < 4; ++r) hh[n][r] += gac[n][r] + g2[n][r] + ((row0 + r == col) ? 1.f : 0.f);
        st_nat(lds, O_Z4, hh[n], row0, col); }
    RW_BAR(); RW_TS(7);
    { f32x4 tt[2]; RW_ZERO(tt); mm_nt(tt, lds, O_Z4, O_AH, ti, ch, c, g);
      RW_BAR(); RW_TS(7);
#pragma unroll
      for (int n = 0; n < 2; ++n) st_nat(lds, O_Z1, tt[n], row0, 32 * ch + 16 * n + c); }
    RW_BAR(); RW_TS(7);
    { f32x4 ww[2], uu[2]; RW_ZERO(ww); RW_ZERO(uu); mm_nt(ww, lds, O_Z1, O_AHT, ti, ch, c, g); mm_nt(uu, lds, O_Z1, O_BH, ti, ch, c, g);
#pragma unroll
      for (int n = 0; n < 2; ++n) { st_tr(lds, O_Z0, ww[n], row0, 32 * ch + 16 * n + c); st_tr(lds, O_KH, uu[n], row0, 32 * ch + 16 * n + c); } }
    RW_BAR(); RW_TS(8);
    { f32x4 qt[2], ml[2], yi[2], nt[2]; RW_ZERO(qt); RW_ZERO(ml); RW_ZERO(yi); RW_ZERO(nt);
      mm_nt(qt, lds, O_Z0, O_Z2, ti, ch, c, g); mm_nt(ml, lds, O_Z0, O_BTT, ti, ch, c, g);
      mm_nt(yi, lds, O_Z2, O_KH, ti, ch, c, g); mm_nt(yi, lds, O_Z3, O_VT, ti, ch, c, g);
      mm_nt(nt, lds, O_BTT, O_KH, ti, ch, c, g); mm_nt(nt, lds, O_KTT, O_VT, ti, ch, c, g);
#pragma unroll
      for (int n = 0; n < 2; ++n) { const int col = 32 * ch + 16 * n + c;
          const u32x2 rv = *(const RW_LAS u32x2*)(lds + O_RH + (col * PT + row0) * 2);
          f32x4 q = qt[n]; q[0] += __uint_as_float(rv.x << 16); q[1] += __uint_as_float(rv.x & 0xffff0000u); q[2] += __uint_as_float(rv.y << 16); q[3] += __uint_as_float(rv.y & 0xffff0000u);
          const int fo = ((((col >> 4) * 2 + (ti >> 1)) * 64) + (col & 15) + 16 * g) * 8 + (ti & 1) * 4;
          u32x2 o; o.x = pk(q[0], q[1]); o.y = pk(q[2], q[3]); *(u32x2*)(rec + UNIT_QT + fo * 2) = o;
          o.x = pk(ml[n][0], ml[n][1]); o.y = pk(ml[n][2], ml[n][3]); *(u32x2*)(rec + UNIT_ML + fo * 2) = o;
          const int ao = (((2 * ch + n) * 4 + ti) * 64 + lane) * 4;
          o.x = pk(yi[n][0], yi[n][1]); o.y = pk(yi[n][2], yi[n][3]); *(u32x2*)(rec + UNIT_YI + ao * 2) = o;
          *(f32x4*)(rec + UNIT_NT + ao * 4) = nt[n]; } }
    RW_BAR(); RW_TS(9);
  }
#if TS_PROBE >= 100
    if (blockIdx.x == 0 && tid_in == 0) { tsw[0] = (unsigned)ts_acc; tsw[1] = (unsigned)(ts_acc >> 32); }
#endif
#undef RW_TS
#undef RW_PREFETCH_X
#undef RW_PREFETCH_E
#undef RW_LOAD_LORA
}

constexpr int PB_STAGE = 25600, PB_D = 5;
__device__ __forceinline__ void part_b_block(const unsigned char* REC, unsigned short* SREC, RW_LAS unsigned char* lds, int bh, int tid) {
    const int lane = tid & 63, w = __builtin_amdgcn_readfirstlane(tid >> 6), g = lane >> 4;
    const unsigned char* rec0 = REC + (size_t)(bh * 128) * UNIT_BYTES + UNIT_ML;
#define PB_SBAR() asm volatile("s_barrier" ::: "memory")
    if (w >= 4) {
        const int lw = w - 4;
#define PB_ISSUE(CH, SLOT) do { const unsigned char* src_ = rec0 + (size_t)(CH) * UNIT_BYTES + lane * 16; RW_LAS unsigned char* dst_ = lds + (SLOT) * PB_STAGE; \
            _Pragma("unroll") for (int p_ = 0; p_ < 7; ++p_) { const int pc_ = lw + 4 * p_; if (pc_ < 25) __builtin_amdgcn_global_load_lds((const unsigned*)(src_ + pc_ * 1024), (RW_LAS unsigned*)(dst_ + pc_ * 1024), 16, 0, 0); } } while (0)
        for (int c0 = 0; c0 < PB_D; ++c0) PB_ISSUE(c0, c0);
        int slot = 0;
        for (int chunk = 0; chunk < 128; ++chunk) {
            if (chunk <= 128 - PB_D) { if (lw == 0) asm volatile("s_waitcnt vmcnt(28)" ::: "memory"); else asm volatile("s_waitcnt vmcnt(24)" ::: "memory"); }
            else asm volatile("s_waitcnt vmcnt(0)" ::: "memory");
            PB_SBAR();
            PB_SBAR();
            if (chunk + PB_D < 128) PB_ISSUE(chunk + PB_D, slot);
            slot = (slot + 1 == PB_D) ? 0 : slot + 1;
        }
#undef PB_ISSUE
    } else {
        const int vs = w;
        f32x4 st[4];
#pragma unroll
        for (int i = 0; i < 4; ++i) st[i] = (f32x4){0.f, 0.f, 0.f, 0.f};
        unsigned short* sr = SREC + (size_t)(bh * 128) * 4096 + (vs * 2 * 64 + lane) * 8;
        int slot = 0;
        for (int chunk = 0; chunk < 128; ++chunk) {
            PB_SBAR();
            const RW_LAS unsigned char* sb = lds + slot * PB_STAGE;
            bf16x8 mf[4][2]; f32x4 nt[4], pp[4];
#pragma unroll
            for (int i = 0; i < 4; ++i) { mf[i][0] = *(const RW_LAS bf16x8*)(sb + (((i * 2 + 0) * 64) + lane) * 16); mf[i][1] = *(const RW_LAS bf16x8*)(sb + (((i * 2 + 1) * 64) + lane) * 16);
                nt[i] = *(const RW_LAS f32x4*)(sb + 8192 + ((vs * 4 + i) * 64 + lane) * 16); pp[i] = *(const RW_LAS f32x4*)(sb + 24576 + (16 * i + 4 * g) * 4); }
            asm volatile("s_waitcnt lgkmcnt(0)" ::: "memory");
            PB_SBAR();
            bf16x8 bf[2];
#pragma unroll
            for (int s = 0; s < 2; ++s) { u32x4 t_; t_.x = pk(st[2 * s][0], st[2 * s][1]); t_.y = pk(st[2 * s][2], st[2 * s][3]); t_.z = pk(st[2 * s + 1][0], st[2 * s + 1][1]); t_.w = pk(st[2 * s + 1][2], st[2 * s + 1][3]); bf[s] = __builtin_bit_cast(bf16x8, t_);
                *(u32x4*)(sr + (size_t)chunk * 4096 + s * 512) = t_; }
#pragma unroll
            for (int i = 0; i < 4; ++i) { f32x4 a_ = st[i] * pp[i] + nt[i];
                a_ = __builtin_amdgcn_mfma_f32_16x16x32_bf16(mf[i][0], bf[0], a_, 0, 0, 0); a_ = __builtin_amdgcn_mfma_f32_16x16x32_bf16(mf[i][1], bf[1], a_, 0, 0, 0); st[i] = a_; }
            slot = (slot + 1 == PB_D) ? 0 : slot + 1;
        }
    }
#undef PB_SBAR
}

struct PartC { const unsigned char* REC; const unsigned short* SREC; const unsigned short* BON; const unsigned short* GG; const float* ln_w; const float* ln_b; unsigned short* MIX; };
__device__ __forceinline__ void part_c_wave(const PartC& C, RW_LAS unsigned char* stage  , int unit, int i, int lane) {
    constexpr int T_ = 8192;
    const int c = lane & 15, g = lane >> 4, bh = unit >> 7, chunk = unit & 127, b = bh >> 3, h = bh & 7;
    const unsigned char* rec = C.REC + (size_t)unit * UNIT_BYTES; const unsigned short* sr = C.SREC + (size_t)unit * 4096;
    const bf16x8 q0 = *(const bf16x8*)(rec + UNIT_QT + (((i * 2 + 0) * 64) + lane) * 16), q1 = *(const bf16x8*)(rec + UNIT_QT + (((i * 2 + 1) * 64) + lane) * 16);
    f32x4 y[4]; u32x2 bo[4], gg[4];
#pragma unroll
    for (int n = 0; n < 4; ++n) { const bf16x8 s0 = *(const bf16x8*)(sr + ((n * 2 + 0) * 64 + lane) * 8), s1 = *(const bf16x8*)(sr + ((n * 2 + 1) * 64 + lane) * 8);
        const u32x2 yi = *(const u32x2*)(rec + UNIT_YI + ((n * 4 + i) * 64 + lane) * 8);
        bo[n] = *(const u32x2*)(C.BON + (size_t)unit * 4096 + ((n * 4 + i) * 64 + lane) * 4); gg[n] = *(const u32x2*)(C.GG + (size_t)unit * 4096 + ((n * 4 + i) * 64 + lane) * 4);
        f32x4 a; a[0] = __uint_as_float(yi.x << 16); a[1] = __uint_as_float(yi.x & 0xffff0000u); a[2] = __uint_as_float(yi.y << 16); a[3] = __uint_as_float(yi.y & 0xffff0000u);
        a = __builtin_amdgcn_mfma_f32_16x16x32_bf16(q0, s0, a, 0, 0, 0); a = __builtin_amdgcn_mfma_f32_16x16x32_bf16(q1, s1, a, 0, 0, 0); y[n] = a; }
    float lw[4], lb[4];
#pragma unroll
    for (int n = 0; n < 4; ++n) { lw[n] = C.ln_w[h * 64 + 16 * n + c]; lb[n] = C.ln_b[h * 64 + 16 * n + c]; }
#pragma unroll
    for (int r = 0; r < 4; ++r) {
        float s = (y[0][r] + y[1][r]) + (y[2][r] + y[3][r]);
        s += __shfl_xor(s, 1); s += __shfl_xor(s, 2); s += __shfl_xor(s, 4); s += __shfl_xor(s, 8);
        const float mean = s * (1.0f / 64.0f); float d[4], q = 0.f;
#pragma unroll
        for (int n = 0; n < 4; ++n) { d[n] = y[n][r] - mean; q += d[n] * d[n]; }
        q += __shfl_xor(q, 1); q += __shfl_xor(q, 2); q += __shfl_xor(q, 4); q += __shfl_xor(q, 8);
        const float rs = 1.0f / sqrtf(q * (1.0f / 64.0f) + 64e-5f);
#pragma unroll
        for (int n = 0; n < 4; ++n) { const unsigned bw = (r & 2) ? bo[n].y : bo[n].x, gw_ = (r & 2) ? gg[n].y : gg[n].x;
            const float bv = (r & 1) ? __uint_as_float(bw & 0xffff0000u) : __uint_as_float(bw << 16), gv = (r & 1) ? __uint_as_float(gw_ & 0xffff0000u) : __uint_as_float(gw_ << 16);
            *(RW_LAS unsigned short*)(stage + ((4 * g + r) * 64 + 16 * n + c) * 2) = f2b((d[n] * rs * lw[n] + lb[n] + bv) * gv); }
    }
    asm volatile("s_waitcnt lgkmcnt(0)" ::: "memory");
    unsigned short* mix = C.MIX + ((size_t)b * T_ + (size_t)chunk * 64 + 16 * i) * 1024 + h * 64;
#pragma unroll
    for (int rr = 0; rr < 2; ++rr) { const int row = (lane >> 3) + 8 * rr; const u32x4 v = *(const RW_LAS u32x4*)(stage + (row * 64 + (lane & 7) * 8) * 2); *(u32x4*)(mix + (size_t)row * 1024 + (lane & 7) * 8) = v; }
    asm volatile("s_waitcnt lgkmcnt(0)" ::: "memory");
}
#undef RW_ZERO
}

constexpr int NWAVES = 8;
#ifndef MK_N_LAUNCHES
#define MK_N_LAUNCHES 1
#endif
constexpr int PER_PHASE = 10;
constexpr int N_LAUNCHES = MK_N_LAUNCHES;

constexpr int BATCH = 4, T = 8192, D = 1024, M = BATCH * T;
constexpr int IN_W = 3336, NU = 3328;
constexpr int RW = 512, NH = 8, HD = 64;
constexpr int C_R = 0, C_K = 512, C_V = 1024, C_WL = 1536, C_AL = 1600, C_GL = 1664, C_FQ = 1792, C_FK = 2304, C_FV = 2816;
constexpr int NE = 32, TOPK = 4, DFF = 1024, NH1 = 2 * DFF;
constexpr int NSLOTS = M * TOPK + NE * 256;
constexpr float RMS_EPS = 1e-5f, GN_EPS = 64e-5f;
constexpr float LOG2E = 1.4426950408889634f;

constexpr size_t MiB = 1u << 20;
constexpr size_t WS_CTL = 0, CTL_ZERO_BYTES = 64 * 1024;
constexpr size_t WS_WIN = 2 * MiB, WS_WOUT = 9 * MiB, WS_W1 = 12 * MiB, WS_W2 = 140 * MiB;
constexpr size_t WS_XN = 204 * MiB;
constexpr size_t WS_U = 268 * MiB;
constexpr size_t WS_MIX = 476 * MiB;
constexpr size_t WS_X1 = 408 * MiB;
constexpr size_t WS_ACT = 268 * MiB;
constexpr size_t WS_Y2 = 540 * MiB;
constexpr size_t WS_LF = 812 * MiB, WS_CK = 813 * MiB;
constexpr size_t WS_ELIST = 814 * MiB;
constexpr size_t WS_TOKSLOT = 818 * MiB, WS_GATE = 819 * MiB;
constexpr size_t WS_RWT = 11 * MiB + 512 * 1024;
constexpr size_t WS_LORA = 11 * MiB;
constexpr size_t WS_REC = 540 * MiB;
constexpr size_t WS_BON = 820 * MiB, WS_GG = 852 * MiB, WS_SREC = 884 * MiB;
constexpr size_t WS_END = 916 * MiB;
static_assert(WS_REC + (size_t)4096 * rw::UNIT_BYTES <= 812 * MiB, "RWKV records fit the Y2 overlay");
constexpr int CW_TMO = 0, CW_CODE = 1;
constexpr int CW_BAR = 4096;
constexpr int CW_CNT = 8192;
constexpr int CW_AQ = 12288, CW_XQ = 12352, CW_XN = 12416;
constexpr int XW_LIMIT = 40;
constexpr int CW_QK = 12544;

constexpr int RING_OFF = 0, RING_BYTES = 131072;
constexpr int LDSCTL_OFF = 153600, MISC_OFF = LDSCTL_OFF + 320;
constexpr int LCNT_OFF = LDSCTL_OFF + 1024, LBASE_OFF = LCNT_OFF + 128, TPRE_OFF = LBASE_OFF + 128, ECNT_OFF = TPRE_OFF + 256;
constexpr int LDS_BYTES = 157696;
static_assert(rw::PART_A_LDS <= LDSCTL_OFF && RING_BYTES <= LDSCTL_OFF, "phase scratch below the control words");
static_assert(ECNT_OFF + 128 <= LDS_BYTES, "LDS map");

#define GAS __attribute__((address_space(1)))
#define LAS __attribute__((address_space(3)))
typedef unsigned short bf16;
typedef unsigned v4u __attribute__((ext_vector_type(4)));
typedef float f32x4 __attribute__((ext_vector_type(4)));
typedef short bf16x8 __attribute__((ext_vector_type(8)));
typedef GAS unsigned gu32;
typedef GAS unsigned long long gu64;
#define RLX_AGENT __ATOMIC_RELAXED, __HIP_MEMORY_SCOPE_AGENT
#define LDS_WAIT() asm volatile("s_waitcnt lgkmcnt(0)" ::: "memory")
#define VM_WAIT() asm volatile("s_waitcnt vmcnt(0)" ::: "memory")
__device__ __forceinline__ unsigned long long rt() { return __builtin_amdgcn_s_memrealtime(); }
__device__ __forceinline__ unsigned f2bf(float f) { unsigned u = __builtin_bit_cast(unsigned, f); return (u + 0x7fffu + ((u >> 16) & 1u)) >> 16; }
__device__ __forceinline__ unsigned pk2(float lo, float hi) { return f2bf(lo) | (f2bf(hi) << 16); }

#define XB_TMO      128
#define XB_XCNT(j)  (256  + 64 * (j))
#define XB_XSUB(j)  (1280 + 64 * (j))
#define XB_XGEN(j)  (2304 + 64 * (j))
#define XB_TOP      3328
#define XB_TOPGEN   3392
#define XCD_BAR_WORDS 3456
#define XB_SPIN_CAP (1u << 18)

__device__ __forceinline__ unsigned xb_ld(unsigned* p)              { return __hip_atomic_load(p, __ATOMIC_RELAXED, __HIP_MEMORY_SCOPE_AGENT); }
__device__ __forceinline__ unsigned xb_add(unsigned* p, unsigned v) { return __hip_atomic_fetch_add(p, v, __ATOMIC_RELAXED, __HIP_MEMORY_SCOPE_AGENT); }
__device__ __forceinline__ unsigned xb_xcc_id() { return (unsigned)__builtin_amdgcn_s_getreg((3 << 11) | 20) & 0xFu; }
#define XB_SPIN(cond, bar) do { unsigned _sp = 0; while (cond) { __builtin_amdgcn_s_sleep(1); \
    if ((++_sp & 255u) == 0u) { if (xb_ld(&(bar)[XB_TMO])) break; if (_sp > XB_SPIN_CAP) { atomicAdd(&(bar)[XB_TMO], 1u); break; } } } } while (0)

struct XcdBarrier {
    unsigned* bar; unsigned x;
    volatile LAS unsigned* st;
};

__device__ __forceinline__ XcdBarrier xcd_barrier_post(unsigned* bar, volatile LAS unsigned* st) {
    XcdBarrier b; b.bar = bar; b.x = xb_xcc_id(); b.st = st;
    if (threadIdx.x == 0) (void)xb_add(&bar[XB_XCNT(b.x)], 1u);
    return b;
}
__device__ __forceinline__ void xcd_barrier_complete(unsigned* bar, unsigned x, unsigned& nloc, unsigned& nx) {
    const unsigned G = gridDim.x * gridDim.y * gridDim.z;
    unsigned sum, cnt, mine, sp = 0u;
    for (;;) {
        sum = 0u; cnt = 0u; mine = 0u;
#pragma unroll
        for (unsigned j = 0; j < 16; ++j) { const unsigned c = xb_ld(&bar[XB_XCNT(j)]); sum += c; cnt += (c > 0u) ? 1u : 0u; mine = (j == x) ? c : mine; }
        if (sum == G) break;
        __builtin_amdgcn_s_sleep(1);
        if ((++sp & 255u) == 0u) { if (xb_ld(&bar[XB_TMO])) break; if (sp > XB_SPIN_CAP) { atomicAdd(&bar[XB_TMO], 1u); break; } }
    }
    nloc = mine > 0u ? mine : 1u; nx = cnt > 0u ? cnt : 1u;
}

__device__ __forceinline__ void xcd_barrier(const XcdBarrier& b) {
    asm volatile("s_waitcnt vmcnt(0)" ::: "memory");
    __syncthreads();
    if (threadIdx.x == 0) {
        unsigned* bar = b.bar;
        __builtin_amdgcn_s_waitcnt(0);
        unsigned nloc = b.st[0], nx = b.st[1];
        if (nloc == 0u) { xcd_barrier_complete(bar, b.x, nloc, nx); b.st[0] = nloc; b.st[1] = nx; }
        const unsigned old = xb_add(&bar[XB_XSUB(b.x)], 1u);
        const unsigned gen = old / nloc;
        if (old + 1u == (gen + 1u) * nloc) {
            __builtin_amdgcn_fence(__ATOMIC_RELEASE, "agent");
            asm volatile("s_waitcnt vmcnt(0)" ::: "memory");
            const unsigned og = xb_add(&bar[XB_TOP], 1u);
            const unsigned tg = og / nx;
            if (og + 1u == (tg + 1u) * nx) xb_add(&bar[XB_TOPGEN], 1u);
            else XB_SPIN(xb_ld(&bar[XB_TOPGEN]) == tg, bar);
            __builtin_amdgcn_fence(__ATOMIC_ACQUIRE, "agent");
            xb_add(&bar[XB_XGEN(b.x)], 1u);
            asm volatile("s_waitcnt vmcnt(0)" ::: "memory");
        } else {
            XB_SPIN(xb_ld(&bar[XB_XGEN(b.x)]) == gen, bar);
            __builtin_amdgcn_fence(__ATOMIC_ACQUIRE, "agent");
            asm volatile("s_waitcnt vmcnt(0)" ::: "memory");
        }
    }
    __syncthreads();
}
struct Frame {
    LAS unsigned char* lds;
    volatile LAS unsigned* MISC;
    gu32* ctl;
    int tid, lane, wave;
    int vcu, G;
    const float* const __attribute__((address_space(4)))* in;
    float* out; unsigned char* ws;
};
enum { I_X = 0, I_ANG, I_WIN, I_MU, I_W0, I_WUP, I_A0, I_AUP, I_GUP, I_KK, I_KA, I_RK, I_LNW, I_LNB, I_FB, I_OG, I_WOUT, I_FNG, I_RW, I_RB, I_W1, I_B1, I_W2, I_B2, I_FIN };

__device__ __forceinline__ float wave_sum(float v) {
#define WS_DPP(ctrl, rmask) v += __uint_as_float((unsigned)__builtin_amdgcn_update_dpp(0, (int)__float_as_uint(v), ctrl, rmask, 0xF, false))
    WS_DPP(0xB1, 0xF); WS_DPP(0x4E, 0xF); WS_DPP(0x141, 0xF); WS_DPP(0x140, 0xF);
    WS_DPP(0x142, 0xA); WS_DPP(0x143, 0xC);
#undef WS_DPP
    return __uint_as_float((unsigned)__builtin_amdgcn_readlane((int)__float_as_uint(v), 63));
}
__device__ __forceinline__ float bf2f(bf16 b) { return __uint_as_float((unsigned)b << 16); }
__device__ __forceinline__ float sigmoidf_(float x) { return 1.0f / (1.0f + __expf(-x)); }

struct XwRegs { f32x4 v[8]; };
__device__ __forceinline__ void p0_transpose_load(XwRegs& R, const float* W, int ldw, int ncols, int item, int lane) {
    const int nblk = ncols / 32, kb = item / nblk, nb = item % nblk, k0 = 64 * kb, n0 = 32 * nb;
#pragma unroll
    for (int i = 0; i < 8; ++i) { const int kk = 8 * i + (lane >> 3); R.v[i] = __builtin_nontemporal_load((const f32x4*)(W + (size_t)(k0 + kk) * ldw + n0 + 4 * (lane & 7))); }
}
template <bool FP8> __device__ __forceinline__ void p0_transpose_finish(const XwRegs& R, int K, int ncols, bf16* WT, LAS float* scr, int item, int lane) {
    const int nblk = ncols / 32, kb = item / nblk, nb = item % nblk, k0 = 64 * kb, n0 = 32 * nb;
#pragma unroll
    for (int i = 0; i < 8; ++i) { const int kk = 8 * i + (lane >> 3); LAS float* d = scr + kk * 33 + 4 * (lane & 7); d[0] = R.v[i].x; d[1] = R.v[i].y; d[2] = R.v[i].z; d[3] = R.v[i].w; }
    LDS_WAIT(); asm volatile("" ::: "memory");
    const int c = lane & 7;
#pragma unroll
    for (int j = 0; j < 4; ++j) { const int n = (lane >> 3) + 8 * j; const LAS float* s = scr + (8 * c) * 33 + n;
        if constexpr (FP8) { int w0 = __builtin_amdgcn_cvt_pk_fp8_f32(s[0 * 33] * 64.f, s[1 * 33] * 64.f, 0, false); w0 = __builtin_amdgcn_cvt_pk_fp8_f32(s[2 * 33] * 64.f, s[3 * 33] * 64.f, w0, true);
            int w1 = __builtin_amdgcn_cvt_pk_fp8_f32(s[4 * 33] * 64.f, s[5 * 33] * 64.f, 0, false); w1 = __builtin_amdgcn_cvt_pk_fp8_f32(s[6 * 33] * 64.f, s[7 * 33] * 64.f, w1, true);
            typedef int i32x2_ __attribute__((ext_vector_type(2))); *(i32x2_*)((unsigned char*)WT + (size_t)(n0 + n) * K + k0 + 8 * c) = (i32x2_){w0, w1}; }
        else { v4u o; o.x = pk2(s[0 * 33], s[1 * 33]); o.y = pk2(s[2 * 33], s[3 * 33]); o.z = pk2(s[4 * 33], s[5 * 33]); o.w = pk2(s[6 * 33], s[7 * 33]);
        *(GAS v4u*)(WT + (size_t)(n0 + n) * K + k0 + 8 * c) = o; } }
    LDS_WAIT(); asm volatile("" ::: "memory");
}
template <bool FP8> __device__ __forceinline__ void p0_transpose_item(const float* W, int K, int ldw, int ncols, bf16* WT, LAS float* scr, int item, int lane) {
    XwRegs R; p0_transpose_load(R, W, ldw, ncols, item, lane); p0_transpose_finish<FP8>(R, K, ncols, WT, scr, item, lane);
}

__device__ __forceinline__ void p0_prologue(Frame& F) {
    LAS float* scr = (LAS float*)(F.lds + RING_OFF + F.wave * 16384);
    const int gw = F.vcu * NWAVES + F.wave, NGW = F.G * NWAVES;
    constexpr int I_IN = (D / 64) * (NU / 32), I_O = (D / 64) * (D / 32), I_1 = (D / 64) * (NH1 / 32), I_2 = (DFF / 64) * (D / 32);
    constexpr int NITEMS = I_IN + I_O;
    bf16* WIN_T = (bf16*)(F.ws + WS_WIN); bf16* WOUT_T = (bf16*)(F.ws + WS_WOUT); bf16* W1_T = (bf16*)(F.ws + WS_W1); bf16* W2_T = (bf16*)(F.ws + WS_W2);
    for (int it = gw; it < NITEMS; it += NGW) {
        int r = it;
        if (r < I_IN) { p0_transpose_item<false>(F.in[I_WIN], D, IN_W, NU, WIN_T, scr, r, F.lane); continue; } r -= I_IN;
        p0_transpose_item<false>(F.in[I_WOUT], D, D, D, WOUT_T, scr, r, F.lane);
    }
    { bf16* WUPT = (bf16*)(F.ws + WS_LORA); bf16* AUPT = WUPT + RW * 64; bf16* GUPT = AUPT + RW * 64;
      for (int i = (F.vcu * NWAVES + F.wave) * 64 + F.lane; i < RW * 64; i += F.G * NWAVES * 64) { const int c = i >> 6, j = i & 63; WUPT[i] = (bf16)f2bf(F.in[I_WUP][j * RW + c]); AUPT[i] = (bf16)f2bf(F.in[I_AUP][j * RW + c]); }
      for (int i = (F.vcu * NWAVES + F.wave) * 64 + F.lane; i < RW * 128; i += F.G * NWAVES * 64) { const int c = i >> 7, j = i & 127; GUPT[i] = (bf16)f2bf(F.in[I_GUP][j * RW + c]); }
      bf16* RWH = (bf16*)(F.ws + WS_RWT); bf16* RWL = RWH + NE * D;
      for (int i = (F.vcu * NWAVES + F.wave) * 64 + F.lane; i < NE * D; i += F.G * NWAVES * 64) { const int e = i >> 10, k = i & 1023; const float w = F.in[I_RW][k * NE + e] * F.in[I_FNG][k]; const unsigned h_ = f2bf(w);   RWH[i] = (bf16)h_; RWL[i] = (bf16)f2bf(w - __uint_as_float(h_ << 16)); } }
    __syncthreads();
    LAS float* wfl = (LAS float*)(F.lds + RING_OFF);
    for (int k = F.tid; k < D; k += NWAVES * 64) {
#pragma unroll
        for (int j = 0; j < 8; ++j) wfl[j * D + k] = F.in[I_WIN][(size_t)k * IN_W + NU + j];
    }
    __syncthreads();
    bf16* XN = (bf16*)(F.ws + WS_XN); float* LF = (float*)(F.ws + WS_LF);
    const float* g = F.in[I_ANG];
    f32x4 gnv[4];
#pragma unroll
    for (int j = 0; j < 4; ++j) gnv[j] = *(const f32x4*)(g + 4 * F.lane + 256 * j);
    for (int m = gw; m < M; m += NGW) {
        const GAS f32x4* xr = (const GAS f32x4*)(F.in[I_X] + (size_t)m * D) + F.lane;
        f32x4 v[4]; float s2 = 0.f;
#pragma unroll
        for (int j = 0; j < 4; ++j) { v[j] = xr[64 * j]; s2 += (v[j].x * v[j].x + v[j].y * v[j].y) + (v[j].z * v[j].z + v[j].w * v[j].w); }
        const float rstd = 1.f / sqrtf(wave_sum(s2) * (1.f / D) + RMS_EPS);
        GAS unsigned long long* o8 = (GAS unsigned long long*)(XN + (size_t)m * D) + F.lane;
        float fl[8];
#pragma unroll
        for (int j = 0; j < 8; ++j) fl[j] = 0.f;
#pragma unroll
        for (int j = 0; j < 4; ++j) { const f32x4 gv = gnv[j]; v[j] = v[j] * rstd * gv;
            o8[64 * j] = (unsigned long long)pk2(v[j].x, v[j].y) | ((unsigned long long)pk2(v[j].z, v[j].w) << 32);
#pragma unroll
            for (int q = 0; q < 8; ++q) { const f32x4 w = *(const LAS f32x4*)(wfl + q * D + 4 * F.lane + 256 * j); fl[q] += (v[j].x * w.x + v[j].y * w.y) + (v[j].z * w.z + v[j].w * w.w); } }
        float mine = 0.f;
#pragma unroll
        for (int q = 0; q < 8; ++q) { const float s = wave_sum(fl[q]); if (F.lane == q) mine = s; }
        if (F.lane < 8) { const float z = mine + F.in[I_FB][F.lane]; const float ls = fminf(z, 0.f) - log1pf(__expf(-fabsf(z)));
            const int b = m / T, t = m % T; LF[(size_t)(b * NH + F.lane) * T + t] = ls * LOG2E; }
    }
}

constexpr int XW_I1 = (D / 64) * (NH1 / 32), XW_I2 = (DFF / 64) * (D / 32), XW_ITEMS = NE * (XW_I1 + XW_I2) / 32;
__device__ __forceinline__ void xw_item(Frame& F, int bi) {
    LAS float* scr = (LAS float*)(F.lds + RING_OFF + F.wave * 16384);
    unsigned char* W1_8 = F.ws + WS_W1; unsigned char* W2_8 = F.ws + WS_W2;
    const int r0 = bi * 32 + F.wave * 4;
    XwRegs R[4];
    if (r0 < NE * XW_I1) {
#pragma unroll
        for (int q = 0; q < 4; ++q) { const int r = r0 + q, e = r / XW_I1; p0_transpose_load(R[q], F.in[I_W1] + (size_t)e * D * NH1, NH1, NH1, r % XW_I1, F.lane); }
#pragma unroll
        for (int q = 0; q < 4; ++q) { const int r = r0 + q, e = r / XW_I1; p0_transpose_finish<true>(R[q], D, NH1, (bf16*)(W1_8 + (size_t)e * NH1 * D), scr, r % XW_I1, F.lane); }
    } else {
#pragma unroll
        for (int q = 0; q < 4; ++q) { const int r = r0 + q - NE * XW_I1, e = r / XW_I2; p0_transpose_load(R[q], F.in[I_W2] + (size_t)e * DFF * D, D, D, r % XW_I2, F.lane); }
#pragma unroll
        for (int q = 0; q < 4; ++q) { const int r = r0 + q - NE * XW_I1, e = r / XW_I2; p0_transpose_finish<true>(R[q], DFF, D, (bf16*)(W2_8 + (size_t)e * D * DFF), scr, r % XW_I2, F.lane); }
    }
}

__device__ __forceinline__ void p2_cumsum(Frame& F, int bh) {
    const float* lf = (const float*)(F.ws + WS_LF) + (size_t)bh * T; float* ck = (float*)(F.ws + WS_CK) + (size_t)bh * T;
    LAS double* wt = (LAS double*)(F.lds + RING_OFF);
    f32x4 v[4];
#pragma unroll
    for (int j = 0; j < 4; ++j) v[j] = *(const f32x4*)(lf + F.tid * 16 + 4 * j);
    double run = 0.0;
#pragma unroll
    for (int j = 0; j < 4; ++j) run += ((double)v[j].x + (double)v[j].y) + ((double)v[j].z + (double)v[j].w);
    double incl = run;
#pragma unroll
    for (int o = 1; o < 64; o <<= 1) { const double n = __shfl_up(incl, o); if (F.lane >= o) incl += n; }
    if (F.lane == 63) wt[F.wave] = incl;
    __syncthreads();
    double acc = incl - run;
    for (int j = 0; j < F.wave; ++j) acc += wt[j];
#pragma unroll
    for (int j = 0; j < 4; ++j) { f32x4 o; acc += (double)v[j].x; o.x = (float)acc; acc += (double)v[j].y; o.y = (float)acc; acc += (double)v[j].z; o.z = (float)acc; acc += (double)v[j].w; o.w = (float)acc; *(f32x4*)(ck + F.tid * 16 + 4 * j) = o; }
    __syncthreads();
}

__device__ __forceinline__ float row_max16(float v) {
#define RM_DPP(ctrl) v = fmaxf(v, __uint_as_float((unsigned)__builtin_amdgcn_update_dpp(0, (int)__float_as_uint(v), ctrl, 0xF, 0xF, true)))
    RM_DPP(0xB1); RM_DPP(0x4E); RM_DPP(0x141); RM_DPP(0x140);
#undef RM_DPP
    return v;
}
__device__ __forceinline__ int row_min16(int v) {
#define RM_DPP(ctrl) { const int o_ = __builtin_amdgcn_update_dpp(0, v, ctrl, 0xF, 0xF, true); v = o_ < v ? o_ : v; }
    RM_DPP(0xB1); RM_DPP(0x4E); RM_DPP(0x141); RM_DPP(0x140);
#undef RM_DPP
    return v;
}
__device__ __forceinline__ void p6_route(Frame& F) {
    typedef short bf16x8_ __attribute__((ext_vector_type(8)));
    LAS unsigned* lcnt = (LAS unsigned*)(F.lds + LCNT_OFF); LAS unsigned* lbase = (LAS unsigned*)(F.lds + LBASE_OFF);
    const bf16* X1 = (const bf16*)(F.ws + WS_X1); unsigned char* XN8 = F.ws + WS_XN; const float* g2 = F.in[I_FNG];
    const bf16* RWH = (const bf16*)(F.ws + WS_RWT); const bf16* RWL = RWH + NE * D;
    int* ELIST = (int*)(F.ws + WS_ELIST); int* TOKSLOT = (int*)(F.ws + WS_TOKSLOT); float* GATE = (float*)(F.ws + WS_GATE);
    const int lane = F.lane, c = lane & 15, g = lane >> 4;
    if (F.tid < NE) lcnt[F.tid] = 0u;
    __syncthreads();
    for (int blk = F.vcu; blk < M / 128; blk += F.G) {
        const int m0 = blk * 128 + F.wave * 16;
        const bf16* xr = X1 + (size_t)(m0 + c) * D + 8 * g;
        const float* gr = g2 + 8 * g;
        int wo_ = c * D + 8 * g; asm volatile("" : "+v"(wo_));
        const bf16* bh0 = RWH + wo_; const bf16* bh1 = bh0 + 16 * D; const bf16* bl0 = RWL + wo_; const bf16* bl1 = bl0 + 16 * D;
        f32x4 a0 = {0.f, 0.f, 0.f, 0.f}, a1 = {0.f, 0.f, 0.f, 0.f}; float ss = 0.f;
        v4u xw[32];
#pragma unroll
        for (int s = 0; s < 32; ++s) xw[s] = *(const v4u*)(xr + 32 * s);
#pragma unroll
        for (int s0 = 0; s0 < 32; s0 += 2) {
            bf16x8_ wh0[2], wh1[2], wl0[2], wl1[2];
            __builtin_amdgcn_sched_barrier(0);
#pragma unroll
            for (int q = 0; q < 2; ++q) { wh0[q] = *(const bf16x8_*)(bh0 + 32 * (s0 + q)); wh1[q] = *(const bf16x8_*)(bh1 + 32 * (s0 + q)); wl0[q] = *(const bf16x8_*)(bl0 + 32 * (s0 + q)); wl1[q] = *(const bf16x8_*)(bl1 + 32 * (s0 + q)); }
#pragma unroll
            for (int q = 0; q < 2; ++q) { const v4u xw_ = xw[s0 + q];
                const f32x4 x0 = {__uint_as_float(xw_.x << 16), __uint_as_float(xw_.x & 0xffff0000u), __uint_as_float(xw_.y << 16), __uint_as_float(xw_.y & 0xffff0000u)}, x1 = {__uint_as_float(xw_.z << 16), __uint_as_float(xw_.z & 0xffff0000u), __uint_as_float(xw_.w << 16), __uint_as_float(xw_.w & 0xffff0000u)};
                ss += (x0.x * x0.x + x0.y * x0.y) + (x0.z * x0.z + x0.w * x0.w) + (x1.x * x1.x + x1.y * x1.y) + (x1.z * x1.z + x1.w * x1.w);
                const bf16x8_ ax = __builtin_bit_cast(bf16x8_, xw_);
                a0 = __builtin_amdgcn_mfma_f32_16x16x32_bf16(ax, wh0[q], a0, 0, 0, 0); a1 = __builtin_amdgcn_mfma_f32_16x16x32_bf16(ax, wh1[q], a1, 0, 0, 0);
                a0 = __builtin_amdgcn_mfma_f32_16x16x32_bf16(ax, wl0[q], a0, 0, 0, 0); a1 = __builtin_amdgcn_mfma_f32_16x16x32_bf16(ax, wl1[q], a1, 0, 0, 0); } }
        ss += __shfl_xor(ss, 16); ss += __shfl_xor(ss, 32);
        const float rstd = 1.f / sqrtf(ss * (1.f / D) + RMS_EPS);
        { unsigned char* xo = XN8 + (size_t)(m0 + c) * D + 8 * g;
#pragma unroll
          for (int s0 = 0; s0 < 32; s0 += 4) { f32x4 ga[4], gb[4];
              __builtin_amdgcn_sched_barrier(0);
#pragma unroll
              for (int q = 0; q < 4; ++q) { ga[q] = *(const f32x4*)(gr + 32 * (s0 + q)); gb[q] = *(const f32x4*)(gr + 32 * (s0 + q) + 4); }
#pragma unroll
              for (int q = 0; q < 4; ++q) { v4u xw_ = xw[s0 + q]; asm volatile("" : "+v"(xw_));
                  const f32x4 x0 = {__uint_as_float(xw_.x << 16), __uint_as_float(xw_.x & 0xffff0000u), __uint_as_float(xw_.y << 16), __uint_as_float(xw_.y & 0xffff0000u)}, x1 = {__uint_as_float(xw_.z << 16), __uint_as_float(xw_.z & 0xffff0000u), __uint_as_float(xw_.w << 16), __uint_as_float(xw_.w & 0xffff0000u)};
                  const f32x4 y0 = x0 * ga[q] * rstd, y1 = x1 * gb[q] * rstd;
                  int w0 = __builtin_amdgcn_cvt_pk_fp8_f32(y0.x, y0.y, 0, false); w0 = __builtin_amdgcn_cvt_pk_fp8_f32(y0.z, y0.w, w0, true);
                  int w1 = __builtin_amdgcn_cvt_pk_fp8_f32(y1.x, y1.y, 0, false); w1 = __builtin_amdgcn_cvt_pk_fp8_f32(y1.z, y1.w, w1, true);
                  typedef int i32x2_ __attribute__((ext_vector_type(2))); *(i32x2_*)(xo + 32 * (s0 + q)) = (i32x2_){w0, w1}; } } }
        const float rb0 = F.in[I_RB][c], rb1 = F.in[I_RB][16 + c];
        int pe = 0; float pg = 0.f;
#pragma unroll
        for (int r = 0; r < 4; ++r) { const float rs = __shfl(rstd, 4 * g + r); float v0 = a0[r] * rs + rb0, v1 = a1[r] * rs + rb1;
            float tv[4]; int ti[4];
#pragma unroll
            for (int k = 0; k < 4; ++k) { const bool first = v0 >= v1; const float bv = first ? v0 : v1; const int be = first ? c : 16 + c;
                const float mx = row_max16(bv); const int wi = row_min16(bv == mx ? be : 99);
                tv[k] = mx; ti[k] = wi; if (wi == c) v0 = -INFINITY; if (wi == 16 + c) v1 = -INFINITY; }
            const float e1 = __expf(tv[1] - tv[0]), e2 = __expf(tv[2] - tv[0]), e3 = __expf(tv[3] - tv[0]); const float inv = 1.f / (1.f + e1 + e2 + e3);
            if ((c >> 2) == r) { const int k = c & 3; pe = k == 0 ? ti[0] : k == 1 ? ti[1] : k == 2 ? ti[2] : ti[3]; pg = (k == 0 ? 1.f : k == 1 ? e1 : k == 2 ? e2 : e3) * inv; } }
        const int ptok = m0 + 4 * g + (c >> 2);
        const unsigned lpos = atomicAdd((unsigned*)(lcnt + pe), 1u);
        __syncthreads();
        if (F.tid < NE) { const unsigned n = lcnt[F.tid]; lbase[F.tid] = n ? __hip_atomic_fetch_add((unsigned*)(F.ctl + CW_CNT + 64 * F.tid), n, RLX_AGENT) : 0u; }
        __syncthreads();
        const unsigned p = lbase[pe] + lpos;
        ELIST[(size_t)pe * M + p] = ptok; TOKSLOT[ptok * 4 + (c & 3)] = (pe << 16) | (int)p; GATE[ptok * 4 + (c & 3)] = pg;
        __syncthreads();
        if (F.tid < NE) lcnt[F.tid] = 0u;
        __syncthreads();
    }
}

__device__ __forceinline__ void moe_prefix(Frame& F) {
    LAS int* tpre = (LAS int*)(F.lds + TPRE_OFF); LAS int* ecnt = (LAS int*)(F.lds + ECNT_OFF);
    if (F.tid < NE) ecnt[F.tid] = (int)__hip_atomic_load((unsigned*)(F.ctl + CW_CNT + 64 * F.tid), RLX_AGENT);
    __syncthreads();
    if (F.tid == 0) { int run = 0; for (int e = 0; e < NE; ++e) { tpre[e] = run; run += (ecnt[e] + 255) >> 8; } tpre[NE] = run; }
    __syncthreads();
}
struct MoeOrder {
    const LAS int* tpre; const LAS int* ecnt; int nN, G, c;
    __device__ __forceinline__ bool next(int i, pg8::Unit& u) const {
        const int ux = i * (G >> 3) + (c >> 3), pm = 8 * (ux / nN) + (c & 7); const int ntl = __builtin_amdgcn_readfirstlane(tpre[NE]); if (pm >= ntl) return false;
        const int L = ux; int e = 0;
        for (int j = 1; j < NE; ++j) { if (__builtin_amdgcn_readfirstlane(tpre[j]) <= pm) e = j; }
        u.pm = pm; u.pn = L % nN; u.e = e; u.l0 = (pm - __builtin_amdgcn_readfirstlane(tpre[e])) * 256; u.cnt = __builtin_amdgcn_readfirstlane(ecnt[e]); return true;
    }
    __device__ __forceinline__ void a_ready(const pg8::Unit&) const {}
    __device__ __forceinline__ void done(const pg8::Unit&) const {}
};

__device__ __forceinline__ void p9_final(Frame& F) {
    const int gw = F.vcu * NWAVES + F.wave, NGW = F.G * NWAVES, lane = F.lane;
    const LAS int* tpre = (const LAS int*)(F.lds + TPRE_OFF);
    const bf16* Y2 = (const bf16*)(F.ws + WS_Y2); const int* TOKSLOT = (const int*)(F.ws + WS_TOKSLOT); const float* GATE = (const float*)(F.ws + WS_GATE);
    const float* gf = F.in[I_FIN];
    int ts[4]; float gt[4];
    f32x4 gfv[4];
#pragma unroll
    for (int j = 0; j < 4; ++j) gfv[j] = *(const f32x4*)(gf + 4 * lane + 256 * j);
#pragma unroll
    for (int k = 0; k < 4; ++k) { ts[k] = TOKSLOT[gw * 4 + k]; gt[k] = GATE[gw * 4 + k]; }
    for (int m = gw; m < M; m += NGW) {
        GAS f32x4* xr = (GAS f32x4*)(F.out + (size_t)m * D) + lane;
        const GAS unsigned long long* x1r = (const GAS unsigned long long*)((const bf16*)(F.ws + WS_X1) + (size_t)m * D) + lane;
        f32x4 v[4];
#pragma unroll
        for (int j = 0; j < 4; ++j) { const unsigned long long w_ = x1r[64 * j]; const unsigned lo_ = (unsigned)w_, hi_ = (unsigned)(w_ >> 32);
            v[j] = (f32x4){__uint_as_float(lo_ << 16), __uint_as_float(lo_ & 0xffff0000u), __uint_as_float(hi_ << 16), __uint_as_float(hi_ & 0xffff0000u)}; }
        int yw[4][4]; float gc[4];
#pragma unroll
        for (int k = 0; k < 4; ++k) { const int e = ts[k] >> 16, p = ts[k] & 0xffff; gc[k] = gt[k] * 0.25f;
            const size_t row = (size_t)tpre[e] * 256 + p; const GAS int* yr = (const GAS int*)((const unsigned char*)Y2 + row * D) + lane;
#pragma unroll
            for (int j = 0; j < 4; ++j) yw[k][j] = yr[64 * j]; }
        { const int mn = (m + NGW < M) ? m + NGW : m;
#pragma unroll
          for (int k = 0; k < 4; ++k) { ts[k] = TOKSLOT[mn * 4 + k]; gt[k] = GATE[mn * 4 + k]; } }
#pragma unroll
        for (int k = 0; k < 4; ++k)
#pragma unroll
            for (int j = 0; j < 4; ++j) { const int w = yw[k][j]; const float g_ = gc[k];
                v[j].x += g_ * __builtin_amdgcn_cvt_f32_fp8(w, 0); v[j].y += g_ * __builtin_amdgcn_cvt_f32_fp8(w, 1); v[j].z += g_ * __builtin_amdgcn_cvt_f32_fp8(w, 2); v[j].w += g_ * __builtin_amdgcn_cvt_f32_fp8(w, 3); }
        float s2 = 0.f;
#pragma unroll
        for (int j = 0; j < 4; ++j) s2 += (v[j].x * v[j].x + v[j].y * v[j].y) + (v[j].z * v[j].z + v[j].w * v[j].w);
        const float rstd = 1.f / sqrtf(wave_sum(s2) * (1.f / D) + RMS_EPS);
#pragma unroll
        for (int j = 0; j < 4; ++j) xr[64 * j] = v[j] * rstd * gfv[j];
    }
}

struct Args { const float* in[25]; float* out; unsigned char* ws; int ph_lo, ph_hi, li, pad; };
__global__ void __launch_bounds__(NWAVES * 64, 2) mk_fwd(Args args) {
    extern __shared__ __attribute__((aligned(16))) unsigned char lds[];
    Frame F;
    F.lds = (LAS unsigned char*)lds;
    F.MISC = (volatile LAS unsigned*)(F.lds + MISC_OFF);
    F.tid = threadIdx.x; F.lane = F.tid & 63; F.wave = __builtin_amdgcn_readfirstlane(F.tid >> 6);
    F.G = gridDim.x; { const int bx = blockIdx.x; F.vcu = (F.G % 8 == 0) ? (bx % 8) * (F.G / 8) + bx / 8 : bx; }
    F.in = (const float* const __attribute__((address_space(4)))*)__builtin_amdgcn_kernarg_segment_ptr();
    F.out = args.out; F.ws = args.ws; F.ctl = (gu32*)(args.ws + WS_CTL);
    for (int u = F.tid; u < (LDS_BYTES - LDSCTL_OFF) / 4; u += NWAVES * 64) ((LAS unsigned*)(F.lds + LDSCTL_OFF))[u] = 0u;
    __syncthreads();
    XcdBarrier bar; bar.bar = (unsigned*)(F.ctl + CW_BAR); bar.x = 0; bar.st = nullptr;
    if (N_LAUNCHES != PER_PHASE) bar = xcd_barrier_post((unsigned*)(F.ctl + CW_BAR), F.MISC + 8);
#define GRID_BAR(seam) do { if (N_LAUNCHES == PER_PHASE) { if (F.tid == 0) __hip_atomic_store(F.ctl + CW_TMO, 0xBADBA0u | (unsigned)(seam), RLX_AGENT); } else { xcd_barrier(bar); } } while (0)
    const int lo = args.ph_lo, hi = args.ph_hi;
#define STAMP(k) do { if (TS_PROBE >= 0 && TS_PROBE < 100 && blockIdx.x == 0 && F.tid == 0) { const unsigned long long ts_ = __builtin_amdgcn_s_memrealtime(); F.MISC[32 + 2 * (k)] = (unsigned)ts_; F.MISC[33 + 2 * (k)] = (unsigned)(ts_ >> 32); } } while (0)
    STAMP(0);
#define IN(k) (lo <= (k) && (k) < hi)
#define BOTH(k) (IN(k) && IN((k) + 1))
    bf16* WIN_T = (bf16*)(F.ws + WS_WIN); bf16* WOUT_T = (bf16*)(F.ws + WS_WOUT); bf16* W1_T = (bf16*)(F.ws + WS_W1); bf16* W2_T = (bf16*)(F.ws + WS_W2);
    bf16* XN = (bf16*)(F.ws + WS_XN); bf16* U = (bf16*)(F.ws + WS_U); bf16* MIX = (bf16*)(F.ws + WS_MIX); bf16* ACT = (bf16*)(F.ws + WS_ACT); bf16* Y2 = (bf16*)(F.ws + WS_Y2);

    if (IN(0)) { _Pragma("unroll") for (int rep_ = 0; rep_ < DUPN(0); ++rep_) p0_prologue(F); if (BOTH(0)) GRID_BAR(0); STAMP(1); }

    if (IN(1)) {
        pg8::Gemm g{XN, WIN_T, D, 0, nullptr, 0}; pg8::StaticOrder S; S.init(M, NU, F.G, (int)blockIdx.x);
        pg8::EpiU E{U, NU, C_FQ / 256, C_FK / 256, attn_body::C2};
        _Pragma("unroll") for (int rep_ = 0; rep_ < DUPN(1); ++rep_) pg8::gemm_phase<pg8::EpiU, pg8::StaticOrder, false, PG8_ALIGN, PG8_SP2>(F.lds + RING_OFF, g, S, E);
        if (BOTH(1)) GRID_BAR(1); STAMP(2);
    }

    if (IN(2)) {
      _Pragma("unroll") for (int rep_ = 0; rep_ < DUPN(2); ++rep_) {
        _Pragma("unroll") for (int r2_ = 0; r2_ < DUPN(11); ++r2_) if (F.vcu < BATCH * NH) p2_cumsum(F, F.vcu);
        _Pragma("unroll") for (int r2_ = 0; r2_ < DUPN(10); ++r2_) { const int gw = F.vcu * NWAVES + F.wave, bh = gw & 31, b = bh / NH, h = bh % NH; float qm = 0.f, km = 0.f;
          {
            const bf16* ub = U + ((size_t)b * T + (size_t)(gw >> 5) * 128 + (F.lane >> 3)) * NU + h * HD + (F.lane & 7) * 8;
            v4u qv[16], kv[16];
#pragma unroll
            for (int i = 0; i < 16; ++i) { qv[i] = *(const v4u*)(ub + (size_t)i * 8 * NU + C_FQ); kv[i] = *(const v4u*)(ub + (size_t)i * 8 * NU + C_FK); }
#pragma unroll
            for (int i = 0; i < 16; ++i) { float sq = 0.f, sk = 0.f;
#pragma unroll
                for (int e = 0; e < 4; ++e) { const float q0 = __uint_as_float(qv[i][e] << 16), q1 = __uint_as_float(qv[i][e] & 0xffff0000u), k0 = __uint_as_float(kv[i][e] << 16), k1 = __uint_as_float(kv[i][e] & 0xffff0000u);
                    sq += q0 * q0 + q1 * q1; sk += k0 * k0 + k1 * k1; }
                qm = fmaxf(qm, sq + 0.f); km = fmaxf(km, sk); qv[i].x = __float_as_uint(sq); kv[i].x = __float_as_uint(sk); }
            qm = 0.f; km = 0.f;
#pragma unroll
            for (int i = 0; i < 16; ++i) { float sq = __uint_as_float(qv[i].x), sk = __uint_as_float(kv[i].x);
#define NR_DPP(v, ctrl) v += __uint_as_float((unsigned)__builtin_amdgcn_update_dpp(0, (int)__float_as_uint(v), ctrl, 0xF, 0xF, true))
                NR_DPP(sq, 0xB1); NR_DPP(sq, 0x4E); NR_DPP(sq, 0x141); NR_DPP(sk, 0xB1); NR_DPP(sk, 0x4E); NR_DPP(sk, 0x141);
#undef NR_DPP
                qm = fmaxf(qm, sq); km = fmaxf(km, sk); }
#pragma unroll
            for (int o = 8; o < 64; o <<= 1) { qm = fmaxf(qm, __shfl_xor(qm, o)); km = fmaxf(km, __shfl_xor(km, o)); } }
          if (F.lane == 0) { __hip_atomic_fetch_max((unsigned*)(F.ctl + CW_QK + 64 * bh), __float_as_uint(sqrtf(qm)), RLX_AGENT); __hip_atomic_fetch_max((unsigned*)(F.ctl + CW_QK + 64 * bh + 1), __float_as_uint(sqrtf(km)), RLX_AGENT); } }
        {
          const rw::PartA PA{F.in, F.ws, WS_U, WS_LORA, WS_REC, WS_BON, WS_GG};
          _Pragma("unroll") for (int r2_ = 0; r2_ < DUPN(9); ++r2_) for (int u = F.vcu * 16; u < 4096; u += F.G * 16)
              rw::part_a_block(PA, F.lds + RING_OFF, u >> 7, u & 127, 16, F.tid, F.MISC + 60); }
      }
        if (BOTH(2)) GRID_BAR(2); STAMP(3);
    }

    if (IN(3)) {
        const attn_body::AttnTensors AT{(const attn_body::bf16*)(U + C_FQ), (const attn_body::bf16*)(U + C_FK), (const attn_body::bf16*)(U + C_FV), (attn_body::bf16*)(MIX + RW),
                                        (const float*)(F.ws + WS_CK), F.in[I_OG]};
      {
        _Pragma("unroll") for (int r2_ = 0; r2_ < DUPN(16); ++r2_) if (F.vcu < BATCH * NH) rw::part_b_block(F.ws + WS_REC, (bf16*)(F.ws + WS_SREC), F.lds + RING_OFF, F.vcu, F.tid);
        __syncthreads();
        for (;;) {
            if (F.wave == 0) {
                int ln_ = (int)threadIdx.x; asm volatile("" : "+v"(ln_));
                unsigned jj = 0; if (ln_ == 0) { jj = __hip_atomic_fetch_add((unsigned*)(F.ctl + CW_AQ), 1u, RLX_AGENT); F.MISC[18] = 0u; }
                int j = (int)__builtin_amdgcn_readfirstlane(jj); int kt0 = 0;
                const int NQ_ = 1024 + XW_ITEMS; j = (j < NQ_) ? (((j % 5) < 2) ? (j / 5) * 2 + (j % 5) : 1024 + (j / 5) * 3 + (j % 5) - 2) : NQ_;
                if (j < BATCH * NH * (T / 256)) { const int bh = j & 31, qb = 31 - (j >> 5), q0 = qb * 256, ntf = (q0 + 256) / 64;
                    const float th = 2.0f * __uint_as_float(__hip_atomic_load((unsigned*)(F.ctl + CW_QK + 64 * bh), RLX_AGENT)) * __uint_as_float(__hip_atomic_load((unsigned*)(F.ctl + CW_QK + 64 * bh + 1), RLX_AGENT)) + 37.0f;
                    const float* ck = AT.CK + (size_t)bh * T; const int cand = 2 * ln_;
                    bool ok = false; if (cand >= 2 && cand <= ntf - 4) ok = (ck[64 * cand - 1] - ck[q0]) >= th;
                    kt0 = 2 * (int)__popcll(__ballot(ok)); }
                if (ln_ == 0) { F.MISC[16] = (unsigned)j; F.MISC[17] = (unsigned)kt0; } }
            __syncthreads();
            const int j = (int)F.MISC[16], kt0 = (int)F.MISC[17]; const unsigned lim = F.MISC[18];
            __syncthreads();
            if (j >= 1024 + XW_ITEMS) break;
            if (j >= 1024) { xw_item(F, j - 1024); if (lim && F.tid == 0) __hip_atomic_fetch_add((unsigned*)(F.ctl + CW_XN), 0xffffffffu, RLX_AGENT); continue; }
            const int bh = j & 31, qb = 31 - (j >> 5);
            attn_body::attn_unit<8>(bh / NH, bh % NH, qb, kt0, AT.Q, AT.K, AT.V, AT.O, AT.CK, AT.OG, (char*)lds + RING_OFF);
        }
      }
        if (BOTH(3)) GRID_BAR(3); STAMP(4);
    }

    if (IN(4)) {
        const rw::PartC PC{F.ws + WS_REC, (const bf16*)(F.ws + WS_SREC), (const bf16*)(F.ws + WS_BON), (const bf16*)(F.ws + WS_GG), F.in[I_LNW], F.in[I_LNB], MIX};
        _Pragma("unroll") for (int rep_ = 0; rep_ < DUPN(4); ++rep_) for (int u = F.vcu * 2 + (F.wave >> 2); u < 4096; u += F.G * 2) rw::part_c_wave(PC, F.lds + RING_OFF + F.wave * 2048, u, F.wave & 3, F.lane);
        if (BOTH(4)) GRID_BAR(4); STAMP(5);
    }

    if (IN(5)) {
        pg8::Gemm g{MIX, WOUT_T, D, 0, nullptr, 0}; pg8::StaticOrder S; S.init(M, D, F.G, (int)blockIdx.x);
        pg8::EpiRes E{F.in[I_X], (bf16*)(F.ws + WS_X1), D};
        _Pragma("unroll") for (int rep_ = 0; rep_ < DUPN(5); ++rep_) pg8::gemm_phase<pg8::EpiRes, pg8::StaticOrder, false, PG8_ALIGN, PG8_SP2>(F.lds + RING_OFF, g, S, E);
        if (BOTH(5)) GRID_BAR(5); STAMP(6);
    }

    if (IN(6)) { p6_route(F); if (BOTH(6)) GRID_BAR(6); STAMP(7); }

    if (IN(7)) {
        moe_prefix(F);
        pg8::Gemm g{XN, W1_T, D / 2, (size_t)NH1 * D / 2, (const int*)(F.ws + WS_ELIST), M};
        MoeOrder S{(const LAS int*)(F.lds + TPRE_OFF), (const LAS int*)(F.lds + ECNT_OFF), NH1 / 256, F.G, (int)blockIdx.x};
        pg8::EpiSwiglu E{(unsigned char*)ACT, DFF, F.in[I_B1], NH1};
        _Pragma("unroll") for (int rep_ = 0; rep_ < DUPN(7); ++rep_) pg8::gemm_phase<pg8::EpiSwiglu, MoeOrder, true, PG8_ALIGN, PG8_SP2, 121>(F.lds + RING_OFF, g, S, E);
        if (BOTH(7)) GRID_BAR(7); STAMP(8);
    }

    if (IN(8)) {
        if (!IN(7)) moe_prefix(F);
        pg8::Gemm g{ACT, W2_T, DFF / 2, (size_t)D * DFF / 2, nullptr, 0};
        MoeOrder S{(const LAS int*)(F.lds + TPRE_OFF), (const LAS int*)(F.lds + ECNT_OFF), D / 256, F.G, (int)blockIdx.x};
        pg8::EpiBias E{(unsigned char*)Y2, D, F.in[I_B2], D};
        _Pragma("unroll") for (int rep_ = 0; rep_ < DUPN(8); ++rep_) pg8::gemm_phase<pg8::EpiBias, MoeOrder, false, PG8_ALIGN, PG8_SP2, 121>(F.lds + RING_OFF, g, S, E);
        if (BOTH(8)) GRID_BAR(8); STAMP(9);
    }

    if (IN(9)) { if (!IN(8)) moe_prefix(F); p9_final(F); }
    STAMP(10);
    if (TS_PROBE >= 100 && blockIdx.x == 0 && F.tid == 0) {
        const unsigned long long span_ = (((unsigned long long)F.MISC[61] << 32) | F.MISC[60]) * TS_MULT, t0_ = __builtin_amdgcn_s_memrealtime();
        while (__builtin_amdgcn_s_memrealtime() - t0_ < span_) __builtin_amdgcn_s_sleep(8);
    }
    if (TS_PROBE >= 0 && TS_PROBE < 100 && blockIdx.x == 0 && F.tid == 0) {
        const unsigned long long a_ = ((unsigned long long)F.MISC[33 + 2 * TS_PROBE] << 32) | F.MISC[32 + 2 * TS_PROBE], b_ = ((unsigned long long)F.MISC[35 + 2 * TS_PROBE] << 32) | F.MISC[34 + 2 * TS_PROBE];
        const unsigned long long t0_ = __builtin_amdgcn_s_memrealtime(), span_ = (b_ - a_) * TS_MULT;
        while (__builtin_amdgcn_s_memrealtime() - t0_ < span_) __builtin_amdgcn_s_sleep(8);
    }
#undef IN
#undef BOTH
}

extern "C" void kernel_launch(void* const* d_in, const int* in_sizes, int n_in, void* d_out, int out_size, void* d_ws, size_t ws_size, hipStream_t stream) {
    static int grid = 0;
    if (grid == 0) {
        if (n_in != 25 || in_sizes[0] != M * D || out_size != M * D || ws_size < WS_END) { fprintf(stderr, "kernel_launch: unexpected shapes (n_in %d, in0 %d, out %d, ws %zu); nothing launched\n", n_in, n_in > 0 ? in_sizes[0] : -1, out_size, ws_size); grid = -1; return; }
        int dev = 0, cus = 0, per_cu = 0;
        if (hipGetDevice(&dev) != hipSuccess || hipDeviceGetAttribute(&cus, hipDeviceAttributeMultiprocessorCount, dev) != hipSuccess) { grid = -1; return; }
        if (hipFuncSetAttribute((const void*)mk_fwd, hipFuncAttributeMaxDynamicSharedMemorySize, LDS_BYTES) != hipSuccess) { fprintf(stderr, "kernel_launch: hipFuncSetAttribute failed\n"); grid = -1; return; }
        if (hipOccupancyMaxActiveBlocksPerMultiprocessor(&per_cu, (const void*)mk_fwd, NWAVES * 64, LDS_BYTES) != hipSuccess || per_cu < 1) fprintf(stderr, "kernel_launch: occupancy query reports %d\n", per_cu);
        (void)hipGetLastError();
        grid = cus;
        if (grid != 256) { fprintf(stderr, "kernel_launch: built for 256 CUs, found %d\n", grid); }
    }
    if (grid < 0) return;
    if (hipMemsetAsync((char*)d_ws + WS_CTL, 0, CTL_ZERO_BYTES, stream) != hipSuccess) return;
    Args a{};
    for (int i = 0; i < 25; ++i) a.in[i] = (const float*)d_in[i];
    a.out = (float*)d_out; a.ws = (unsigned char*)d_ws;
    for (int li = 0; li < N_LAUNCHES; ++li) {
        a.ph_lo = (N_LAUNCHES == PER_PHASE) ? li : 0; a.ph_hi = (N_LAUNCHES == PER_PHASE) ? li + 1 : PER_PHASE; a.li = li;
        hipLaunchKernelGGL(mk_fwd, dim3(grid), dim3(NWAVES * 64), LDS_BYTES, stream, a);
    }
}
```
